# Optimizing an MI355X kernel written in HIP

```python
import jax, jax.numpy as jnp
from jax import lax
import numpy as np

D_MODEL = 1024
BATCH = 8
SEQ = 2048
DEPTH = 2
DEC_BATCH = 128
DEC_SEQ = 1
PAST_LEN = 16384
PAGE_SIZE = 128

W_POOL = D_MODEL // 2
POOL_WINDOWS = (2, 4, 8, 16)
N_POOL_GROUPS = len(POOL_WINDOWS)
POOL_GROUP_DIM = W_POOL // N_POOL_GROUPS
POOL_BUF = max(POOL_WINDOWS) - 1
W_GMLP = D_MODEL // 2
GMLP_CHUNK = 128
N_GMLP_HEADS = 4
GMLP_HEAD_DIM = W_GMLP // N_GMLP_HEADS
W_CONV = D_MODEL // 2
CONV_K = 31
W_SC = D_MODEL // 2
SC_K = 3
IN_COLS = W_POOL + 2 * W_GMLP + 2 * W_CONV + 3 * W_SC
N_BRANCH = 4
N_MEM = 256
N_XHEADS = 4
XHEAD_DIM = D_MODEL // N_XHEADS
D_FF = ((8 * D_MODEL // 3 + 127) // 128) * 128
DN_ALPHA = (2.0 * DEPTH) ** 0.25
DN_BETA = (8.0 * DEPTH) ** -0.25
LN_EPS = 1e-5

kernel_name = 'hybrid_pool_sgu_conv_decoder_step'


def _layernorm(x, g, b):
    xf = x.astype(jnp.float32)
    mu = jnp.mean(xf, axis=-1, keepdims=True)
    var = jnp.mean(jnp.square(xf - mu), axis=-1, keepdims=True)
    y = (xf - mu) * lax.rsqrt(var + LN_EPS) * g.astype(jnp.float32) + b.astype(jnp.float32)
    return y.astype(x.dtype)


def _swiglu(x, w1, w3, w2):
    return (jax.nn.silu(x @ w1) * (x @ w3)) @ w2


def _causal_depthwise(ext, w):
    return lax.conv_general_dilated(ext, w[:, None, :].astype(ext.dtype), window_strides=(1,),
                                    padding='VALID', dimension_numbers=('NWC', 'WIO', 'NWC'),
                                    feature_group_count=ext.shape[-1])


def _pool_mix(a_ext, pos0, w_group, scale):
    n_b = a_ext.shape[0]
    L = a_ext.shape[1] - POOL_BUF
    af = a_ext.astype(jnp.float32)
    cs = jnp.concatenate([jnp.zeros_like(af[:, :1]), jnp.cumsum(af, axis=1)], axis=1)
    hi = cs[:, POOL_BUF + 1:]
    pos = pos0 + jnp.arange(L)
    means = []
    for g, win in enumerate(POOL_WINDOWS):
        c = slice(g * POOL_GROUP_DIM, (g + 1) * POOL_GROUP_DIM)
        lo = cs[:, POOL_BUF + 1 - win:POOL_BUF + 1 - win + L, c]
        cnt = jnp.minimum(pos + 1, win).astype(jnp.float32)[None, :, None]
        means.append((hi[:, :, c] - lo) / cnt)
    pooled = (jnp.concatenate(means, axis=-1) - af[:, POOL_BUF:]).astype(a_ext.dtype)
    grouped = pooled.reshape(n_b, L, N_POOL_GROUPS, POOL_GROUP_DIM)
    y = jnp.einsum('blgc,gcd->blgd', grouped, w_group).reshape(n_b, L, W_POOL)
    return y * scale


def _gmlp_sgu(u, v, ws, bias):
    n_b, L, _ = v.shape
    n = min(L, GMLP_CHUNK)
    mask = jnp.tril(jnp.ones((n, n), dtype=bool))
    w = jnp.where(mask[None], ws[:, :n, :n], 0)
    vc = v.reshape(n_b, L // n, n, N_GMLP_HEADS, GMLP_HEAD_DIM)
    z = jnp.einsum('hts,bcshd->bcthd', w, vc) + bias[:, :n].T[None, None, :, :, None]
    return u * z.reshape(n_b, L, W_GMLP)


def _token_mixer(h, pos0, pool_buf, conv_buf, sc_buf, p):
    n_b, L, _ = h.shape
    s1 = W_POOL
    s2 = s1 + W_GMLP
    s3 = s2 + W_GMLP
    s4 = s3 + W_CONV
    s5 = s4 + W_CONV
    s6 = s5 + W_SC
    s7 = s6 + W_SC
    proj = h @ p['w_in']
    a, gu, gv, ca, cb, sbg, scg, sx = jnp.split(proj, [s1, s2, s3, s4, s5, s6, s7], axis=-1)
    a_ext = jnp.concatenate([pool_buf, a], axis=1)
    y_a = _pool_mix(a_ext, pos0, p['pool_w'], p['pool_scale']) @ p['pool_proj']
    new_pool = a_ext[:, -POOL_BUF:]
    v = _layernorm(gv, p['gmlp_ln_g'], p['gmlp_ln_b'])
    y_b = _gmlp_sgu(gu, v, p['gmlp_ws'], p['gmlp_b']) @ p['gmlp_proj']
    glu = ca * jax.nn.sigmoid(cb)
    c_ext = jnp.concatenate([conv_buf, glu], axis=1)
    c = _causal_depthwise(c_ext, p['conv_dw']) + p['conv_db']
    y_c = jax.nn.silu(_layernorm(c, p['conv_ln_g'], p['conv_ln_b'])) @ p['conv_proj']
    new_conv = c_ext[:, -(CONV_K - 1):]
    z_ext = jnp.concatenate([sc_buf, scg * sx], axis=1)
    y_d = (sbg * _causal_depthwise(z_ext, p['sc_w'])) @ p['sc_proj']
    new_sc = z_ext[:, -(SC_K - 1):]
    gates = jax.nn.sigmoid(h @ p['w_gate'] + p['b_gate']).reshape(n_b, L, N_BRANCH, D_MODEL)
    merged = gates[:, :, 0] * y_a + gates[:, :, 1] * y_b + gates[:, :, 2] * y_c + gates[:, :, 3] * y_d
    return merged @ p['w_o'], new_pool, new_conv, new_sc, v


def _cross_attn(h, k, v, wq, wo):
    n_b, L, _ = h.shape
    q = (h @ wq).reshape(n_b, L, N_XHEADS, XHEAD_DIM)
    s = jnp.einsum('blhd,bmhd->bhlm', q, k).astype(jnp.float32) * (XHEAD_DIM ** -0.5)
    pr = jax.nn.softmax(s, axis=-1).astype(v.dtype)
    o = jnp.einsum('bhlm,bmhd->blhd', pr, v).reshape(n_b, L, D_MODEL)
    return o @ wo


def _layer(x, pos0, pool_buf, conv_buf, sc_buf, mem_k, mem_v, p):
    x = _layernorm(DN_ALPHA * x + 0.5 * _swiglu(x, p['ffn1_w1'], p['ffn1_w3'], p['ffn1_w2']), p['ln1_g'], p['ln1_b'])
    mix, new_pool, new_conv, new_sc, v = _token_mixer(x, pos0, pool_buf, conv_buf, sc_buf, p)
    x = _layernorm(DN_ALPHA * x + mix, p['ln2_g'], p['ln2_b'])
    x = _layernorm(DN_ALPHA * x + _cross_attn(x, mem_k, mem_v, p['xa_wq'], p['xa_wo']), p['ln3_g'], p['ln3_b'])
    x = _layernorm(DN_ALPHA * x + 0.5 * _swiglu(x, p['ffn2_w1'], p['ffn2_w3'], p['ffn2_w2']), p['ln4_g'], p['ln4_b'])
    return x, new_pool, new_conv, new_sc, v


def setup_inputs(seed: int = 0) -> dict:
    key = jax.random.key(seed)
    ks = iter(jax.random.split(key, 80))

    def nrm(shape, scale):
        return jax.random.normal(next(ks), shape, jnp.float32) * scale

    def gain(shape):
        return 1.0 + nrm(shape, 0.05)

    def bias(shape):
        return nrm(shape, 0.02)

    L = DEPTH
    return {
        'x_prompt': nrm((BATCH, SEQ, D_MODEL), 1.0),
        'x_sample': nrm((DEC_BATCH, DEC_SEQ, D_MODEL), 1.0),
        'mem_prompt': nrm((BATCH, N_MEM, D_MODEL), 1.0),
        'state_pool': nrm((DEPTH, DEC_BATCH, POOL_BUF, W_POOL), 1.0),
        'state_conv': nrm((DEPTH, DEC_BATCH, CONV_K - 1, W_CONV), 0.5),
        'state_shortconv': nrm((DEPTH, DEC_BATCH, SC_K - 1, W_SC), 0.5),
        'cache_mem_k': nrm((DEPTH, DEC_BATCH, N_MEM, N_XHEADS, XHEAD_DIM), 1.0),
        'cache_mem_v': nrm((DEPTH, DEC_BATCH, N_MEM, N_XHEADS, XHEAD_DIM), 1.0),
        'ln1_g': gain((L, D_MODEL)),
        'ln1_b': bias((L, D_MODEL)),
        'ffn1_w1': nrm((L, D_MODEL, D_FF), D_MODEL ** -0.5),
        'ffn1_w3': nrm((L, D_MODEL, D_FF), D_MODEL ** -0.5),
        'ffn1_w2': nrm((L, D_FF, D_MODEL), DN_BETA * D_FF ** -0.5),
        'w_in': nrm((L, D_MODEL, IN_COLS), D_MODEL ** -0.5),
        'w_gate': nrm((L, D_MODEL, N_BRANCH * D_MODEL), D_MODEL ** -0.5),
        'b_gate': bias((L, N_BRANCH * D_MODEL)),
        'pool_w': nrm((L, N_POOL_GROUPS, POOL_GROUP_DIM, POOL_GROUP_DIM), POOL_GROUP_DIM ** -0.5),
        'pool_scale': 1.0 + nrm((L, W_POOL), 0.1),
        'pool_proj': nrm((L, W_POOL, D_MODEL), W_POOL ** -0.5),
        'gmlp_ln_g': gain((L, W_GMLP)),
        'gmlp_ln_b': bias((L, W_GMLP)),
        'gmlp_ws': nrm((L, N_GMLP_HEADS, GMLP_CHUNK, GMLP_CHUNK), GMLP_CHUNK ** -0.5),
        'gmlp_b': 1.0 + nrm((L, N_GMLP_HEADS, GMLP_CHUNK), 0.1),
        'gmlp_proj': nrm((L, W_GMLP, D_MODEL), W_GMLP ** -0.5),
        'conv_dw': nrm((L, CONV_K, W_CONV), CONV_K ** -0.5),
        'conv_db': bias((L, W_CONV)),
        'conv_ln_g': gain((L, W_CONV)),
        'conv_ln_b': bias((L, W_CONV)),
        'conv_proj': nrm((L, W_CONV, D_MODEL), W_CONV ** -0.5),
        'sc_w': nrm((L, SC_K, W_SC), SC_K ** -0.5),
        'sc_proj': nrm((L, W_SC, D_MODEL), W_SC ** -0.5),
        'w_o': nrm((L, D_MODEL, D_MODEL), DN_BETA * D_MODEL ** -0.5),
        'ln2_g': gain((L, D_MODEL)),
        'ln2_b': bias((L, D_MODEL)),
        'xa_wq': nrm((L, D_MODEL, D_MODEL), D_MODEL ** -0.5),
        'xa_wk': nrm((L, D_MODEL, D_MODEL), D_MODEL ** -0.5),
        'xa_wv': nrm((L, D_MODEL, D_MODEL), D_MODEL ** -0.5),
        'xa_wo': nrm((L, D_MODEL, D_MODEL), DN_BETA * D_MODEL ** -0.5),
        'ln3_g': gain((L, D_MODEL)),
        'ln3_b': bias((L, D_MODEL)),
        'ffn2_w1': nrm((L, D_MODEL, D_FF), D_MODEL ** -0.5),
        'ffn2_w3': nrm((L, D_MODEL, D_FF), D_MODEL ** -0.5),
        'ffn2_w2': nrm((L, D_FF, D_MODEL), DN_BETA * D_FF ** -0.5),
        'ln4_g': gain((L, D_MODEL)),
        'ln4_b': bias((L, D_MODEL)),
    }


def reference(x_prompt, x_sample, mem_prompt, state_pool, state_conv, state_shortconv, cache_mem_k, cache_mem_v,
              ln1_g, ln1_b, ffn1_w1, ffn1_w3, ffn1_w2, w_in, w_gate, b_gate, pool_w, pool_scale, pool_proj,
              gmlp_ln_g, gmlp_ln_b, gmlp_ws, gmlp_b, gmlp_proj, conv_dw, conv_db, conv_ln_g, conv_ln_b, conv_proj,
              sc_w, sc_proj, w_o, ln2_g, ln2_b, xa_wq, xa_wk, xa_wv, xa_wo, ln3_g, ln3_b,
              ffn2_w1, ffn2_w3, ffn2_w2, ln4_g, ln4_b):
    n_p = x_prompt.shape[0]
    dt = x_prompt.dtype
    hp, hs = x_prompt, x_sample
    pool_p, conv_p, sc_p, mk_p, mv_p = [], [], [], [], []
    pool_s, conv_s, sc_s, gv_s = [], [], [], []
    for l in range(DEPTH):
        p = dict(ln1_g=ln1_g[l], ln1_b=ln1_b[l], ffn1_w1=ffn1_w1[l], ffn1_w3=ffn1_w3[l], ffn1_w2=ffn1_w2[l],
                 w_in=w_in[l], w_gate=w_gate[l], b_gate=b_gate[l], pool_w=pool_w[l], pool_scale=pool_scale[l],
                 pool_proj=pool_proj[l], gmlp_ln_g=gmlp_ln_g[l], gmlp_ln_b=gmlp_ln_b[l], gmlp_ws=gmlp_ws[l],
                 gmlp_b=gmlp_b[l], gmlp_proj=gmlp_proj[l], conv_dw=conv_dw[l], conv_db=conv_db[l],
                 conv_ln_g=conv_ln_g[l], conv_ln_b=conv_ln_b[l], conv_proj=conv_proj[l], sc_w=sc_w[l],
                 sc_proj=sc_proj[l], w_o=w_o[l], ln2_g=ln2_g[l], ln2_b=ln2_b[l], xa_wq=xa_wq[l], xa_wo=xa_wo[l],
                 ln3_g=ln3_g[l], ln3_b=ln3_b[l], ffn2_w1=ffn2_w1[l], ffn2_w3=ffn2_w3[l], ffn2_w2=ffn2_w2[l],
                 ln4_g=ln4_g[l], ln4_b=ln4_b[l])
        mk = (mem_prompt @ xa_wk[l]).reshape(n_p, N_MEM, N_XHEADS, XHEAD_DIM)
        mv = (mem_prompt @ xa_wv[l]).reshape(n_p, N_MEM, N_XHEADS, XHEAD_DIM)
        hp, npool, nconv, nsc, _ = _layer(
            hp, 0,
            jnp.zeros((n_p, POOL_BUF, W_POOL), dt),
            jnp.zeros((n_p, CONV_K - 1, W_CONV), dt),
            jnp.zeros((n_p, SC_K - 1, W_SC), dt),
            mk, mv, p)
        pool_p.append(npool)
        conv_p.append(nconv)
        sc_p.append(nsc)
        mk_p.append(mk)
        mv_p.append(mv)
        hs, spool, sconv, ssc, sv = _layer(hs, PAST_LEN, state_pool[l], state_conv[l], state_shortconv[l],
                                           cache_mem_k[l], cache_mem_v[l], p)
        pool_s.append(spool)
        conv_s.append(sconv)
        sc_s.append(ssc)
        gv_s.append(sv)
    return (hp, hs,
            jnp.stack(pool_p), jnp.stack(conv_p), jnp.stack(sc_p), jnp.stack(mk_p), jnp.stack(mv_p),
            jnp.stack(pool_s), jnp.stack(conv_s), jnp.stack(sc_s), jnp.stack(gv_s))
```

```cpp
#include <hip/hip_runtime.h>
#include <hip/hip_cooperative_groups.h>
#include <cstdio>
#include <cstdint>
namespace cg = cooperative_groups;
#define MK_TID (wv_ * 64 + (int)__builtin_amdgcn_mbcnt_hi(~0u, __builtin_amdgcn_mbcnt_lo(~0u, 0u)))

#ifndef MK_MULTI
#define MK_MULTI 0
#endif

namespace pg8 {
#define PG8_LAS __attribute__((address_space(3)))
typedef unsigned short bf16_t;
typedef short bf16x8 __attribute__((ext_vector_type(8)));
typedef float f32x4 __attribute__((ext_vector_type(4)));
typedef float f32x2 __attribute__((ext_vector_type(2)));
typedef unsigned u32x4 __attribute__((ext_vector_type(4)));
typedef unsigned u32x2 __attribute__((ext_vector_type(2)));
constexpr int BM = 256, BK = 64, HALF = 128, HTB = HALF * BK * 2, STAGE_BYTES = 8 * HTB, NXCD = 8, WGM = 8;

__host__ __device__ __forceinline__ int lds_byte(int r, int c) { const int st = (r >> 4) * 2 + (c >> 5), rr = r & 15, cc = c & 31, ob = rr * 64 + cc * 2; return st * 1024 + (ob ^ (((ob >> 9) & 1) << 5)); }
__host__ __device__ __forceinline__ void stage_rc(int b, int& R, int& C) { const int st = b / 1024, sb = b % 1024, swz = sb ^ (((sb >> 9) & 1) << 5); R = (st >> 1) * 16 + swz / 64; C = (st & 1) * 32 + (swz % 64) / 2; }
__host__ __device__ __forceinline__ int perm32(int rho) { const int n = rho >> 4, i = rho & 15; return 8 * (i >> 2) + 4 * n + (i & 3); }

struct Unit { int pm, pn, aux; size_t aoff, boff; };
struct Gemm { const bf16_t* A; const bf16_t* Bt; int lda, ldb, K; };

struct Sched {
    int nM, nN, nsub, nwg, G, c;
    size_t a_pm, a_pn, a_sub, a_b, b_pn, b_sub, b_b;
    __device__ __forceinline__ void init(int nM_, int nN_, int nsub_, int G_, int c_) { nM = nM_; nN = nN_; nsub = nsub_; nwg = nM_ * nN_; G = G_; c = c_; a_pm = a_pn = a_sub = a_b = b_pn = b_sub = b_b = 0; }
    __device__ __forceinline__ bool next(int i, Unit& u) const {
        const int sub = i % nsub; const long L = (long)(i / nsub) * G + c; if (L >= nwg) return false;
        int wgid = (int)L; { const int q = nwg / NXCD, r = nwg % NXCD, xcd = wgid % NXCD, off = wgid / NXCD; wgid = (xcd < r ? xcd * (q + 1) : r * (q + 1) + (xcd - r) * q) + off; }
        const int nig = WGM * nN, gid = wgid / nig, fm = gid * WGM, gsz = (nM - fm) < WGM ? (nM - fm) : WGM;
        u.pm = fm + ((wgid % nig) % gsz); u.pn = (wgid % nig) / gsz; u.aux = sub;
        u.aoff = (size_t)u.pm * a_pm + (size_t)u.pn * a_pn + (size_t)sub * a_sub + (size_t)(u.pm >> 3) * a_b;
        u.boff = (size_t)u.pn * b_pn + (size_t)sub * b_sub + (size_t)(u.pm >> 3) * b_b;
        return true;
    }
};

typedef __bf16 bf16v2 __attribute__((ext_vector_type(2)));
__device__ __forceinline__ unsigned cvt_pk_bf16(float lo, float hi) { const f32x2 v = {lo, hi}; return __builtin_bit_cast(unsigned, __builtin_convertvector(v, bf16v2)); }
__device__ __forceinline__ float sigm(float x) { return __builtin_amdgcn_rcpf(1.f + __expf(-x)); }
__device__ __forceinline__ f32x4 sigm4(f32x4 v) { return (f32x4){sigm(v[0]), sigm(v[1]), sigm(v[2]), sigm(v[3])}; }
__device__ __forceinline__ u32x4 pack2(f32x4 v0, f32x4 v1) { u32x4 w; w.x = cvt_pk_bf16(v0[0], v0[1]); w.y = cvt_pk_bf16(v0[2], v0[3]); w.z = cvt_pk_bf16(v1[0], v1[1]); w.w = cvt_pk_bf16(v1[2], v1[3]); return w; }
__device__ __forceinline__ f32x4 bflo(unsigned a, unsigned b) { return (f32x4){__uint_as_float(a << 16), __uint_as_float(a & 0xffff0000u), __uint_as_float(b << 16), __uint_as_float(b & 0xffff0000u)}; }

typedef f32x4 Acc[2][2][4][2];

struct EpiUp {
    bf16_t* H; int ldh;
    __device__ __forceinline__ bool keep(const Unit&) const { return false; }
    __device__ __forceinline__ void operator()(Acc& acc, const Unit& u, int wr, int wc, int fr, int fq, PG8_LAS unsigned char*) const {
        const int row0 = u.pm * BM + wr * 64 + fr, col = u.pn * 128 + wc * 32 + 8 * fq;
#pragma unroll
        for (int ai = 0; ai < 2; ++ai)
#pragma unroll
            for (int m = 0; m < 4; ++m) {
                const f32x4 a0 = acc[ai][0][m][0], a1 = acc[ai][0][m][1], b0 = acc[ai][1][m][0], b1 = acc[ai][1][m][1];
                const f32x4 h0 = a0 * sigm4(a0) * b0, h1 = a1 * sigm4(a1) * b1;
                *(u32x4*)(H + (size_t)(row0 + ai * HALF + m * 16) * ldh + col) = pack2(h0, h1);
            }
    }
};
template <int HALF_SCALE>
struct EpiResidLN {
    bf16_t* XB; const float* g; const float* b; float* out; unsigned char* ctl;
    long xoff;
    __device__ __forceinline__ bool keep(const Unit&) const { return false; }
    __device__ __forceinline__ void operator()(Acc& acc, const Unit& u, int wr, int wc, int fr, int fq, PG8_LAS unsigned char* lds) const {
        constexpr float alpha = 1.41421356237f, s = HALF_SCALE ? 0.5f : 1.0f;
        unsigned long long* xbuf = (unsigned long long*)(ctl + xoff); unsigned* cnt = (unsigned*)ctl;
        PG8_LAS f32x2* P = (PG8_LAS f32x2*)(lds + STAGE_BYTES);
        PG8_LAS f32x2* S = (PG8_LAS f32x2*)(lds + STAGE_BYTES + 8192);
        const int row0 = u.pm * BM + wr * 64 + fr, col = u.pn * BM + wc * 32 + 8 * fq, wid = wr * 4 + wc, lane = fq * 16 + fr;
#pragma unroll
        for (int ai = 0; ai < 2; ++ai) {
            u32x4 xr[4][2];
#pragma unroll
            for (int m = 0; m < 4; ++m)
#pragma unroll
                for (int bj = 0; bj < 2; ++bj) xr[m][bj] = *(const u32x4*)(XB + (size_t)(row0 + ai * HALF + m * 16) * 1024 + col + bj * HALF);
#pragma unroll
            for (int m = 0; m < 4; ++m)
#pragma unroll
                for (int bj = 0; bj < 2; ++bj) { const u32x4 x = xr[m][bj];
                    acc[ai][bj][m][0] = bflo(x.x, x.y) * alpha + acc[ai][bj][m][0] * s; acc[ai][bj][m][1] = bflo(x.z, x.w) * alpha + acc[ai][bj][m][1] * s; }
            asm volatile("" ::: "memory");
        }
#pragma unroll
        for (int ai = 0; ai < 2; ++ai)
#pragma unroll
            for (int m = 0; m < 4; ++m) {
                float sm = 0.f;
#pragma unroll
                for (int bj = 0; bj < 2; ++bj)
#pragma unroll
                    for (int n = 0; n < 2; ++n) { const f32x4 x = acc[ai][bj][m][n]; sm += (x[0] + x[1]) + (x[2] + x[3]); }
                sm += __shfl_xor(sm, 16); sm += __shfl_xor(sm, 32);
                const float mw = sm * (1.0f / 64.0f); float q = 0.f;
#pragma unroll
                for (int bj = 0; bj < 2; ++bj)
#pragma unroll
                    for (int n = 0; n < 2; ++n) { const f32x4 d = acc[ai][bj][m][n] - mw; q += (d[0] * d[0] + d[1] * d[1]) + (d[2] * d[2] + d[3] * d[3]); }
                q += __shfl_xor(q, 16); q += __shfl_xor(q, 32);
                if (fq == 0) P[(ai * HALF + wr * 64 + m * 16 + fr) * 4 + wc] = (f32x2){mw, q};
            }
        asm volatile("s_waitcnt lgkmcnt(0)" ::: "memory"); __builtin_amdgcn_s_barrier(); asm volatile("" ::: "memory");
        const int row = wid * 32 + (lane & 31);
        if (lane < 32) {
            const f32x2 a = P[row * 4 + 0], bb = P[row * 4 + 1], c = P[row * 4 + 2], d = P[row * 4 + 3];
            const float mt = (a.x + bb.x + c.x + d.x) * 0.25f;
            const float da = a.x - mt, db = bb.x - mt, dc = c.x - mt, dd = d.x - mt;
            const float m2 = (a.y + bb.y) + (c.y + d.y) + 64.0f * ((da * da + db * db) + (dc * dc + dd * dd));
            unsigned long long* slot = xbuf + ((size_t)(u.pm * BM + row) * 4 + u.pn);
            __hip_atomic_store(slot, ((unsigned long long)__float_as_uint(m2) << 32) | __float_as_uint(mt), __ATOMIC_RELAXED, __HIP_MEMORY_SCOPE_AGENT);
        }
        asm volatile("s_waitcnt vmcnt(0)" ::: "memory");
        if (lane == 0) __hip_atomic_fetch_add(cnt + 64 * u.pm, 1u, __ATOMIC_RELAXED, __HIP_MEMORY_SCOPE_AGENT);
        if (wid == 0) {
            unsigned sp = 0;
            while ((unsigned)__builtin_amdgcn_readfirstlane(__hip_atomic_load(cnt + 64 * u.pm, __ATOMIC_RELAXED, __HIP_MEMORY_SCOPE_AGENT)) < 32u) { __builtin_amdgcn_s_sleep(2); if (++sp > (1u << 22)) break; }
            __builtin_amdgcn_fence(__ATOMIC_ACQUIRE, "agent");
        }
        asm volatile("s_waitcnt vmcnt(0) lgkmcnt(0)" ::: "memory"); __builtin_amdgcn_s_barrier(); asm volatile("" ::: "memory");
        if (lane < 32) {
            const unsigned long long* slot = xbuf + (size_t)(u.pm * BM + row) * 4; float mt[4], m2[4]; float ms = 0.f;
#pragma unroll
            for (int t = 0; t < 4; ++t) { const unsigned long long w = __hip_atomic_load(slot + t, __ATOMIC_RELAXED, __HIP_MEMORY_SCOPE_AGENT); mt[t] = __uint_as_float((unsigned)w); m2[t] = __uint_as_float((unsigned)(w >> 32)); ms += mt[t]; }
            const float mean = ms * 0.25f; float q = 0.f;
#pragma unroll
            for (int t = 0; t < 4; ++t) { const float dm = mt[t] - mean; q += m2[t] + 256.0f * dm * dm; }
            S[row] = (f32x2){mean, 1.0f / sqrtf(q * (1.0f / 1024.0f) + 1e-5f)};
        }
        asm volatile("s_waitcnt lgkmcnt(0)" ::: "memory"); __builtin_amdgcn_s_barrier(); asm volatile("" ::: "memory");
#pragma unroll
        for (int bj = 0; bj < 2; ++bj) {
            const f32x4 g0 = *(const f32x4*)(g + col + bj * HALF), g1 = *(const f32x4*)(g + col + bj * HALF + 4), b0 = *(const f32x4*)(b + col + bj * HALF), b1 = *(const f32x4*)(b + col + bj * HALF + 4);
#pragma unroll
            for (int ai = 0; ai < 2; ++ai)
#pragma unroll
                for (int m = 0; m < 4; ++m) {
                    const f32x2 sr = S[ai * HALF + wr * 64 + m * 16 + fr];
                    const size_t o = (size_t)(row0 + ai * HALF + m * 16) * 1024 + col + bj * HALF;
                    const f32x4 y0 = (acc[ai][bj][m][0] - sr.x) * sr.y * g0 + b0, y1 = (acc[ai][bj][m][1] - sr.x) * sr.y * g1 + b1;
                    *(u32x4*)(XB + o) = pack2(y0, y1);
                    if (out) { *(f32x4*)(out + o) = y0; *(f32x4*)(out + o + 4) = y1; }
                    asm volatile("" ::: "memory");
                }
        }
    }
};
struct EpiStore {
    bf16_t* O; int ldo; float s;
    __device__ __forceinline__ bool keep(const Unit&) const { return false; }
    __device__ __forceinline__ void operator()(Acc& acc, const Unit& u, int wr, int wc, int fr, int fq, PG8_LAS unsigned char*) const {
        const int row0 = u.pm * BM + wr * 64 + fr, col = u.pn * BM + wc * 32 + 8 * fq;
#pragma unroll
        for (int ai = 0; ai < 2; ++ai)
#pragma unroll
            for (int m = 0; m < 4; ++m) {
                bf16_t* p = O + (size_t)(row0 + ai * HALF + m * 16) * ldo + col;
#pragma unroll
                for (int bj = 0; bj < 2; ++bj) *(u32x4*)(p + bj * HALF) = pack2(acc[ai][bj][m][0] * s, acc[ai][bj][m][1] * s);
            }
    }
};
struct EpiKV {
    float* mk; float* mv; bf16_t* KB;
    __device__ __forceinline__ bool keep(const Unit&) const { return false; }
    __device__ __forceinline__ void operator()(Acc& acc, const Unit& u, int wr, int wc, int fr, int fq, PG8_LAS unsigned char*) const {
        const int row0 = u.pm * BM + wr * 64 + fr; const bool isk = u.pn < 4; const int col = (u.pn & 3) * BM + wc * 32 + 8 * fq;
        float* dst = isk ? mk : mv;
#pragma unroll
        for (int ai = 0; ai < 2; ++ai)
#pragma unroll
            for (int m = 0; m < 4; ++m) {
                const size_t o = (size_t)(row0 + ai * HALF + m * 16) * 1024 + col;
#pragma unroll
                for (int bj = 0; bj < 2; ++bj) {
                    *(f32x4*)(dst + o + bj * HALF) = acc[ai][bj][m][0]; *(f32x4*)(dst + o + bj * HALF + 4) = acc[ai][bj][m][1];
                    if (isk) *(u32x4*)(KB + o + bj * HALF) = pack2(acc[ai][bj][m][0], acc[ai][bj][m][1]);
                }
            }
    }
};
struct EpiIn {
    bf16_t* P; bf16_t* GATE; const float* bg;
    __device__ __forceinline__ bool keep(const Unit&) const { return false; }
    __device__ __forceinline__ void operator()(Acc& acc, const Unit& u, int wr, int wc, int fr, int fq, PG8_LAS unsigned char*) const {
        const int row0 = u.pm * BM + wr * 64 + fr, cw = wc * 32 + 8 * fq, pn = u.pn;
        if (pn >= 16) {
            const int col = (pn - 16) * BM + cw;
            f32x4 bv[2][2];
#pragma unroll
            for (int bj = 0; bj < 2; ++bj) { bv[bj][0] = *(const f32x4*)(bg + col + bj * HALF); bv[bj][1] = *(const f32x4*)(bg + col + bj * HALF + 4); }
#pragma unroll
            for (int ai = 0; ai < 2; ++ai)
#pragma unroll
                for (int m = 0; m < 4; ++m) {
                    bf16_t* p = GATE + (size_t)(row0 + ai * HALF + m * 16) * 4096 + col;
#pragma unroll
                    for (int bj = 0; bj < 2; ++bj) *(u32x4*)(p + bj * HALF) = pack2(sigm4(acc[ai][bj][m][0] + bv[bj][0]), sigm4(acc[ai][bj][m][1] + bv[bj][1]));
                }
        } else if ((pn >= 6 && pn < 10) || pn >= 12) {
            const bool glu = pn < 10; const int col = (glu ? 1536 + (pn - 6) * 128 : 2560 + (pn - 12) * 128) + cw;
#pragma unroll
            for (int ai = 0; ai < 2; ++ai)
#pragma unroll
                for (int m = 0; m < 4; ++m) {
                    f32x4 b0 = acc[ai][1][m][0], b1 = acc[ai][1][m][1];
                    if (glu) { b0 = sigm4(b0); b1 = sigm4(b1); }
                    *(u32x4*)(P + (size_t)(row0 + ai * HALF + m * 16) * 3072 + col) = pack2(acc[ai][0][m][0] * b0, acc[ai][0][m][1] * b1);
                }
        } else {
            const int col = (pn < 6 ? pn * BM : 2048 + (pn - 10) * BM) + cw;
#pragma unroll
            for (int ai = 0; ai < 2; ++ai)
#pragma unroll
                for (int m = 0; m < 4; ++m) {
                    bf16_t* p = P + (size_t)(row0 + ai * HALF + m * 16) * 3072 + col;
#pragma unroll
                    for (int bj = 0; bj < 2; ++bj) *(u32x4*)(p + bj * HALF) = pack2(acc[ai][bj][m][0], acc[ai][bj][m][1]);
                }
        }
    }
};
struct EpiBranch {
    const bf16_t* GATE; bf16_t* O;
    __device__ __forceinline__ bool keep(const Unit& u) const { return u.aux < 3; }
    __device__ __forceinline__ void operator()(Acc& acc, const Unit& u, int wr, int wc, int fr, int fq, PG8_LAS unsigned char*) const {
        const int row0 = u.pm * BM + wr * 64 + fr, col = u.pn * BM + wc * 32 + 8 * fq, kb = u.aux;
#pragma unroll
        for (int ai = 0; ai < 2; ++ai)
#pragma unroll
            for (int m = 0; m < 4; ++m) {
                const size_t r = (size_t)(row0 + ai * HALF + m * 16);
                const bf16_t* gp = GATE + r * 4096 + kb * 1024 + col;
#pragma unroll
                for (int bj = 0; bj < 2; ++bj) {
                    const u32x4 g = *(const u32x4*)(gp + bj * HALF);
                    f32x4 g0 = bflo(g.x, g.y), g1 = bflo(g.z, g.w);
                    if (kb < 3) {
                        const u32x4 h = *(const u32x4*)(gp + 1024 + bj * HALF);
                        const f32x4 h0 = bflo(h.x, h.y), h1 = bflo(h.z, h.w);
#pragma unroll
                        for (int j = 0; j < 4; ++j) { g0[j] = g0[j] * __builtin_amdgcn_rcpf(fmaxf(h0[j], 1e-30f)); g1[j] = g1[j] * __builtin_amdgcn_rcpf(fmaxf(h1[j], 1e-30f)); }
                        acc[ai][bj][m][0] *= g0; acc[ai][bj][m][1] *= g1;
                    } else {
                        *(u32x4*)(O + r * 1024 + col + bj * HALF) = pack2(acc[ai][bj][m][0] * g0, acc[ai][bj][m][1] * g1);
                    }
                }
            }
    }
};
struct EpiSoftmax {
    bf16_t* PR;
    __device__ __forceinline__ bool keep(const Unit&) const { return false; }
    __device__ __forceinline__ void operator()(Acc& acc, const Unit& u, int wr, int wc, int fr, int fq, PG8_LAS unsigned char* lds) const {
        PG8_LAS f32x2* X = (PG8_LAS f32x2*)(lds + STAGE_BYTES);
        const int row0 = u.pm * BM + wr * 64 + fr, col = u.pn * BM + wc * 32 + 8 * fq;
        float mxs[2][4];
#pragma unroll
        for (int ai = 0; ai < 2; ++ai)
#pragma unroll
            for (int m = 0; m < 4; ++m) {
                float mx = -3.0e38f;
#pragma unroll
                for (int bj = 0; bj < 2; ++bj)
#pragma unroll
                    for (int n = 0; n < 2; ++n) { const f32x4 v = acc[ai][bj][m][n]; mx = fmaxf(mx, fmaxf(fmaxf(v[0], v[1]), fmaxf(v[2], v[3]))); }
                mx = fmaxf(mx, __shfl_xor(mx, 16)); mx = fmaxf(mx, __shfl_xor(mx, 32));
                float sm = 0.f;
#pragma unroll
                for (int bj = 0; bj < 2; ++bj)
#pragma unroll
                    for (int n = 0; n < 2; ++n) { f32x4 v = acc[ai][bj][m][n];
#pragma unroll
                        for (int j = 0; j < 4; ++j) v[j] = __expf(v[j] - mx);
                        acc[ai][bj][m][n] = v; sm += (v[0] + v[1]) + (v[2] + v[3]); }
                sm += __shfl_xor(sm, 16); sm += __shfl_xor(sm, 32);
                mxs[ai][m] = mx;
                if (fq == 0) X[(ai * HALF + wr * 64 + m * 16 + fr) * 4 + wc] = (f32x2){mx, sm};
                asm volatile("" ::: "memory");
            }
        asm volatile("s_waitcnt lgkmcnt(0)" ::: "memory"); __builtin_amdgcn_s_barrier(); asm volatile("" ::: "memory");
#pragma unroll
        for (int ai = 0; ai < 2; ++ai)
#pragma unroll
            for (int m = 0; m < 4; ++m) {
                const int rl = ai * HALF + wr * 64 + m * 16 + fr;
                const f32x2 p0 = X[rl * 4 + 0], p1 = X[rl * 4 + 1], p2 = X[rl * 4 + 2], p3 = X[rl * 4 + 3];
                const float M = fmaxf(fmaxf(p0.x, p1.x), fmaxf(p2.x, p3.x));
                const float L = (p0.y * __expf(p0.x - M) + p1.y * __expf(p1.x - M)) + (p2.y * __expf(p2.x - M) + p3.y * __expf(p3.x - M));
                const float f = __expf(mxs[ai][m] - M) * __builtin_amdgcn_rcpf(L);
                bf16_t* p = PR + (size_t)(row0 + ai * HALF + m * 16) * 1024 + col;
#pragma unroll
                for (int bj = 0; bj < 2; ++bj) *(u32x4*)(p + bj * HALF) = pack2(acc[ai][bj][m][0] * f, acc[ai][bj][m][1] * f);
                asm volatile("" ::: "memory");
            }
        asm volatile("s_waitcnt lgkmcnt(0)" ::: "memory"); __builtin_amdgcn_s_barrier(); asm volatile("" ::: "memory");
    }
};

template <class Epi>
__device__ __forceinline__ void gemm_phase(PG8_LAS unsigned char* lds, const Gemm g, const Sched& S, const Epi& E, const int wv_) {
    int tid_ = MK_TID; asm volatile("" : "+v"(tid_)); const int tid = tid_, wid = __builtin_amdgcn_readfirstlane(tid >> 6), lane = tid & 63, wr = wid >> 2, wc = wid & 3, fr = lane & 15, fq = lane >> 4;
    const int nt = g.K / BK;
    unsigned voffA[2], voffB[2];
#pragma unroll
    for (int i = 0; i < 2; ++i) { int R, C; stage_rc(tid * 16 + i * 8192, R, C); const int Rb = (R & ~31) + perm32(R & 31);
        voffA[i] = (unsigned)(R * g.lda + C) * 2u; voffB[i] = (unsigned)(Rb * g.ldb + C) * 2u; }
    const size_t kstep = (size_t)(BK * 2);
    const size_t hstepA = (size_t)HALF * g.lda * 2, hstepB = (size_t)HALF * g.ldb * 2;
    const unsigned ldsw = (unsigned)wid * 1024u;
    const int aoff = lds_byte(wr * 64 + fr, fq * 8), boff = lds_byte(wc * 32 + fr, fq * 8);
#define PG8_SA(b, h) (((b) * 2 + (h)) * HTB)
#define PG8_SB(b, h) ((4 + (b) * 2 + (h)) * HTB)
#define PG8_STAGE(bufoff, gbase, voff) do { _Pragma("unroll") for (int _i = 0; _i < 2; ++_i) \
        __builtin_amdgcn_global_load_lds((const unsigned*)((const char*)(gbase) + (voff)[_i]), (PG8_LAS unsigned*)(lds + (bufoff) + ldsw + _i * 8192), 16, 0, 0); } while (0)
#define PG8_LDA(dst, b, h) do { _Pragma("unroll") for (int m = 0; m < 4; ++m) _Pragma("unroll") for (int k = 0; k < 2; ++k) dst[m][k] = *(const PG8_LAS bf16x8*)(lds + PG8_SA(b, h) + aoff + m * 2048 + k * 1024); } while (0)
#define PG8_LDB(dst, b, h) do { _Pragma("unroll") for (int n = 0; n < 2; ++n) _Pragma("unroll") for (int k = 0; k < 2; ++k) dst[n][k] = *(const PG8_LAS bf16x8*)(lds + PG8_SB(b, h) + boff + n * 2048 + k * 1024); } while (0)
#define PG8_MMA(ai, bj, At, Bt) do { __builtin_amdgcn_s_setprio(1); _Pragma("unroll") for (int m = 0; m < 4; ++m) _Pragma("unroll") for (int n = 0; n < 2; ++n) _Pragma("unroll") for (int k = 0; k < 2; ++k) \
        acc[ai][bj][m][n] = __builtin_amdgcn_mfma_f32_16x16x32_bf16(Bt[n][k], At[m][k], acc[ai][bj][m][n], 0, 0, 0); __builtin_amdgcn_s_setprio(0); } while (0)
#define PG8_WAIT_V(n) asm volatile("s_waitcnt vmcnt(" #n ")" ::: "memory")
#define PG8_WAIT_L(n) asm volatile("s_waitcnt lgkmcnt(" #n ")" ::: "memory")
#define PG8_BAR __builtin_amdgcn_s_barrier()
#define PG8_SCHED __builtin_amdgcn_sched_barrier(0)
#define PG8_ZERO do { _Pragma("unroll") for (int a = 0; a < 2; ++a) _Pragma("unroll") for (int b = 0; b < 2; ++b) _Pragma("unroll") for (int m = 0; m < 4; ++m) _Pragma("unroll") for (int n = 0; n < 2; ++n) acc[a][b][m][n] = (f32x4){0.f, 0.f, 0.f, 0.f}; } while (0)
    Unit cur, nxt; int ui = 0;
    if (!S.next(0, cur)) return;
    Acc acc;
    PG8_ZERO;
    bf16x8 At[4][2], B0[2][2], B1[2][2];
    const char* cA = (const char*)g.A + cur.aoff; const char* cB = (const char*)g.Bt + cur.boff;
    PG8_STAGE(PG8_SB(0, 0), cB, voffB); PG8_STAGE(PG8_SB(0, 1), cB + hstepB, voffB); PG8_STAGE(PG8_SA(0, 0), cA, voffA); PG8_STAGE(PG8_SA(0, 1), cA + hstepA, voffA);
    if (wr == 1) PG8_BAR;
    PG8_WAIT_V(2); PG8_BAR;
    PG8_STAGE(PG8_SB(1, 0), cB + kstep, voffB); PG8_STAGE(PG8_SA(1, 0), cA + kstep, voffA); PG8_STAGE(PG8_SB(1, 1), cB + hstepB + kstep, voffB);
    PG8_WAIT_V(6); PG8_BAR;
    for (;;) {
        const bool has_next = S.next(ui + 1, nxt);
        const char* nA = has_next ? (const char*)g.A + nxt.aoff : cA; const char* nB = has_next ? (const char*)g.Bt + nxt.boff : cB;
        for (int t = 0; t < nt; t += 2) {
            const bool last = (t == nt - 2);
            const char* a1 = cA + (size_t)(t + 1) * kstep;
            const char* a2 = last ? nA : cA + (size_t)(t + 2) * kstep; const char* b2 = last ? nB : cB + (size_t)(t + 2) * kstep;
            const char* a3 = a2 + kstep; const char* b3 = b2 + kstep;
            PG8_LDB(B0, 0, 0); PG8_LDB(B1, 0, 1); PG8_SCHED; PG8_LDA(At, 0, 0); PG8_STAGE(PG8_SA(1, 1), a1 + hstepA, voffA);
            PG8_WAIT_V(8); PG8_WAIT_L(0); PG8_BAR; PG8_MMA(0, 0, At, B0); PG8_MMA(0, 1, At, B1); PG8_BAR; PG8_SCHED;
            PG8_LDA(At, 0, 1); PG8_STAGE(PG8_SB(0, 0), b2, voffB); PG8_STAGE(PG8_SB(0, 1), b2 + hstepB, voffB); PG8_STAGE(PG8_SA(0, 0), a2, voffA);
            PG8_WAIT_V(8); PG8_WAIT_L(0); PG8_BAR; PG8_MMA(1, 0, At, B0); PG8_MMA(1, 1, At, B1); PG8_BAR; PG8_SCHED;
            PG8_LDB(B0, 1, 0); PG8_LDB(B1, 1, 1); PG8_SCHED; PG8_LDA(At, 1, 0); PG8_STAGE(PG8_SA(0, 1), a2 + hstepA, voffA);
            PG8_WAIT_V(8); PG8_WAIT_L(0); PG8_BAR; PG8_MMA(0, 0, At, B0); PG8_MMA(0, 1, At, B1); PG8_BAR; PG8_SCHED;
            PG8_LDA(At, 1, 1); PG8_STAGE(PG8_SB(1, 0), b3, voffB); PG8_STAGE(PG8_SB(1, 1), b3 + hstepB, voffB); PG8_STAGE(PG8_SA(1, 0), a3, voffA);
            PG8_WAIT_V(8); PG8_WAIT_L(0); PG8_BAR; PG8_MMA(1, 0, At, B0); PG8_MMA(1, 1, At, B1); PG8_BAR; PG8_SCHED;
        }
        if (wr == 0) PG8_BAR;
        PG8_WAIT_V(0);
        { int te = tid; asm volatile("" : "+v"(te));
          E(acc, cur, (te >> 8) & 1, (te >> 6) & 3, te & 15, (te >> 4) & 3, lds); }
        if (!has_next) break;
        if (!E.keep(cur)) PG8_ZERO;
        cur = nxt; cA = nA; cB = nB; ++ui;
        if (wr == 1) PG8_BAR;
    }
    PG8_WAIT_V(0);
    PG8_BAR;
#undef PG8_SA
#undef PG8_SB
#undef PG8_STAGE
#undef PG8_LDA
#undef PG8_LDB
#undef PG8_MMA
#undef PG8_WAIT_V
#undef PG8_WAIT_L
#undef PG8_BAR
#undef PG8_SCHED
#undef PG8_ZERO
}
}

using pg8::bf16_t; using pg8::f32x4; using pg8::u32x4; using pg8::u32x2; using pg8::bf16x8; using pg8::cvt_pk_bf16; using pg8::sigm;

constexpr int NWAVES = 8, NT = 512;
constexpr int D = 1024, MP = 16384, NSAMP = 128, M_TOK = MP + NSAMP, M_PAD = 16640, SEQ = 2048, NB = 8, FF = 2816, NMEM = 256;
constexpr float DN_ALPHA = 1.41421356237f, LN_EPS = 1e-5f;
constexpr size_t OUT_Y = 0, OUT_POOLP = 16908288, OUT_CONVP = 17031168, OUT_SCP = 17276928, OUT_MK = 17293312, OUT_MV = 21487616,
                 OUT_POOLS = 25681920, OUT_CONVS = 27648000, OUT_SCS = 31580160, OUT_GV = 31842304, OUT_END = 31973376;
constexpr size_t MiB = 1u << 20;
constexpr size_t WO_UP1 = 0, WO_DN1 = WO_UP1 + (size_t)5632 * 1024 * 2, WO_IN = WO_DN1 + (size_t)1024 * 2816 * 2, WO_PROJ = WO_IN + (size_t)8192 * 1024 * 2,
                 WO_WO = WO_PROJ + (size_t)1024 * 2048 * 2, WO_WQ = WO_WO + (size_t)1024 * 1024 * 2, WO_KV = WO_WQ + (size_t)1024 * 1024 * 2, WO_AO = WO_KV + (size_t)2048 * 1024 * 2,
                 WO_UP2 = WO_AO + (size_t)1024 * 1024 * 2, WO_DN2 = WO_UP2 + (size_t)5632 * 1024 * 2, W_LAYER = WO_DN2 + (size_t)1024 * 2816 * 2;
constexpr size_t WS_CTL = 0, CTL_BYTES = 16384 + 8 * 16384;
constexpr size_t WS_XBUF = 256 * 1024;
constexpr size_t WS_W = 1 * MiB, WS_XB = WS_W + 2 * W_LAYER, WS_XF = WS_XB + (size_t)M_PAD * 1024 * 2, WS_R1 = WS_XF + (size_t)M_PAD * 1024 * 4,
                 WS_R2 = WS_R1 + (size_t)M_PAD * 4096 * 2, WS_MIX = WS_R2 + (size_t)M_PAD * 3072 * 2, WS_MRG = WS_MIX + (size_t)M_PAD * 2048 * 2,
                 WS_MEMB = WS_MRG + (size_t)M_PAD * 1024 * 2, WS_KB = WS_MEMB + (size_t)2048 * 1024 * 2, WS_VT = WS_KB + (size_t)2 * 2048 * 1024 * 2, WS_END = WS_VT + (size_t)2 * 2048 * 1024 * 2;
static_assert(W_LAYER % 256 == 0, "align");
constexpr int LDS_BYTES = 147456;

enum { I_XP = 0, I_XS, I_MEM, I_SPOOL, I_SCONV, I_SSC, I_CK, I_CV, I_LN1G, I_LN1B, I_F1W1, I_F1W3, I_F1W2, I_WIN, I_WGATE, I_BGATE, I_POOLW, I_POOLS, I_POOLP,
       I_GLNG, I_GLNB, I_GWS, I_GB, I_GPROJ, I_CDW, I_CDB, I_CLNG, I_CLNB, I_CPROJ, I_SCW, I_SCPROJ, I_WO, I_LN2G, I_LN2B, I_WQ, I_WK, I_WV, I_XWO, I_LN3G, I_LN3B,
       I_F2W1, I_F2W3, I_F2W2, I_LN4G, I_LN4B, N_IN };

struct Args { const float* in[N_IN]; float* out; unsigned char* ws; int ph_lo, ph_hi; };
struct View { const Args* a; int z; unsigned char* ws; float* out; __device__ __forceinline__ const float* in(int i) const { return a->in[i + z]; } };

#define LAS __attribute__((address_space(3)))
__device__ __forceinline__ float wave_sum(float v) {
#pragma unroll
    for (int o = 1; o < 64; o <<= 1) v += __shfl_xor(v, o);
    return v;
}
__device__ __forceinline__ float wave_max(float v) {
#pragma unroll
    for (int o = 1; o < 64; o <<= 1) v = fmaxf(v, __shfl_xor(v, o));
    return v;
}
__device__ __forceinline__ void unpack8(u32x4 w, float (&f)[8]) {
    f[0] = __uint_as_float(w.x << 16); f[1] = __uint_as_float(w.x & 0xffff0000u); f[2] = __uint_as_float(w.y << 16); f[3] = __uint_as_float(w.y & 0xffff0000u);
    f[4] = __uint_as_float(w.z << 16); f[5] = __uint_as_float(w.z & 0xffff0000u); f[6] = __uint_as_float(w.w << 16); f[7] = __uint_as_float(w.w & 0xffff0000u);
}
__device__ __forceinline__ u32x4 pack8(const float (&f)[8]) { u32x4 w; w.x = cvt_pk_bf16(f[0], f[1]); w.y = cvt_pk_bf16(f[2], f[3]); w.z = cvt_pk_bf16(f[4], f[5]); w.w = cvt_pk_bf16(f[6], f[7]); return w; }
__device__ __forceinline__ void ldf8(const float* p, float (&f)[8]) { const f32x4 a = *(const f32x4*)p, b = *(const f32x4*)(p + 4); f[0] = a[0]; f[1] = a[1]; f[2] = a[2]; f[3] = a[3]; f[4] = b[0]; f[5] = b[1]; f[6] = b[2]; f[7] = b[3]; }
__device__ __forceinline__ void stf8(float* p, const float (&f)[8]) { *(f32x4*)p = (f32x4){f[0], f[1], f[2], f[3]}; *(f32x4*)(p + 4) = (f32x4){f[4], f[5], f[6], f[7]}; }
__device__ __forceinline__ void ldb8(const bf16_t* p, float (&f)[8]) { unpack8(*(const u32x4*)p, f); }

__device__ __forceinline__ void transpose_item(const float* W, int N, bf16_t* WT, int ldd, int koff, int k0, int n0, int drow0, LAS float* scr, int lane) {
    float wreg[32];
#pragma unroll
    for (int i = 0; i < 32; ++i) { const int kk = 2 * i + (lane >> 5); wreg[i] = W[(size_t)(k0 + kk) * N + n0 + (lane & 31)]; }
#pragma unroll
    for (int i = 0; i < 32; ++i) { const int kk = 2 * i + (lane >> 5); scr[kk * 33 + (lane & 31)] = wreg[i]; }
    asm volatile("s_waitcnt lgkmcnt(0)" ::: "memory");
    const int c = lane & 7;
#pragma unroll
    for (int j = 0; j < 4; ++j) { const int n = (lane >> 3) + 8 * j; const LAS float* s = scr + (8 * c) * 33 + n;
        u32x4 o; o.x = cvt_pk_bf16(s[0 * 33], s[1 * 33]); o.y = cvt_pk_bf16(s[2 * 33], s[3 * 33]); o.z = cvt_pk_bf16(s[4 * 33], s[5 * 33]); o.w = cvt_pk_bf16(s[6 * 33], s[7 * 33]);
        *(u32x4*)(WT + (size_t)(drow0 + n) * ldd + koff + k0 + 8 * c) = o; }
    asm volatile("s_waitcnt lgkmcnt(0)" ::: "memory");
}
__device__ __forceinline__ int map_pair(int n0, int half) { return 256 * (n0 >> 7) + 128 * half + (n0 & 127); }
__device__ __forceinline__ int map_win(int n0) {
    const int seg = n0 >> 9, o = n0 & 511;
    switch (seg) { case 0: case 1: case 2: return n0;
        case 3: return 1536 + map_pair(o, 0); case 4: return 1536 + map_pair(o, 1); case 5: return 2560 + o;
        case 6: return 3072 + map_pair(o, 0); default: return 3072 + map_pair(o, 1); }
}
#define NJOBS 16
template <int J> struct TJ;
#define DEF_TJ(J, SRC, K_, N_, LDD, KOFF, MAP, DST) template <> struct TJ<J> { static constexpr int src = SRC, K = K_, N = N_, ldd = LDD, koff = KOFF, map = MAP, items = (K_ / 64) * (N_ / 32); static constexpr size_t dst = DST; };
DEF_TJ(0, I_F1W1, 1024, 2816, 1024, 0, 1, WO_UP1)
DEF_TJ(1, I_F1W3, 1024, 2816, 1024, 0, 2, WO_UP1)
DEF_TJ(2, I_F1W2, 2816, 1024, 2816, 0, 0, WO_DN1)
DEF_TJ(3, I_WIN, 1024, 4096, 1024, 0, 3, WO_IN)
DEF_TJ(4, I_WGATE, 1024, 4096, 1024, 0, 4, WO_IN)
DEF_TJ(5, I_GPROJ, 512, 1024, 2048, 512, 0, WO_PROJ)
DEF_TJ(6, I_CPROJ, 512, 1024, 2048, 1024, 0, WO_PROJ)
DEF_TJ(7, I_SCPROJ, 512, 1024, 2048, 1536, 0, WO_PROJ)
DEF_TJ(8, I_WO, 1024, 1024, 1024, 0, 0, WO_WO)
DEF_TJ(9, I_WQ, 1024, 1024, 1024, 0, 0, WO_WQ)
DEF_TJ(10, I_WK, 1024, 1024, 1024, 0, 0, WO_KV)
DEF_TJ(11, I_WV, 1024, 1024, 1024, 0, 5, WO_KV)
DEF_TJ(12, I_XWO, 1024, 1024, 1024, 0, 0, WO_AO)
DEF_TJ(13, I_F2W1, 1024, 2816, 1024, 0, 1, WO_UP2)
DEF_TJ(14, I_F2W3, 1024, 2816, 1024, 0, 2, WO_UP2)
DEF_TJ(15, I_F2W2, 2816, 1024, 2816, 0, 0, WO_DN2)
template <int J> __device__ __forceinline__ void run_tjob(const View& a, LAS float* scr, int lane, int gw, int NGW, int& base) {
    typedef TJ<J> T;
    const float* W0 = a.in(T::src); unsigned char* wsW = a.ws + WS_W + T::dst;
    int r = (gw - base) % NGW; if (r < 0) r += NGW;
    for (; r < 2 * T::items; r += NGW) {
        const int l = r / T::items, q = r % T::items;
        constexpr int nblk = T::N / 32; const int kb = q / nblk, nb = q % nblk, n0 = nb * 32;
        int drow;
        if (T::map == 0) drow = n0; else if (T::map == 1) drow = map_pair(n0, 0); else if (T::map == 2) drow = map_pair(n0, 1); else if (T::map == 3) drow = map_win(n0); else if (T::map == 4) drow = 4096 + n0; else drow = 1024 + n0;
        transpose_item(W0 + (size_t)l * T::K * T::N, T::N, (bf16_t*)(wsW + (size_t)l * W_LAYER), T::ldd, T::koff, kb * 64, n0, drow, scr, lane);
    }
    base = (base + 2 * T::items) % NGW;
}

__device__ __forceinline__ void prologue(const View& a, unsigned char* lds_g, int G, int cid, const int wv_) {
    int tid_ = MK_TID; asm volatile("" : "+v"(tid_)); const int tid = tid_, lane = tid & 63, wave = __builtin_amdgcn_readfirstlane(tid >> 6);
    const int gw = cid * NWAVES + wave, NGW = G * NWAVES;
    LAS float* scr = (LAS float*)((LAS unsigned char*)lds_g + wave * 16384);
    { int base = 0;
      run_tjob<0>(a, scr, lane, gw, NGW, base); run_tjob<1>(a, scr, lane, gw, NGW, base); run_tjob<2>(a, scr, lane, gw, NGW, base); run_tjob<3>(a, scr, lane, gw, NGW, base);
      run_tjob<4>(a, scr, lane, gw, NGW, base); run_tjob<5>(a, scr, lane, gw, NGW, base); run_tjob<6>(a, scr, lane, gw, NGW, base); run_tjob<7>(a, scr, lane, gw, NGW, base);
      run_tjob<8>(a, scr, lane, gw, NGW, base); run_tjob<9>(a, scr, lane, gw, NGW, base); run_tjob<10>(a, scr, lane, gw, NGW, base); run_tjob<11>(a, scr, lane, gw, NGW, base);
      run_tjob<12>(a, scr, lane, gw, NGW, base); run_tjob<13>(a, scr, lane, gw, NGW, base); run_tjob<14>(a, scr, lane, gw, NGW, base); run_tjob<15>(a, scr, lane, gw, NGW, base); }
    for (int it = gw; it < 2048; it += NGW) {
        const int l = it >> 10, k0 = ((it >> 4) & 63) * 8, g = k0 >> 7, n = (it & 15) * 64 + lane;
        const float* pw = a.in(I_POOLW) + ((size_t)l * 512 + k0) * 128;
        const float* sc = a.in(I_POOLS) + l * 512 + g * 128;
        const float* pp = a.in(I_POOLP) + ((size_t)l * 512 + g * 128) * 1024 + n;
        float acc[8];
#pragma unroll
        for (int kk = 0; kk < 8; ++kk) acc[kk] = 0.f;
#pragma unroll 2
        for (int d = 0; d < 128; d += 4) {
            float p[4];
#pragma unroll
            for (int q = 0; q < 4; ++q) p[q] = pp[(size_t)(d + q) * 1024] * sc[d + q];
#pragma unroll
            for (int kk = 0; kk < 8; ++kk) { const f32x4 w = *(const f32x4*)(pw + kk * 128 + d); acc[kk] += (w[0] * p[0] + w[1] * p[1]) + (w[2] * p[2] + w[3] * p[3]); }
        }
        *(u32x4*)((bf16_t*)(a.ws + WS_W + (size_t)l * W_LAYER + WO_PROJ) + (size_t)n * 2048 + k0) = pack8(acc);
    }
    bf16_t* XB = (bf16_t*)(a.ws + WS_XB); bf16_t* MEMB = (bf16_t*)(a.ws + WS_MEMB);
    for (int r = gw; r < M_PAD + 2048; r += NGW) {
        if (r < M_PAD) {
            const float* src = r < MP ? a.in(I_XP) + (size_t)r * D : a.in(I_XS) + (size_t)(r - MP) * D;
#pragma unroll
            for (int j = 0; j < 4; ++j) {
                f32x4 v = (f32x4){0.f, 0.f, 0.f, 0.f};
                if (r < M_TOK) v = *(const f32x4*)(src + 256 * j + 4 * lane);
                *(u32x2*)(XB + (size_t)r * D + 256 * j + 4 * lane) = (u32x2){cvt_pk_bf16(v[0], v[1]), cvt_pk_bf16(v[2], v[3])};
            }
        } else {
            const int m = r - M_PAD; const float* src = a.in(I_MEM) + (size_t)m * D;
#pragma unroll
            for (int j = 0; j < 4; ++j) { const f32x4 v = *(const f32x4*)(src + 256 * j + 4 * lane);
                *(u32x2*)(MEMB + (size_t)m * D + 256 * j + 4 * lane) = (u32x2){cvt_pk_bf16(v[0], v[1]), cvt_pk_bf16(v[2], v[3])}; }
        }
    }
}

__device__ __forceinline__ void ln_pass_sample(const float* Ys, bf16_t* XB, const float* g, const float* b, float* out, int G, int cid, const int wv_) {
    int tid_ = MK_TID; asm volatile("" : "+v"(tid_)); const int tid = tid_, lane = tid & 63, wave = __builtin_amdgcn_readfirstlane(tid >> 6);
    const int gw = cid * NWAVES + wave, NGW = G * NWAVES;
    for (int r = gw; r < NSAMP; r += NGW) {
        const float* xr = Ys + (size_t)r * D + 4 * lane;
        f32x4 v[4]; float s = 0.f;
#pragma unroll
        for (int j = 0; j < 4; ++j) { v[j] = *(const f32x4*)(xr + 256 * j); s += (v[j][0] + v[j][1]) + (v[j][2] + v[j][3]); }
        const float mean = wave_sum(s) * (1.f / D); float s2 = 0.f;
#pragma unroll
        for (int j = 0; j < 4; ++j) { v[j] = v[j] - mean; s2 += (v[j][0] * v[j][0] + v[j][1] * v[j][1]) + (v[j][2] * v[j][2] + v[j][3] * v[j][3]); }
        const float rstd = 1.0f / sqrtf(wave_sum(s2) * (1.f / D) + LN_EPS);
#pragma unroll
        for (int j = 0; j < 4; ++j) {
            const f32x4 y = v[j] * rstd * *(const f32x4*)(g + 256 * j + 4 * lane) + *(const f32x4*)(b + 256 * j + 4 * lane);
            *(u32x2*)(XB + (size_t)(MP + r) * D + 256 * j + 4 * lane) = (u32x2){cvt_pk_bf16(y[0], y[1]), cvt_pk_bf16(y[2], y[3])};
            if (out) *(f32x4*)(out + (size_t)(MP + r) * D + 256 * j + 4 * lane) = y;
        }
    }
}

template <bool DO_C>
__device__ __forceinline__ void mix_row_p(const View& a, int l, int r, int lane, const bf16_t* P, bf16_t* MIX, const LAS float* DW, const LAS bf16_t* GLrow) {
    const int ch0 = lane * 8, b = r >> 11, t = r & 2047;
    const bf16_t* Pr = P + (size_t)r * 3072 + ch0; bf16_t* Mr = MIX + (size_t)r * 2048 + ch0; float* out = a.out + ch0;
    {
        const int win = 2 << (lane >> 4);
        float av[8], sacc[8]; ldb8(Pr, av);
#pragma unroll
        for (int c = 0; c < 8; ++c) sacc[c] = av[c];
        u32x4 x[15];
#pragma unroll
        for (int i = 1; i < 16; ++i) { const int dr = i > t ? t : i; x[i - 1] = *(const u32x4*)(Pr - (ptrdiff_t)dr * 3072); }
#pragma unroll
        for (int i = 1; i < 16; ++i) { float f[8]; unpack8(x[i - 1], f); const float mk = (i < win && i <= t) ? 1.f : 0.f;
#pragma unroll
            for (int c = 0; c < 8; ++c) sacc[c] += f[c] * mk; }
        const int cnt = t + 1 < win ? t + 1 : win; const float inv = 1.0f / (float)cnt; float o[8];
#pragma unroll
        for (int c = 0; c < 8; ++c) o[c] = sacc[c] * inv - av[c];
        *(u32x4*)(Mr) = pack8(o);
        if (t >= SEQ - 15) stf8(out + OUT_POOLP + ((size_t)(l * NB + b) * 15 + (t - (SEQ - 15))) * 512, av);
    }
    asm volatile("" ::: "memory");
    if constexpr (DO_C) {
        float cacc[8]; ldf8(a.in(I_CDB) + l * 512 + ch0, cacc);
#pragma unroll
        for (int jb = 0; jb < 31; jb += 8) {
            u32x4 x[8];
#pragma unroll
            for (int u = 0; u < 8; ++u) { const int j = jb + u; if (j < 31) x[u] = *(const LAS u32x4*)(GLrow - (30 - j) * 512 + ch0); }
#pragma unroll
            for (int u = 0; u < 8; ++u) { const int j = jb + u; if (j < 31) {
                float f[8]; unpack8(x[u], f); const float mk = (30 - j <= t) ? 1.f : 0.f;
                const f32x4 w0 = *(const LAS f32x4*)(DW + j * 512 + ch0) * mk, w1 = *(const LAS f32x4*)(DW + j * 512 + ch0 + 4) * mk;
                cacc[0] += f[0] * w0[0]; cacc[1] += f[1] * w0[1]; cacc[2] += f[2] * w0[2]; cacc[3] += f[3] * w0[3];
                cacc[4] += f[4] * w1[0]; cacc[5] += f[5] * w1[1]; cacc[6] += f[6] * w1[2]; cacc[7] += f[7] * w1[3];
            } }
            asm volatile("" ::: "memory");
        }
        float sm = 0.f;
#pragma unroll
        for (int c = 0; c < 8; ++c) sm += cacc[c];
        const float mean = wave_sum(sm) * (1.f / 512.f); float s2 = 0.f;
#pragma unroll
        for (int c = 0; c < 8; ++c) { cacc[c] -= mean; s2 += cacc[c] * cacc[c]; }
        const float rstd = 1.0f / sqrtf(wave_sum(s2) * (1.f / 512.f) + LN_EPS);
        float g[8], bb[8], o[8]; ldf8(a.in(I_CLNG) + l * 512 + ch0, g); ldf8(a.in(I_CLNB) + l * 512 + ch0, bb);
#pragma unroll
        for (int c = 0; c < 8; ++c) { const float y = cacc[c] * rstd * g[c] + bb[c]; o[c] = y * sigm(y); }
        *(u32x4*)(Mr + 1024) = pack8(o);
        if (t >= SEQ - 30) { float gl[8]; ldb8(Pr + 1536, gl); stf8(out + OUT_CONVP + ((size_t)(l * NB + b) * 30 + (t - (SEQ - 30))) * 512, gl); }
    }
    {
        const float* sw = a.in(I_SCW) + (size_t)l * 3 * 512 + ch0;
        float w0[8], w1[8], w2[8], z0[8], z1[8], z2[8], sb[8], o[8];
        ldf8(sw, w0); ldf8(sw + 512, w1); ldf8(sw + 1024, w2);
        const u32x4 xz2 = *(const u32x4*)(Pr + 2560), xsb = *(const u32x4*)(Pr + 2048);
        const u32x4 xz1 = *(const u32x4*)(Pr - (ptrdiff_t)(t >= 1 ? 1 : 0) * 3072 + 2560), xz0 = *(const u32x4*)(Pr - (ptrdiff_t)(t >= 2 ? 2 : 0) * 3072 + 2560);
        unpack8(xz2, z2); unpack8(xsb, sb); unpack8(xz1, z1); unpack8(xz0, z0);
        const float m1 = t >= 1 ? 1.f : 0.f, m0 = t >= 2 ? 1.f : 0.f;
#pragma unroll
        for (int c = 0; c < 8; ++c) o[c] = sb[c] * (w0[c] * z0[c] * m0 + w1[c] * z1[c] * m1 + w2[c] * z2[c]);
        *(u32x4*)(Mr + 1536) = pack8(o);
        if (t >= SEQ - 2) stf8(out + OUT_SCP + ((size_t)(l * NB + b) * 2 + (t - (SEQ - 2))) * 512, z2);
    }
}

__device__ __forceinline__ void conv4_lds(const View& a, int l, int r0, int lane, bf16_t* MIX, const LAS float* DW, const LAS bf16_t* GLw) {
    const int ch0 = lane * 8;
    float cacc[4][8];
    { float db[8]; ldf8(a.in(I_CDB) + l * 512 + ch0, db);
#pragma unroll
      for (int i = 0; i < 4; ++i)
#pragma unroll
          for (int c = 0; c < 8; ++c) cacc[i][c] = db[c]; }
    float wv[4][8];
#pragma unroll
    for (int q = 0; q < 34; ++q) {
        if (q <= 30) { const f32x4 w0 = *(const LAS f32x4*)(DW + q * 512 + ch0), w1 = *(const LAS f32x4*)(DW + q * 512 + ch0 + 4);
            wv[q & 3][0] = w0[0]; wv[q & 3][1] = w0[1]; wv[q & 3][2] = w0[2]; wv[q & 3][3] = w0[3]; wv[q & 3][4] = w1[0]; wv[q & 3][5] = w1[1]; wv[q & 3][6] = w1[2]; wv[q & 3][7] = w1[3]; }
        float f[8]; unpack8(*(const LAS u32x4*)(GLw + q * 512 + ch0), f);
#pragma unroll
        for (int i = 0; i < 4; ++i) { const int j = q - i; if (j >= 0 && j <= 30) {
#pragma unroll
                for (int c = 0; c < 8; ++c) cacc[i][c] += f[c] * wv[j & 3][c]; } }
    }
    float g[8], bb[8]; ldf8(a.in(I_CLNG) + l * 512 + ch0, g); ldf8(a.in(I_CLNB) + l * 512 + ch0, bb);
#pragma unroll
    for (int i = 0; i < 4; ++i) {
        float sm = 0.f;
#pragma unroll
        for (int c = 0; c < 8; ++c) sm += cacc[i][c];
        const float mean = wave_sum(sm) * (1.f / 512.f); float s2 = 0.f;
#pragma unroll
        for (int c = 0; c < 8; ++c) { cacc[i][c] -= mean; s2 += cacc[i][c] * cacc[i][c]; }
        const float rstd = 1.0f / sqrtf(wave_sum(s2) * (1.f / 512.f) + LN_EPS); float o[8];
#pragma unroll
        for (int c = 0; c < 8; ++c) { const float y = cacc[i][c] * rstd * g[c] + bb[c]; o[c] = y * sigm(y); }
        *(u32x4*)(MIX + (size_t)(r0 + i) * 2048 + 1024 + ch0) = pack8(o);
    }
    const int t0 = r0 & 2047, b = r0 >> 11;
    if (t0 + 3 >= SEQ - 30) {
        for (int i = 0; i < 4; ++i) { const int t = t0 + i; if (t >= SEQ - 30) { float f[8]; unpack8(*(const LAS u32x4*)(GLw + (30 + i) * 512 + ch0), f);
            stf8(a.out + OUT_CONVP + ((size_t)(l * NB + b) * 30 + (t - (SEQ - 30))) * 512 + ch0, f); } }
    }
}

__device__ __forceinline__ void mix_row_s(const View& a, int l, int bs, int lane, const bf16_t* P, bf16_t* MIX, const LAS float* DW) {
    const int ch0 = lane * 8, r = MP + bs;
    const bf16_t* Pr = P + (size_t)r * 3072 + ch0; bf16_t* Mr = MIX + (size_t)r * 2048 + ch0; float* out = a.out + ch0;
    {
        const int win = 2 << (lane >> 4);
        const float* sp = a.in(I_SPOOL) + ((size_t)(l * NSAMP + bs) * 15) * 512 + ch0;
        float* dp = out + OUT_POOLS + ((size_t)(l * NSAMP + bs) * 15) * 512;
        float av[8], sacc[8]; ldb8(Pr, av);
#pragma unroll
        for (int c = 0; c < 8; ++c) sacc[c] = av[c];
        f32x4 x0[15], x1[15];
#pragma unroll
        for (int i = 0; i < 15; ++i) { x0[i] = *(const f32x4*)(sp + i * 512); x1[i] = *(const f32x4*)(sp + i * 512 + 4); }
#pragma unroll
        for (int i = 0; i < 15; ++i) { const float mk = (15 - i < win) ? 1.f : 0.f;
            sacc[0] += x0[i][0] * mk; sacc[1] += x0[i][1] * mk; sacc[2] += x0[i][2] * mk; sacc[3] += x0[i][3] * mk; sacc[4] += x1[i][0] * mk; sacc[5] += x1[i][1] * mk; sacc[6] += x1[i][2] * mk; sacc[7] += x1[i][3] * mk;
            if (i >= 1) { *(f32x4*)(dp + (i - 1) * 512) = x0[i]; *(f32x4*)(dp + (i - 1) * 512 + 4) = x1[i]; } }
        stf8(dp + 14 * 512, av);
        const float inv = 1.0f / (float)win; float o[8];
#pragma unroll
        for (int c = 0; c < 8; ++c) o[c] = sacc[c] * inv - av[c];
        *(u32x4*)(Mr) = pack8(o);
    }
    asm volatile("" ::: "memory");
    {
        float cacc[8]; ldf8(a.in(I_CDB) + l * 512 + ch0, cacc);
        const float* sp = a.in(I_SCONV) + ((size_t)(l * NSAMP + bs) * 30) * 512 + ch0;
        float* dp = out + OUT_CONVS + ((size_t)(l * NSAMP + bs) * 30) * 512;
#pragma unroll
        for (int jb = 0; jb < 30; jb += 10) {
            f32x4 x0[10], x1[10];
#pragma unroll
            for (int u = 0; u < 10; ++u) { x0[u] = *(const f32x4*)(sp + (jb + u) * 512); x1[u] = *(const f32x4*)(sp + (jb + u) * 512 + 4); }
#pragma unroll
            for (int u = 0; u < 10; ++u) { const int j = jb + u;
                const f32x4 w0 = *(const LAS f32x4*)(DW + j * 512 + ch0), w1 = *(const LAS f32x4*)(DW + j * 512 + ch0 + 4);
                cacc[0] += x0[u][0] * w0[0]; cacc[1] += x0[u][1] * w0[1]; cacc[2] += x0[u][2] * w0[2]; cacc[3] += x0[u][3] * w0[3];
                cacc[4] += x1[u][0] * w1[0]; cacc[5] += x1[u][1] * w1[1]; cacc[6] += x1[u][2] * w1[2]; cacc[7] += x1[u][3] * w1[3];
                if (j >= 1) { *(f32x4*)(dp + (j - 1) * 512) = x0[u]; *(f32x4*)(dp + (j - 1) * 512 + 4) = x1[u]; } }
            asm volatile("" ::: "memory");
        }
        { float gl[8]; ldb8(Pr + 1536, gl);
          const f32x4 w0 = *(const LAS f32x4*)(DW + 30 * 512 + ch0), w1 = *(const LAS f32x4*)(DW + 30 * 512 + ch0 + 4);
          cacc[0] += gl[0] * w0[0]; cacc[1] += gl[1] * w0[1]; cacc[2] += gl[2] * w0[2]; cacc[3] += gl[3] * w0[3]; cacc[4] += gl[4] * w1[0]; cacc[5] += gl[5] * w1[1]; cacc[6] += gl[6] * w1[2]; cacc[7] += gl[7] * w1[3];
          stf8(dp + 29 * 512, gl); }
        float sm = 0.f;
#pragma unroll
        for (int c = 0; c < 8; ++c) sm += cacc[c];
        const float mean = wave_sum(sm) * (1.f / 512.f); float s2 = 0.f;
#pragma unroll
        for (int c = 0; c < 8; ++c) { cacc[c] -= mean; s2 += cacc[c] * cacc[c]; }
        const float rstd = 1.0f / sqrtf(wave_sum(s2) * (1.f / 512.f) + LN_EPS);
        float g[8], bb[8], o[8]; ldf8(a.in(I_CLNG) + l * 512 + ch0, g); ldf8(a.in(I_CLNB) + l * 512 + ch0, bb);
#pragma unroll
        for (int c = 0; c < 8; ++c) { const float y = cacc[c] * rstd * g[c] + bb[c]; o[c] = y * sigm(y); }
        *(u32x4*)(Mr + 1024) = pack8(o);
    }
    {
        const float* sw = a.in(I_SCW) + (size_t)l * 3 * 512 + ch0;
        float w0[8], w1[8], w2[8], z0[8], z1[8], z2[8], sb[8], o[8];
        ldf8(sw, w0); ldf8(sw + 512, w1); ldf8(sw + 1024, w2);
        ldb8(Pr + 2560, z2); ldb8(Pr + 2048, sb);
        const float* sp = a.in(I_SSC) + ((size_t)(l * NSAMP + bs) * 2) * 512 + ch0;
        float* dp = out + OUT_SCS + ((size_t)(l * NSAMP + bs) * 2) * 512;
        ldf8(sp, z0); ldf8(sp + 512, z1);
        stf8(dp, z1); stf8(dp + 512, z2);
#pragma unroll
        for (int c = 0; c < 8; ++c) o[c] = sb[c] * (w0[c] * z0[c] + w1[c] * z1[c] + w2[c] * z2[c]);
        *(u32x4*)(Mr + 1536) = pack8(o);
    }
    {
        float v[8]; ldb8(Pr + 1024, v);
        float sm = 0.f;
#pragma unroll
        for (int c = 0; c < 8; ++c) sm += v[c];
        const float mean = wave_sum(sm) * (1.f / 512.f); float s2 = 0.f;
#pragma unroll
        for (int c = 0; c < 8; ++c) { v[c] -= mean; s2 += v[c] * v[c]; }
        const float rstd = 1.0f / sqrtf(wave_sum(s2) * (1.f / 512.f) + LN_EPS);
        float g[8], bb[8], u[8], o[8]; ldf8(a.in(I_GLNG) + l * 512 + ch0, g); ldf8(a.in(I_GLNB) + l * 512 + ch0, bb); ldb8(Pr + 512, u);
        const int h = lane >> 4;
        const float w00 = a.in(I_GWS)[((size_t)(l * 4 + h) * 128) * 128], b0 = a.in(I_GB)[(l * 4 + h) * 128];
#pragma unroll
        for (int c = 0; c < 8; ++c) { v[c] = v[c] * rstd * g[c] + bb[c]; o[c] = u[c] * (w00 * v[c] + b0); }
        stf8(out + OUT_GV + (size_t)(l * NSAMP + bs) * 512, v);
        *(u32x4*)(Mr + 512) = pack8(o);
    }
}

__device__ __forceinline__ void sgu_unit(const View& a, int l, int un, unsigned char* lds_g, const bf16_t* P, bf16_t* MIX, const int wv_) {
    int tid_ = MK_TID; asm volatile("" : "+v"(tid_)); const int tid = tid_, lane = tid & 63, wave = __builtin_amdgcn_readfirstlane(tid >> 6);
    const int ck = un >> 1, h0 = (un & 1) * 2; const int r0 = ck * 128;
    LAS bf16_t* V = (LAS bf16_t*)lds_g;
    {
        float g[8], bb[8]; ldf8(a.in(I_GLNG) + l * 512 + lane * 8, g); ldf8(a.in(I_GLNB) + l * 512 + lane * 8, bb);
        u32x4 vr[16];
#pragma unroll
        for (int i = 0; i < 16; ++i) vr[i] = *(const u32x4*)(P + (size_t)(r0 + wave * 16 + i) * 3072 + 1024 + lane * 8);
#pragma unroll
        for (int i = 0; i < 16; ++i) {
            const int s_ = wave * 16 + i;
            float v[8]; unpack8(vr[i], v);
            float s = 0.f;
#pragma unroll
            for (int q = 0; q < 8; ++q) s += v[q];
            const float mean = wave_sum(s) * (1.f / 512.f); float s2 = 0.f;
#pragma unroll
            for (int q = 0; q < 8; ++q) { v[q] -= mean; s2 += v[q] * v[q]; }
            const float rstd = 1.0f / sqrtf(wave_sum(s2) * (1.f / 512.f) + LN_EPS);
            if ((lane >> 5) == (h0 >> 1)) {
                LAS unsigned* dst = (LAS unsigned*)(V + ((lane >> 4) & 1) * (128 * 130) + s_ * 130 + (lane & 15) * 8);
#pragma unroll
                for (int q = 0; q < 4; ++q) dst[q] = cvt_pk_bf16(v[2 * q] * rstd * g[2 * q] + bb[2 * q], v[2 * q + 1] * rstd * g[2 * q + 1] + bb[2 * q + 1]);
            }
        }
    }
    __syncthreads();
    for (int hh = 0; hh < 2; ++hh) {
        const int h = h0 + hh; const LAS bf16_t* Vh = V + hh * (128 * 130);
        const int t0 = wave * 16, nk = (t0 + 16 + 31) >> 5, fr = lane & 15, fq = lane >> 4;
        const int t = t0 + fr;
        const float* Wrow = a.in(I_GWS) + ((size_t)(l * 4 + h) * 128 + t) * 128;
        f32x4 acc[8];
#pragma unroll
        for (int n = 0; n < 8; ++n) acc[n] = (f32x4){0.f, 0.f, 0.f, 0.f};
        for (int kk = 0; kk < nk; ++kk) {
            const int s0 = kk * 32 + fq * 8;
            float w[8]; ldf8(Wrow + s0, w);
#pragma unroll
            for (int q = 0; q < 8; ++q) if (s0 + q > t) w[q] = 0.f;
            const u32x4 wp = pack8(w);
            const bf16x8 wf = __builtin_bit_cast(bf16x8, wp);
#pragma unroll
            for (int n = 0; n < 8; ++n) {
                bf16x8 vf;
#pragma unroll
                for (int q = 0; q < 8; ++q) vf[q] = (short)Vh[(s0 + q) * 130 + n * 16 + fr];
                acc[n] = __builtin_amdgcn_mfma_f32_16x16x32_bf16(vf, wf, acc[n], 0, 0, 0);
            }
        }
        const float bias = a.in(I_GB)[(l * 4 + h) * 128 + t];
        const bf16_t* up = P + (size_t)(r0 + t) * 3072 + 512 + h * 128 + fq * 4;
        bf16_t* op = MIX + (size_t)(r0 + t) * 2048 + 512 + h * 128 + fq * 4;
        u32x2 uall[8];
#pragma unroll
        for (int n = 0; n < 8; ++n) uall[n] = *(const u32x2*)(up + n * 16);
#pragma unroll
        for (int n = 0; n < 8; ++n) {
            const u32x2 uu = uall[n];
            const f32x4 u4 = pg8::bflo(uu.x, uu.y);
            const f32x4 z = (acc[n] + bias) * u4;
            *(u32x2*)(op + n * 16) = (u32x2){cvt_pk_bf16(z[0], z[1]), cvt_pk_bf16(z[2], z[3])};
        }
    }
    __syncthreads();
}

__device__ __forceinline__ void samp_attn_unit(const View& a, int l, int un, unsigned char* lds_g, const bf16_t* Q, bf16_t* O, const int wv_) {
    int tid_ = MK_TID; asm volatile("" : "+v"(tid_)); const int tid = tid_, lane = tid & 63, wave = __builtin_amdgcn_readfirstlane(tid >> 6);
    const int b = un >> 2, h = un & 3;
    LAS float* S = (LAS float*)lds_g;
    LAS float* Pl = S + 256;
    LAS float* RED = S + 512;
    const size_t base = (((size_t)(l * NSAMP + b) * NMEM) * 4 + h) * 256;
    const float* Kp = a.in(I_CK) + base + 4 * lane; const float* Vp = a.in(I_CV) + base + 4 * lane;
    const u32x2 qq = *(const u32x2*)(Q + (size_t)(MP + b) * D + h * 256 + 4 * lane);
    const f32x4 q4 = pg8::bflo(qq.x, qq.y);
    for (int mm = 0; mm < 32; mm += 8) {
        f32x4 k[8];
#pragma unroll
        for (int i = 0; i < 8; ++i) k[i] = *(const f32x4*)(Kp + (size_t)(wave * 32 + mm + i) * 1024);
#pragma unroll
        for (int i = 0; i < 8; ++i) { float d = (q4[0] * k[i][0] + q4[1] * k[i][1]) + (q4[2] * k[i][2] + q4[3] * k[i][3]); d = wave_sum(d); if (lane == 0) S[wave * 32 + mm + i] = d; }
    }
    __syncthreads();
    {
        const float s0 = S[lane], s1 = S[64 + lane], s2 = S[128 + lane], s3 = S[192 + lane];
        const float mx = wave_max(fmaxf(fmaxf(s0, s1), fmaxf(s2, s3)));
        const float e0 = __expf(s0 - mx), e1 = __expf(s1 - mx), e2 = __expf(s2 - mx), e3 = __expf(s3 - mx);
        const float inv = 1.0f / wave_sum((e0 + e1) + (e2 + e3));
        if (wave == 0) { Pl[lane] = e0 * inv; Pl[64 + lane] = e1 * inv; Pl[128 + lane] = e2 * inv; Pl[192 + lane] = e3 * inv; }
    }
    __syncthreads();
    {
        f32x4 o = (f32x4){0.f, 0.f, 0.f, 0.f};
        for (int mm = 0; mm < 32; mm += 8) {
            f32x4 v[8];
#pragma unroll
            for (int i = 0; i < 8; ++i) v[i] = *(const f32x4*)(Vp + (size_t)(wave * 32 + mm + i) * 1024);
#pragma unroll
            for (int i = 0; i < 8; ++i) o += v[i] * Pl[wave * 32 + mm + i];
        }
        *(LAS f32x4*)(RED + wave * 256 + 4 * lane) = o;
    }
    __syncthreads();
    if (tid < 256) {
        float s = 0.f;
#pragma unroll
        for (int w = 0; w < 8; ++w) s += RED[w * 256 + tid];
        const float other = __shfl_xor(s, 1);
        if ((tid & 1) == 0) *(unsigned*)(O + (size_t)(MP + b) * D + h * 256 + tid) = cvt_pk_bf16(s, other);
    }
    __syncthreads();
}

template <int MODE>
__device__ __forceinline__ void skinny_gemm(unsigned char* lds_g, const bf16_t* A, int lda, const bf16_t* Bt, int ldb, int Kq, float* X, bf16_t* O, const bf16_t* GATE, float alpha, float sc, int G, int cid, const int wv_) {
    int tid_ = MK_TID; asm volatile("" : "+v"(tid_)); const int tid = tid_, lane = tid & 63, wave = __builtin_amdgcn_readfirstlane(tid >> 6);
    const int rg = wave & 1, kq = wave >> 1, fr = lane & 15, fq = lane >> 4, nIt = Kq >> 5;
    LAS f32x4* RED = (LAS f32x4*)lds_g;
    for (int j = cid; j < 256; j += G) {
        const int rb = j & 3, cb = j >> 2;
        const bf16_t* ap = A + (size_t)(MP + rb * 32 + rg * 16 + fr) * lda + kq * Kq + fq * 8;
        const bf16_t* bp = Bt + (size_t)(cb * 16 + fr) * ldb + kq * Kq + fq * 8;
        f32x4 acc = (f32x4){0.f, 0.f, 0.f, 0.f};
        for (int k = 0; k < nIt; k += 4) {
            bf16x8 a[4], b[4];
#pragma unroll
            for (int u = 0; u < 4; ++u) {
                if (k + u < nIt) { a[u] = *(const bf16x8*)(ap + (k + u) * 32); b[u] = *(const bf16x8*)(bp + (k + u) * 32); }
                else { a[u] = (bf16x8){0, 0, 0, 0, 0, 0, 0, 0}; b[u] = a[u]; }
            }
#pragma unroll
            for (int u = 0; u < 4; ++u) acc = __builtin_amdgcn_mfma_f32_16x16x32_bf16(b[u], a[u], acc, 0, 0, 0);
        }
        RED[(kq * 2 + rg) * 64 + lane] = acc;
        __syncthreads();
        if (kq == 0) {
            const int orow = MP + rb * 32 + rg * 16 + fr, ocol = cb * 16 + 4 * fq;
            f32x4 v;
            if (MODE == 2) {
                v = (f32x4){0.f, 0.f, 0.f, 0.f};
#pragma unroll
                for (int q = 0; q < 4; ++q) { const u32x2 gq = *(const u32x2*)(GATE + (size_t)orow * 4096 + q * 1024 + ocol); v += RED[(q * 2 + rg) * 64 + lane] * pg8::bflo(gq.x, gq.y); }
            } else {
                v = (RED[(0 * 2 + rg) * 64 + lane] + RED[(1 * 2 + rg) * 64 + lane]) + (RED[(2 * 2 + rg) * 64 + lane] + RED[(3 * 2 + rg) * 64 + lane]);
            }
            if (MODE == 0) { const u32x2 xr = *(const u32x2*)(O + (size_t)orow * 1024 + ocol); *(f32x4*)(X + (size_t)(orow - MP) * 1024 + ocol) = pg8::bflo(xr.x, xr.y) * alpha + v * sc; }
            else { *(u32x2*)(O + (size_t)orow * 1024 + ocol) = (u32x2){cvt_pk_bf16(v[0] * sc, v[1] * sc), cvt_pk_bf16(v[2] * sc, v[3] * sc)}; }
        }
        __syncthreads();
    }
}

#define XB_TMO      128
#define XB_XCNT(j)  (256  + 64 * (j))
#define XB_XSUB(j)  (1280 + 64 * (j))
#define XB_XGEN(j)  (2304 + 64 * (j))
#define XB_TOP      3328
#define XB_TOPGEN   3392
#define XCD_BAR_WORDS 3456
#define XB_SPIN_CAP (1u << 18)

__device__ __forceinline__ unsigned xb_ld(unsigned* p)              { return __hip_atomic_load(p, __ATOMIC_RELAXED, __HIP_MEMORY_SCOPE_AGENT); }
__device__ __forceinline__ unsigned xb_add(unsigned* p, unsigned v) { return __hip_atomic_fetch_add(p, v, __ATOMIC_RELAXED, __HIP_MEMORY_SCOPE_AGENT); }
__device__ __forceinline__ unsigned xb_xcc_id() { return (unsigned)__builtin_amdgcn_s_getreg((3 << 11) | 20) & 0xFu; }
#define XB_SPIN(cond, bar) do { unsigned _sp = 0; while (cond) { __builtin_amdgcn_s_sleep(1); \
    if ((++_sp & 255u) == 0u) { if (xb_ld(&(bar)[XB_TMO])) break; if (_sp > XB_SPIN_CAP) { atomicAdd(&(bar)[XB_TMO], 1u); break; } } } } while (0)

struct XcdBarrier {
    unsigned* bar; unsigned x;
    volatile LAS unsigned* st;
};

__device__ __forceinline__ XcdBarrier xcd_barrier_post(unsigned* bar, volatile LAS unsigned* st) {
    XcdBarrier b; b.bar = bar; b.x = xb_xcc_id(); b.st = st;
    if (threadIdx.x == 0) (void)xb_add(&bar[XB_XCNT(b.x)], 1u);
    return b;
}
__device__ __forceinline__ void xcd_barrier_complete(unsigned* bar, unsigned x, unsigned& nloc, unsigned& nx) {
    const unsigned G = gridDim.x * gridDim.y * gridDim.z;
    unsigned sum, cnt, mine, sp = 0u;
    for (;;) {
        sum = 0u; cnt = 0u; mine = 0u;
#pragma unroll
        for (unsigned j = 0; j < 16; ++j) { const unsigned c = xb_ld(&bar[XB_XCNT(j)]); sum += c; cnt += (c > 0u) ? 1u : 0u; mine = (j == x) ? c : mine; }
        if (sum == G) break;
        __builtin_amdgcn_s_sleep(1);
        if ((++sp & 255u) == 0u) { if (xb_ld(&bar[XB_TMO])) break; if (sp > XB_SPIN_CAP) { atomicAdd(&bar[XB_TMO], 1u); break; } }
    }
    nloc = mine > 0u ? mine : 1u; nx = cnt > 0u ? cnt : 1u;
}

__device__ __forceinline__ void xcd_barrier(const XcdBarrier& b) {
    asm volatile("s_waitcnt vmcnt(0)" ::: "memory");
    __syncthreads();
    if (threadIdx.x == 0) {
        unsigned* bar = b.bar;
        __builtin_amdgcn_s_waitcnt(0);
        unsigned nloc = b.st[0], nx = b.st[1];
        if (nloc == 0u) { xcd_barrier_complete(bar, b.x, nloc, nx); b.st[0] = nloc; b.st[1] = nx; }
        const unsigned old = xb_add(&bar[XB_XSUB(b.x)], 1u);
        const unsigned gen = old / nloc;
        if (old + 1u == (gen + 1u) * nloc) {
            __builtin_amdgcn_fence(__ATOMIC_RELEASE, "agent");
            asm volatile("s_waitcnt vmcnt(0)" ::: "memory");
            const unsigned og = xb_add(&bar[XB_TOP], 1u);
            const unsigned tg = og / nx;
            if (og + 1u == (tg + 1u) * nx) xb_add(&bar[XB_TOPGEN], 1u);
            else XB_SPIN(xb_ld(&bar[XB_TOPGEN]) == tg, bar);
            __builtin_amdgcn_fence(__ATOMIC_ACQUIRE, "agent");
            xb_add(&bar[XB_XGEN(b.x)], 1u);
            asm volatile("s_waitcnt vmcnt(0)" ::: "memory");
        } else {
            XB_SPIN(xb_ld(&bar[XB_XGEN(b.x)]) == gen, bar);
            __builtin_amdgcn_fence(__ATOMIC_ACQUIRE, "agent");
            asm volatile("s_waitcnt vmcnt(0)" ::: "memory");
        }
    }
    __syncthreads();
}


constexpr int N_PHASES = 3 + 32;

template <int PH>
__device__ __forceinline__ void run_phase(const Args& args, unsigned char* lds, const int wv_) {
    constexpr int ph = PH, l = PH >= 3 ? (PH - 3) >> 4 : 0, s = PH >= 3 ? (PH - 3) & 15 : -1;
    PG8_LAS unsigned char* L = (PG8_LAS unsigned char*)lds;
        int z0 = 0; asm volatile("s_mov_b32 %0, 0" : "=s"(z0));
        unsigned char* ws = args.ws + z0;
        int tid_ = MK_TID; asm volatile("" : "+v"(tid_)); const int tid = tid_, lane = tid & 63, wave = __builtin_amdgcn_readfirstlane(tid >> 6);
        const View vw{&args, z0, ws, args.out + z0};
        const int G = (int)gridDim.x + z0, cid = (int)blockIdx.x + z0;
        bf16_t* XB = (bf16_t*)(ws + WS_XB); float* XF = (float*)(ws + WS_XF);
        bf16_t* GATE = (bf16_t*)(ws + WS_R1); bf16_t* HB = (bf16_t*)(ws + WS_R1);
        bf16_t* PB = (bf16_t*)(ws + WS_R2); bf16_t* QB = (bf16_t*)(ws + WS_R2); bf16_t* PRB = QB + (size_t)M_PAD * D; bf16_t* OB = PRB + (size_t)M_PAD * D;
        bf16_t* MIX = (bf16_t*)(ws + WS_MIX); bf16_t* MRG = (bf16_t*)(ws + WS_MRG); bf16_t* MEMB = (bf16_t*)(ws + WS_MEMB);

        const unsigned char* WL = ws + WS_W + (size_t)l * W_LAYER;
        if constexpr (ph == 0) {
#ifndef SK0
            prologue(vw, lds, G, cid, wv_);
#endif
        }
        if constexpr (s == 8 || s == 10) {
            constexpr int nj = 1;
            for (int j = 0; j < nj; ++j) {
                pg8::Gemm g; pg8::Sched S; pg8::EpiStore E;
                if constexpr (s == 8) {
                    g = pg8::Gemm{XB, (const bf16_t*)(WL + WO_WQ), 1024, 1024, 1024};
                    S.init(MP / 256, 4, 1, G, cid); S.a_pm = (size_t)256 * 1024 * 2; S.b_pn = (size_t)256 * 1024 * 2;
                    E = pg8::EpiStore{QB, 1024, 0.0625f};
                    skinny_gemm<1>(lds, XB, 1024, (const bf16_t*)(WL + WO_WQ), 1024, 256, nullptr, QB, nullptr, 0.f, 0.0625f, G, cid, wv_);
                } else {
                    g = pg8::Gemm{PRB, (const bf16_t*)(ws + WS_VT) + (size_t)l * 1024 * 2048, 1024, 2048, 256};
                    S.init(MP / 256, 4, 1, G, cid); S.a_pm = (size_t)256 * 1024 * 2; S.a_pn = 256 * 2; S.b_pn = (size_t)256 * 2048 * 2; S.b_b = 256 * 2;
                    E = pg8::EpiStore{OB, 1024, 1.0f};
                }
#ifndef SK2
                pg8::gemm_phase<pg8::EpiStore>(L, g, S, E, wv_);
#endif
            }
            if constexpr (s == 10) {
                __syncthreads();
                for (int un = 256 + cid; un < 512; un += G) samp_attn_unit(vw, l, un, lds, QB, OB, wv_);
            }
        } else if constexpr (s == 0 || s == 13) {
            pg8::Gemm g{XB, (const bf16_t*)(WL + (s == 0 ? WO_UP1 : WO_UP2)), 1024, 1024, 1024};
            pg8::Sched S; S.init(M_PAD / 256, 22, 1, G, cid); S.a_pm = (size_t)256 * 1024 * 2; S.b_pn = (size_t)256 * 1024 * 2;
            pg8::EpiUp E{HB, FF};
#ifndef SK3
            pg8::gemm_phase<pg8::EpiUp>(L, g, S, E, wv_);
#endif
            if constexpr (s == 0) {
                constexpr int c0 = (M_PAD / 256) * 22 % 256;
                {
                    pg8::Gemm g2{MEMB, (const bf16_t*)(WL + WO_KV), 1024, 1024, 1024};
                    pg8::Sched S2; S2.init(8, 8, 1, G, (cid + G - c0 % G) % G); S2.a_pm = (size_t)256 * 1024 * 2; S2.b_pn = (size_t)256 * 1024 * 2;
                    pg8::EpiKV E2{vw.out + OUT_MK + (size_t)l * 2048 * 1024, vw.out + OUT_MV + (size_t)l * 2048 * 1024, (bf16_t*)(ws + WS_KB) + (size_t)l * 2048 * 1024};
                    pg8::gemm_phase<pg8::EpiKV>(L, g2, S2, E2, wv_);
                }
                {
                    pg8::Gemm g3{(const bf16_t*)(WL + WO_KV) + (size_t)1024 * 1024, MEMB, 1024, 1024, 1024};
                    pg8::Sched S3; S3.init(4, 8, 1, G, (cid + G - (c0 + 64) % G) % G); S3.a_pm = (size_t)256 * 1024 * 2; S3.b_pn = (size_t)256 * 1024 * 2;
                    pg8::EpiStore E3{(bf16_t*)(ws + WS_VT) + (size_t)l * 1024 * 2048, 2048, 1.0f};
                    pg8::gemm_phase<pg8::EpiStore>(L, g3, S3, E3, wv_);
                }
            }
        } else if constexpr (s == 1 || s == 14 || s == 6 || s == 11) {
            pg8::Gemm g; float sc;
            if constexpr (s == 1 || s == 14) { g = pg8::Gemm{HB, (const bf16_t*)(WL + (s == 1 ? WO_DN1 : WO_DN2)), FF, FF, FF}; sc = 0.5f; }
            else if constexpr (s == 6) { g = pg8::Gemm{MRG, (const bf16_t*)(WL + WO_WO), 1024, 1024, 1024}; sc = 1.0f; }
            else { g = pg8::Gemm{OB, (const bf16_t*)(WL + WO_AO), 1024, 1024, 1024}; sc = 1.0f; }
            pg8::Sched S; S.init(MP / 256, 4, 1, G, cid); S.a_pm = (size_t)256 * g.lda * 2; S.b_pn = (size_t)256 * g.ldb * 2;
            constexpr int which = s == 1 ? 0 : s == 6 ? 1 : s == 11 ? 2 : 3;
            constexpr int gi = which == 0 ? I_LN1G : which == 1 ? I_LN2G : which == 2 ? I_LN3G : I_LN4G;
            constexpr size_t bank_off = WS_CTL + 16384 + (size_t)(l * 4 + which) * 16384;
            typedef pg8::EpiResidLN<(which == 0 || which == 3) ? 1 : 0> EpiT;
            EpiT E{XB, vw.in(gi) + l * D, vw.in(gi + 1) + l * D, (which == 3 && l == 1) ? vw.out + OUT_Y : nullptr, ws + bank_off, (long)WS_XBUF - (long)bank_off};
            skinny_gemm<0>(lds, g.A, g.lda, g.Bt, g.ldb, g.K / 4, XF, XB, nullptr, DN_ALPHA, sc, G, cid, wv_);
#ifndef SK4
            pg8::gemm_phase<EpiT>(L, g, S, E, wv_);
#endif
        } else if constexpr (s == 2 || s == 7 || s == 12 || s == 15) {
            constexpr int gi = s == 2 ? I_LN1G : s == 7 ? I_LN2G : s == 12 ? I_LN3G : I_LN4G;
#ifndef SK5
            ln_pass_sample(XF, XB, vw.in(gi) + l * D, vw.in(gi + 1) + l * D, (s == 15 && l == 1) ? vw.out + OUT_Y : nullptr, G, cid, wv_);
#endif
        } else if constexpr (s == 3) {
            pg8::Gemm g{XB, (const bf16_t*)(WL + WO_IN), 1024, 1024, 1024};
            pg8::Sched S; S.init(M_PAD / 256, 32, 1, G, cid); S.a_pm = (size_t)256 * 1024 * 2; S.b_pn = (size_t)256 * 1024 * 2;
            pg8::EpiIn E{PB, GATE, vw.in(I_BGATE) + l * 4096};
#ifndef SK6
            pg8::gemm_phase<pg8::EpiIn>(L, g, S, E, wv_);
#endif
        } else if constexpr (s == 4) {
#ifndef SK7
            for (int un = cid; un < 256; un += G) sgu_unit(vw, l, un, lds, PB, MIX, wv_);
#endif
#ifndef SK8
            if ((MP % (G * 64)) == 0 || true) {
                __syncthreads();
                LAS float* DW = (LAS float*)((LAS unsigned char*)lds + 65536);
                LAS bf16_t* GL = (LAS bf16_t*)lds;
                const float* dwg = vw.in(I_CDW) + (size_t)l * 31 * 512;
                { f32x4 tw[8];
#pragma unroll
                  for (int u = 0; u < 8; ++u) { const int e = tid + u * NT; tw[u] = *(const f32x4*)(dwg + 4 * (e < 31 * 512 / 4 ? e : 0)); }
#pragma unroll
                  for (int u = 0; u < 8; ++u) { const int e = tid + u * NT; if (e < 31 * 512 / 4) ((LAS f32x4*)DW)[e] = tw[u]; } }
                __syncthreads();
                { const int gw = cid * NWAVES + wave; if ((gw & 15) == 5 && (gw >> 4) < NSAMP) mix_row_s(vw, l, gw >> 4, lane, PB, MIX, DW); }
                const int per = MP / G;
                for (int p0 = 0; p0 < per; p0 += 32) {
                    const int T0 = cid * per + p0, tseq = T0 & 2047;
                    __syncthreads();
                    {
                        u32x4 tw[8]; int t3 = tid; asm volatile("" : "+v"(t3));
#pragma unroll
                        for (int u = 0; u < 8; ++u) { const int e = t3 + u * NT, row = e >> 6, c16 = e & 63; tw[u] = (u32x4){0u, 0u, 0u, 0u};
                            if (e < 62 * 64 && tseq - 30 + row >= 0) tw[u] = *(const u32x4*)(PB + (size_t)(T0 - 30 + row) * 3072 + 1536 + c16 * 8); }
#pragma unroll
                        for (int u = 0; u < 8; ++u) { const int e = t3 + u * NT; if (e < 62 * 64) ((LAS u32x4*)GL)[e] = tw[u]; }
                    }
                    __syncthreads();
                    conv4_lds(vw, l, T0 + wave * 4, lane, MIX, DW, GL + (wave * 4) * 512);
                    { int tb = T0 + wave * 4; asm volatile("" : "+s"(tb));
#pragma nounroll
                      for (int i = 0; i < 4; ++i) mix_row_p<false>(vw, l, tb + i, lane, PB, MIX, DW, GL); }
                }
            }
#endif
        } else if constexpr (s == 5) {
            pg8::Gemm g{MIX, (const bf16_t*)(WL + WO_PROJ), 2048, 2048, 512};
            pg8::Sched S; S.init(MP / 256, 4, 4, G, cid); S.a_pm = (size_t)256 * 2048 * 2; S.b_pn = (size_t)256 * 2048 * 2; S.a_sub = 512 * 2; S.b_sub = 512 * 2;
            pg8::EpiBranch E{GATE, MRG};
            skinny_gemm<2>(lds, MIX, 2048, (const bf16_t*)(WL + WO_PROJ), 2048, 512, nullptr, MRG, GATE, 0.f, 1.0f, G, cid, wv_);
#ifndef SK9
            pg8::gemm_phase<pg8::EpiBranch>(L, g, S, E, wv_);
#endif
        } else if constexpr (s == 9) {
            pg8::Gemm g{QB, (const bf16_t*)(ws + WS_KB) + (size_t)l * 2048 * 1024, 1024, 1024, 256};
            pg8::Sched S; S.init(MP / 256, 4, 1, G, cid); S.a_pm = (size_t)256 * 1024 * 2; S.a_pn = 256 * 2; S.b_pn = 256 * 2; S.b_b = (size_t)256 * 1024 * 2;
            pg8::EpiSoftmax E{PRB};
#ifndef SK10
            pg8::gemm_phase<pg8::EpiSoftmax>(L, g, S, E, wv_);
#endif
            asm volatile("s_waitcnt vmcnt(0)" ::: "memory");
            __syncthreads();
            {
                pg8::Gemm g2{PRB, (const bf16_t*)(ws + WS_VT) + (size_t)l * 1024 * 2048, 1024, 2048, 256};
                pg8::Sched S2; S2.init(MP / 256, 4, 1, G, cid); S2.a_pm = (size_t)256 * 1024 * 2; S2.a_pn = 256 * 2; S2.b_pn = (size_t)256 * 2048 * 2; S2.b_b = 256 * 2;
                pg8::EpiStore E2{OB, 1024, 1.0f};
                pg8::gemm_phase<pg8::EpiStore>(L, g2, S2, E2, wv_);
            }
            __syncthreads();
#ifndef SK11
            for (int un = cid; un < 512; un += G) samp_attn_unit(vw, l, un, lds, QB, OB, wv_);
#endif
        }
}

__global__ void __launch_bounds__(NT, 2) mega_fwd(Args args) {
    extern __shared__ __attribute__((aligned(16))) unsigned char lds[];
    cg::grid_group grid = cg::this_grid();
    const int lo = args.ph_lo, hi = args.ph_hi;
    const int wv_ = __builtin_amdgcn_readfirstlane((int)threadIdx.x >> 6);
    volatile LAS unsigned* MISC = (volatile LAS unsigned*)((LAS unsigned char*)lds + LDS_BYTES - 64);
    if (threadIdx.x < 16) MISC[threadIdx.x] = 0u;
    __syncthreads();
    const XcdBarrier bar = xcd_barrier_post((unsigned*)(args.ws + WS_CTL), MISC);
#define RUN(k) if (lo <= (k) && (k) < hi) { run_phase<(k)>(args, lds, wv_); if ((k) + 1 < hi) { if ((k) == 0) grid.sync(); else xcd_barrier(bar); } }
    RUN(0)
    RUN(3) RUN(4) RUN(5) RUN(6) RUN(7) RUN(8) RUN(9) RUN(10) RUN(11) RUN(12) RUN(14) RUN(15) RUN(16) RUN(17) RUN(18)
    RUN(19) RUN(20) RUN(21) RUN(22) RUN(23) RUN(24) RUN(25) RUN(26) RUN(27) RUN(28) RUN(30) RUN(31) RUN(32) RUN(33) RUN(34)
#undef RUN
}

extern "C" void kernel_launch(void* const* d_in, const int* in_sizes, int n_in, void* d_out, int out_size, void* d_ws, size_t ws_size, hipStream_t stream) {
    static int grid = 0;
    if (grid == 0) {
        if (n_in != N_IN || (size_t)out_size != OUT_END || ws_size < WS_END) { fprintf(stderr, "kernel_launch: unexpected shapes: n_in %d out %d ws %zu (need %zu)\n", n_in, out_size, ws_size, (size_t)WS_END); grid = -1; return; }
        int dev = 0, cus = 0, per_cu = 0;
        if (hipGetDevice(&dev) != hipSuccess || hipDeviceGetAttribute(&cus, hipDeviceAttributeMultiprocessorCount, dev) != hipSuccess) { grid = -1; return; }
        if (hipFuncSetAttribute((const void*)mega_fwd, hipFuncAttributeMaxDynamicSharedMemorySize, LDS_BYTES) != hipSuccess) { fprintf(stderr, "kernel_launch: hipFuncSetAttribute failed\n"); grid = -1; return; }
        if (hipOccupancyMaxActiveBlocksPerMultiprocessor(&per_cu, (const void*)mega_fwd, NT, LDS_BYTES) != hipSuccess || per_cu < 1) { fprintf(stderr, "kernel_launch: occupancy query says %d\n", per_cu); per_cu = 1; }
        (void)hipGetLastError();
        grid = cus * 1;
    }
    if (grid < 0) return;
    Args a{};
    for (int i = 0; i < N_IN; ++i) a.in[i] = (const float*)d_in[i];
    a.out = (float*)d_out; a.ws = (unsigned char*)d_ws;
#if MK_MULTI
#ifndef MK_LAST
#define MK_LAST N_PHASES
#endif
    for (int p = 0; p < MK_LAST; ++p) {
        a.ph_lo = p; a.ph_hi = p + 1;
        hipLaunchKernelGGL(mega_fwd, dim3(grid), dim3(NT), LDS_BYTES, stream, a);
    }
#else
    a.ph_lo = 0; a.ph_hi = N_PHASES;
    if (hipMemsetAsync((char*)d_ws + WS_CTL, 0, CTL_BYTES, stream) != hipSuccess) { fprintf(stderr, "kernel_launch: memset failed\n"); return; }
    void* kargs[] = {&a};
    hipError_t e = hipLaunchCooperativeKernel((const void*)mega_fwd, dim3(grid), dim3(NT), kargs, LDS_BYTES, stream);
    if (e != hipSuccess) fprintf(stderr, "cooperative launch failed: %s (grid %d)\n", hipGetErrorString(e), grid);
#endif
}
```

```cpp
#include <hip/hip_runtime.h>
#include <hip/hip_cooperative_groups.h>
#include <cstdio>
#include <cstdint>
namespace cg = cooperative_groups;
#define MK_TID (wv_ * 64 + (int)__builtin_amdgcn_mbcnt_hi(~0u, __builtin_amdgcn_mbcnt_lo(~0u, 0u)))

#ifndef MK_MULTI
#define MK_MULTI 0
#endif

namespace pg8 {
#define PG8_LAS __attribute__((address_space(3)))
typedef unsigned short bf16_t;
typedef short bf16x8 __attribute__((ext_vector_type(8)));
typedef float f32x4 __attribute__((ext_vector_type(4)));
typedef float f32x2 __attribute__((ext_vector_type(2)));
typedef unsigned u32x4 __attribute__((ext_vector_type(4)));
typedef unsigned u32x2 __attribute__((ext_vector_type(2)));
constexpr int BM = 256, BK = 64, HALF = 128, HTB = HALF * BK * 2, STAGE_BYTES = 8 * HTB, NXCD = 8, WGM = 8;

__host__ __device__ __forceinline__ int lds_byte(int r, int c) { const int st = (r >> 4) * 2 + (c >> 5), rr = r & 15, cc = c & 31, ob = rr * 64 + cc * 2; return st * 1024 + (ob ^ (((ob >> 9) & 1) << 5)); }
__host__ __device__ __forceinline__ void stage_rc(int b, int& R, int& C) { const int st = b / 1024, sb = b % 1024, swz = sb ^ (((sb >> 9) & 1) << 5); R = (st >> 1) * 16 + swz / 64; C = (st & 1) * 32 + (swz % 64) / 2; }
__host__ __device__ __forceinline__ int perm32(int rho) { const int n = rho >> 4, i = rho & 15; return 8 * (i >> 2) + 4 * n + (i & 3); }

struct Unit { int pm, pn, aux; size_t aoff, boff; };
struct Gemm { const bf16_t* A; const bf16_t* Bt; int lda, ldb, K; };

struct Sched {
    int nM, nN, nsub, nwg, G, c;
    size_t a_pm, a_pn, a_sub, a_b, b_pn, b_sub, b_b;
    __device__ __forceinline__ void init(int nM_, int nN_, int nsub_, int G_, int c_) { nM = nM_; nN = nN_; nsub = nsub_; nwg = nM_ * nN_; G = G_; c = c_; a_pm = a_pn = a_sub = a_b = b_pn = b_sub = b_b = 0; }
    __device__ __forceinline__ bool next(int i, Unit& u) const {
        const int sub = i % nsub; const long L = (long)(i / nsub) * G + c; if (L >= nwg) return false;
        int wgid = (int)L; { const int q = nwg / NXCD, r = nwg % NXCD, xcd = wgid % NXCD, off = wgid / NXCD; wgid = (xcd < r ? xcd * (q + 1) : r * (q + 1) + (xcd - r) * q) + off; }
        const int nig = WGM * nN, gid = wgid / nig, fm = gid * WGM, gsz = (nM - fm) < WGM ? (nM - fm) : WGM;
        u.pm = fm + ((wgid % nig) % gsz); u.pn = (wgid % nig) / gsz; u.aux = sub;
        u.aoff = (size_t)u.pm * a_pm + (size_t)u.pn * a_pn + (size_t)sub * a_sub + (size_t)(u.pm >> 3) * a_b;
        u.boff = (size_t)u.pn * b_pn + (size_t)sub * b_sub + (size_t)(u.pm >> 3) * b_b;
        return true;
    }
};

typedef __bf16 bf16v2 __attribute__((ext_vector_type(2)));
__device__ __forceinline__ unsigned cvt_pk_bf16(float lo, float hi) { const f32x2 v = {lo, hi}; return __builtin_bit_cast(unsigned, __builtin_convertvector(v, bf16v2)); }
__device__ __forceinline__ float sigm(float x) { return __builtin_amdgcn_rcpf(1.f + __expf(-x)); }
__device__ __forceinline__ f32x4 sigm4(f32x4 v) { return (f32x4){sigm(v[0]), sigm(v[1]), sigm(v[2]), sigm(v[3])}; }
__device__ __forceinline__ u32x4 pack2(f32x4 v0, f32x4 v1) { u32x4 w; w.x = cvt_pk_bf16(v0[0], v0[1]); w.y = cvt_pk_bf16(v0[2], v0[3]); w.z = cvt_pk_bf16(v1[0], v1[1]); w.w = cvt_pk_bf16(v1[2], v1[3]); return w; }
__device__ __forceinline__ f32x4 bflo(unsigned a, unsigned b) { return (f32x4){__uint_as_float(a << 16), __uint_as_float(a & 0xffff0000u), __uint_as_float(b << 16), __uint_as_float(b & 0xffff0000u)}; }

typedef f32x4 Acc[2][2][4][2];

struct EpiUp {
    bf16_t* H; int ldh;
    __device__ __forceinline__ bool keep(const Unit&) const { return false; }
    __device__ __forceinline__ void operator()(Acc& acc, const Unit& u, int wr, int wc, int fr, int fq, PG8_LAS unsigned char*) const {
        const int row0 = u.pm * BM + wr * 64 + fr, col = u.pn * 128 + wc * 32 + 8 * fq;
#pragma unroll
        for (int ai = 0; ai < 2; ++ai)
#pragma unroll
            for (int m = 0; m < 4; ++m) {
                const f32x4 a0 = acc[ai][0][m][0], a1 = acc[ai][0][m][1], b0 = acc[ai][1][m][0], b1 = acc[ai][1][m][1];
                const f32x4 h0 = a0 * sigm4(a0) * b0, h1 = a1 * sigm4(a1) * b1;
                *(u32x4*)(H + (size_t)(row0 + ai * HALF + m * 16) * ldh + col) = pack2(h0, h1);
            }
    }
};
template <int HALF_SCALE>
struct EpiResidLN {
    bf16_t* XB; const float* g; const float* b; float* out; unsigned char* ctl;
    long xoff;
    __device__ __forceinline__ bool keep(const Unit&) const { return false; }
    __device__ __forceinline__ void operator()(Acc& acc, const Unit& u, int wr, int wc, int fr, int fq, PG8_LAS unsigned char* lds) const {
        constexpr float alpha = 1.41421356237f, s = HALF_SCALE ? 0.5f : 1.0f;
        unsigned long long* xbuf = (unsigned long long*)(ctl + xoff); unsigned* cnt = (unsigned*)ctl;
        PG8_LAS f32x2* P = (PG8_LAS f32x2*)(lds + STAGE_BYTES);
        PG8_LAS f32x2* S = (PG8_LAS f32x2*)(lds + STAGE_BYTES + 8192);
        const int row0 = u.pm * BM + wr * 64 + fr, col = u.pn * BM + wc * 32 + 8 * fq, wid = wr * 4 + wc, lane = fq * 16 + fr;
#pragma unroll
        for (int ai = 0; ai < 2; ++ai) {
            u32x4 xr[4][2];
#pragma unroll
            for (int m = 0; m < 4; ++m)
#pragma unroll
                for (int bj = 0; bj < 2; ++bj) xr[m][bj] = *(const u32x4*)(XB + (size_t)(row0 + ai * HALF + m * 16) * 1024 + col + bj * HALF);
#pragma unroll
            for (int m = 0; m < 4; ++m)
#pragma unroll
                for (int bj = 0; bj < 2; ++bj) { const u32x4 x = xr[m][bj];
                    acc[ai][bj][m][0] = bflo(x.x, x.y) * alpha + acc[ai][bj][m][0] * s; acc[ai][bj][m][1] = bflo(x.z, x.w) * alpha + acc[ai][bj][m][1] * s; }
            asm volatile("" ::: "memory");
        }
#pragma unroll
        for (int ai = 0; ai < 2; ++ai)
#pragma unroll
            for (int m = 0; m < 4; ++m) {
                float sm = 0.f;
#pragma unroll
                for (int bj = 0; bj < 2; ++bj)
#pragma unroll
                    for (int n = 0; n < 2; ++n) { const f32x4 x = acc[ai][bj][m][n]; sm += (x[0] + x[1]) + (x[2] + x[3]); }
                sm += __shfl_xor(sm, 16); sm += __shfl_xor(sm, 32);
                const float mw = sm * (1.0f / 64.0f); float q = 0.f;
#pragma unroll
                for (int bj = 0; bj < 2; ++bj)
#pragma unroll
                    for (int n = 0; n < 2; ++n) { const f32x4 d = acc[ai][bj][m][n] - mw; q += (d[0] * d[0] + d[1] * d[1]) + (d[2] * d[2] + d[3] * d[3]); }
                q += __shfl_xor(q, 16); q += __shfl_xor(q, 32);
                if (fq == 0) P[(ai * HALF + wr * 64 + m * 16 + fr) * 4 + wc] = (f32x2){mw, q};
            }
        asm volatile("s_waitcnt lgkmcnt(0)" ::: "memory"); __builtin_amdgcn_s_barrier(); asm volatile("" ::: "memory");
        const int row = wid * 32 + (lane & 31);
        if (lane < 32) {
            const f32x2 a = P[row * 4 + 0], bb = P[row * 4 + 1], c = P[row * 4 + 2], d = P[row * 4 + 3];
            const float mt = (a.x + bb.x + c.x + d.x) * 0.25f;
            const float da = a.x - mt, db = bb.x - mt, dc = c.x - mt, dd = d.x - mt;
            const float m2 = (a.y + bb.y) + (c.y + d.y) + 64.0f * ((da * da + db * db) + (dc * dc + dd * dd));
            unsigned long long* slot = xbuf + ((size_t)(u.pm * BM + row) * 4 + u.pn);
            __hip_atomic_store(slot, ((unsigned long long)__float_as_uint(m2) << 32) | __float_as_uint(mt), __ATOMIC_RELAXED, __HIP_MEMORY_SCOPE_AGENT);
        }
        asm volatile("s_waitcnt vmcnt(0)" ::: "memory");
        if (lane == 0) __hip_atomic_fetch_add(cnt + 64 * u.pm, 1u, __ATOMIC_RELAXED, __HIP_MEMORY_SCOPE_AGENT);
        if (wid == 0) {
            unsigned sp = 0;
            while ((unsigned)__builtin_amdgcn_readfirstlane(__hip_atomic_load(cnt + 64 * u.pm, __ATOMIC_RELAXED, __HIP_MEMORY_SCOPE_AGENT)) < 32u) { __builtin_amdgcn_s_sleep(2); if (++sp > (1u << 22)) break; }
            __builtin_amdgcn_fence(__ATOMIC_ACQUIRE, "agent");
        }
        asm volatile("s_waitcnt vmcnt(0) lgkmcnt(0)" ::: "memory"); __builtin_amdgcn_s_barrier(); asm volatile("" ::: "memory");
        if (lane < 32) {
            const unsigned long long* slot = xbuf + (size_t)(u.pm * BM + row) * 4; float mt[4], m2[4]; float ms = 0.f;
#pragma unroll
            for (int t = 0; t < 4; ++t) { const unsigned long long w = __hip_atomic_load(slot + t, __ATOMIC_RELAXED, __HIP_MEMORY_SCOPE_AGENT); mt[t] = __uint_as_float((unsigned)w); m2[t] = __uint_as_float((unsigned)(w >> 32)); ms += mt[t]; }
            const float mean = ms * 0.25f; float q = 0.f;
#pragma unroll
            for (int t = 0; t < 4; ++t) { const float dm = mt[t] - mean; q += m2[t] + 256.0f * dm * dm; }
            S[row] = (f32x2){mean, 1.0f / sqrtf(q * (1.0f / 1024.0f) + 1e-5f)};
        }
        asm volatile("s_waitcnt lgkmcnt(0)" ::: "memory"); __builtin_amdgcn_s_barrier(); asm volatile("" ::: "memory");
#pragma unroll
        for (int bj = 0; bj < 2; ++bj) {
            const f32x4 g0 = *(const f32x4*)(g + col + bj * HALF), g1 = *(const f32x4*)(g + col + bj * HALF + 4), b0 = *(const f32x4*)(b + col + bj * HALF), b1 = *(const f32x4*)(b + col + bj * HALF + 4);
#pragma unroll
            for (int ai = 0; ai < 2; ++ai)
#pragma unroll
                for (int m = 0; m < 4; ++m) {
                    const f32x2 sr = S[ai * HALF + wr * 64 + m * 16 + fr];
                    const size_t o = (size_t)(row0 + ai * HALF + m * 16) * 1024 + col + bj * HALF;
                    const f32x4 y0 = (acc[ai][bj][m][0] - sr.x) * sr.y * g0 + b0, y1 = (acc[ai][bj][m][1] - sr.x) * sr.y * g1 + b1;
                    *(u32x4*)(XB + o) = pack2(y0, y1);
                    if (out) { *(f32x4*)(out + o) = y0; *(f32x4*)(out + o + 4) = y1; }
                    asm volatile("" ::: "memory");
                }
        }
    }
};
struct EpiStore {
    bf16_t* O; int ldo; float s;
    __device__ __forceinline__ bool keep(const Unit&) const { return false; }
    __device__ __forceinline__ void operator()(Acc& acc, const Unit& u, int wr, int wc, int fr, int fq, PG8_LAS unsigned char*) const {
        const int row0 = u.pm * BM + wr * 64 + fr, col = u.pn * BM + wc * 32 + 8 * fq;
#pragma unroll
        for (int ai = 0; ai < 2; ++ai)
#pragma unroll
            for (int m = 0; m < 4; ++m) {
                bf16_t* p = O + (size_t)(row0 + ai * HALF + m * 16) * ldo + col;
#pragma unroll
                for (int bj = 0; bj < 2; ++bj) *(u32x4*)(p + bj * HALF) = pack2(acc[ai][bj][m][0] * s, acc[ai][bj][m][1] * s);
            }
    }
};
struct EpiKV {
    float* mk; float* mv; bf16_t* KB;
    __device__ __forceinline__ bool keep(const Unit&) const { return false; }
    __device__ __forceinline__ void operator()(Acc& acc, const Unit& u, int wr, int wc, int fr, int fq, PG8_LAS unsigned char*) const {
        const int row0 = u.pm * BM + wr * 64 + fr; const bool isk = u.pn < 4; const int col = (u.pn & 3) * BM + wc * 32 + 8 * fq;
        float* dst = isk ? mk : mv;
#pragma unroll
        for (int ai = 0; ai < 2; ++ai)
#pragma unroll
            for (int m = 0; m < 4; ++m) {
                const size_t o = (size_t)(row0 + ai * HALF + m * 16) * 1024 + col;
#pragma unroll
                for (int bj = 0; bj < 2; ++bj) {
                    *(f32x4*)(dst + o + bj * HALF) = acc[ai][bj][m][0]; *(f32x4*)(dst + o + bj * HALF + 4) = acc[ai][bj][m][1];
                    if (isk) *(u32x4*)(KB + o + bj * HALF) = pack2(acc[ai][bj][m][0], acc[ai][bj][m][1]);
                }
            }
    }
};
struct EpiIn {
    bf16_t* P; bf16_t* GATE; const float* bg;
    __device__ __forceinline__ bool keep(const Unit&) const { return false; }
    __device__ __forceinline__ void operator()(Acc& acc, const Unit& u, int wr, int wc, int fr, int fq, PG8_LAS unsigned char*) const {
        const int row0 = u.pm * BM + wr * 64 + fr, cw = wc * 32 + 8 * fq, pn = u.pn;
        if (pn >= 16) {
            const int col = (pn - 16) * BM + cw;
            f32x4 bv[2][2];
#pragma unroll
            for (int bj = 0; bj < 2; ++bj) { bv[bj][0] = *(const f32x4*)(bg + col + bj * HALF); bv[bj][1] = *(const f32x4*)(bg + col + bj * HALF + 4); }
#pragma unroll
            for (int ai = 0; ai < 2; ++ai)
#pragma unroll
                for (int m = 0; m < 4; ++m) {
                    bf16_t* p = GATE + (size_t)(row0 + ai * HALF + m * 16) * 4096 + col;
#pragma unroll
                    for (int bj = 0; bj < 2; ++bj) *(u32x4*)(p + bj * HALF) = pack2(sigm4(acc[ai][bj][m][0] + bv[bj][0]), sigm4(acc[ai][bj][m][1] + bv[bj][1]));
                }
        } else if ((pn >= 6 && pn < 10) || pn >= 12) {
            const bool glu = pn < 10; const int col = (glu ? 1536 + (pn - 6) * 128 : 2560 + (pn - 12) * 128) + cw;
#pragma unroll
            for (int ai = 0; ai < 2; ++ai)
#pragma unroll
                for (int m = 0; m < 4; ++m) {
                    f32x4 b0 = acc[ai][1][m][0], b1 = acc[ai][1][m][1];
                    if (glu) { b0 = sigm4(b0); b1 = sigm4(b1); }
                    *(u32x4*)(P + (size_t)(row0 + ai * HALF + m * 16) * 3072 + col) = pack2(acc[ai][0][m][0] * b0, acc[ai][0][m][1] * b1);
                }
        } else {
            const int col = (pn < 6 ? pn * BM : 2048 + (pn - 10) * BM) + cw;
#pragma unroll
            for (int ai = 0; ai < 2; ++ai)
#pragma unroll
                for (int m = 0; m < 4; ++m) {
                    bf16_t* p = P + (size_t)(row0 + ai * HALF + m * 16) * 3072 + col;
#pragma unroll
                    for (int bj = 0; bj < 2; ++bj) *(u32x4*)(p + bj * HALF) = pack2(acc[ai][bj][m][0], acc[ai][bj][m][1]);
                }
        }
    }
};
struct EpiBranch {
    const bf16_t* GATE; bf16_t* O;
    __device__ __forceinline__ bool keep(const Unit& u) const { return u.aux < 3; }
    __device__ __forceinline__ void operator()(Acc& acc, const Unit& u, int wr, int wc, int fr, int fq, PG8_LAS unsigned char*) const {
        const int row0 = u.pm * BM + wr * 64 + fr, col = u.pn * BM + wc * 32 + 8 * fq, kb = u.aux;
#pragma unroll
        for (int ai = 0; ai < 2; ++ai)
#pragma unroll
            for (int m = 0; m < 4; ++m) {
                const size_t r = (size_t)(row0 + ai * HALF + m * 16);
                const bf16_t* gp = GATE + r * 4096 + kb * 1024 + col;
#pragma unroll
                for (int bj = 0; bj < 2; ++bj) {
                    const u32x4 g = *(const u32x4*)(gp + bj * HALF);
                    f32x4 g0 = bflo(g.x, g.y), g1 = bflo(g.z, g.w);
                    if (kb < 3) {
                        const u32x4 h = *(const u32x4*)(gp + 1024 + bj * HALF);
                        const f32x4 h0 = bflo(h.x, h.y), h1 = bflo(h.z, h.w);
#pragma unroll
                        for (int j = 0; j < 4; ++j) { g0[j] = g0[j] * __builtin_amdgcn_rcpf(fmaxf(h0[j], 1e-30f)); g1[j] = g1[j] * __builtin_amdgcn_rcpf(fmaxf(h1[j], 1e-30f)); }
                        acc[ai][bj][m][0] *= g0; acc[ai][bj][m][1] *= g1;
                    } else {
                        *(u32x4*)(O + r * 1024 + col + bj * HALF) = pack2(acc[ai][bj][m][0] * g0, acc[ai][bj][m][1] * g1);
                    }
                }
            }
    }
};
struct EpiSoftmax {
    bf16_t* PR;
    __device__ __forceinline__ bool keep(const Unit&) const { return false; }
    __device__ __forceinline__ void operator()(Acc& acc, const Unit& u, int wr, int wc, int fr, int fq, PG8_LAS unsigned char* lds) const {
        PG8_LAS f32x2* X = (PG8_LAS f32x2*)(lds + STAGE_BYTES);
        const int row0 = u.pm * BM + wr * 64 + fr, col = u.pn * BM + wc * 32 + 8 * fq;
        float mxs[2][4];
#pragma unroll
        for (int ai = 0; ai < 2; ++ai)
#pragma unroll
            for (int m = 0; m < 4; ++m) {
                float mx = -3.0e38f;
#pragma unroll
                for (int bj = 0; bj < 2; ++bj)
#pragma unroll
                    for (int n = 0; n < 2; ++n) { const f32x4 v = acc[ai][bj][m][n]; mx = fmaxf(mx, fmaxf(fmaxf(v[0], v[1]), fmaxf(v[2], v[3]))); }
                mx = fmaxf(mx, __shfl_xor(mx, 16)); mx = fmaxf(mx, __shfl_xor(mx, 32));
                float sm = 0.f;
#pragma unroll
                for (int bj = 0; bj < 2; ++bj)
#pragma unroll
                    for (int n = 0; n < 2; ++n) { f32x4 v = acc[ai][bj][m][n];
#pragma unroll
                        for (int j = 0; j < 4; ++j) v[j] = __expf(v[j] - mx);
                        acc[ai][bj][m][n] = v; sm += (v[0] + v[1]) + (v[2] + v[3]); }
                sm += __shfl_xor(sm, 16); sm += __shfl_xor(sm, 32);
                mxs[ai][m] = mx;
                if (fq == 0) X[(ai * HALF + wr * 64 + m * 16 + fr) * 4 + wc] = (f32x2){mx, sm};
                asm volatile("" ::: "memory");
            }
        asm volatile("s_waitcnt lgkmcnt(0)" ::: "memory"); __builtin_amdgcn_s_barrier(); asm volatile("" ::: "memory");
#pragma unroll
        for (int ai = 0; ai < 2; ++ai)
#pragma unroll
            for (int m = 0; m < 4; ++m) {
                const int rl = ai * HALF + wr * 64 + m * 16 + fr;
                const f32x2 p0 = X[rl * 4 + 0], p1 = X[rl * 4 + 1], p2 = X[rl * 4 + 2], p3 = X[rl * 4 + 3];
                const float M = fmaxf(fmaxf(p0.x, p1.x), fmaxf(p2.x, p3.x));
                const float L = (p0.y * __expf(p0.x - M) + p1.y * __expf(p1.x - M)) + (p2.y * __expf(p2.x - M) + p3.y * __expf(p3.x - M));
                const float f = __expf(mxs[ai][m] - M) * __builtin_amdgcn_rcpf(L);
                bf16_t* p = PR + (size_t)(row0 + ai * HALF + m * 16) * 1024 + col;
#pragma unroll
                for (int bj = 0; bj < 2; ++bj) *(u32x4*)(p + bj * HALF) = pack2(acc[ai][bj][m][0] * f, acc[ai][bj][m][1] * f);
                asm volatile("" ::: "memory");
            }
        asm volatile("s_waitcnt lgkmcnt(0)" ::: "memory"); __builtin_amdgcn_s_barrier(); asm volatile("" ::: "memory");
    }
};

template <class Epi>
__device__ __forceinline__ void gemm_phase(PG8_LAS unsigned char* lds, const Gemm g, const Sched& S, const Epi& E, const int wv_) {
    int tid_ = MK_TID; asm volatile("" : "+v"(tid_)); const int tid = tid_, wid = __builtin_amdgcn_readfirstlane(tid >> 6), lane = tid & 63, wr = wid >> 2, wc = wid & 3, fr = lane & 15, fq = lane >> 4;
    const int nt = g.K / BK;
    unsigned voffA[2], voffB[2];
#pragma unroll
    for (int i = 0; i < 2; ++i) { int R, C; stage_rc(tid * 16 + i * 8192, R, C); const int Rb = (R & ~31) + perm32(R & 31);
        voffA[i] = (unsigned)(R * g.lda + C) * 2u; voffB[i] = (unsigned)(Rb * g.ldb + C) * 2u; }
    const size_t kstep = (size_t)(BK * 2);
    const size_t hstepA = (size_t)HALF * g.lda * 2, hstepB = (size_t)HALF * g.ldb * 2;
    const unsigned ldsw = (unsigned)wid * 1024u;
    const int aoff = lds_byte(wr * 64 + fr, fq * 8), boff = lds_byte(wc * 32 + fr, fq * 8);
#define PG8_SA(b, h) (((b) * 2 + (h)) * HTB)
#define PG8_SB(b, h) ((4 + (b) * 2 + (h)) * HTB)
#define PG8_STAGE(bufoff, gbase, voff) do { _Pragma("unroll") for (int _i = 0; _i < 2; ++_i) \
        __builtin_amdgcn_global_load_lds((const unsigned*)((const char*)(gbase) + (voff)[_i]), (PG8_LAS unsigned*)(lds + (bufoff) + ldsw + _i * 8192), 16, 0, 0); } while (0)
#define PG8_LDA(dst, b, h) do { _Pragma("unroll") for (int m = 0; m < 4; ++m) _Pragma("unroll") for (int k = 0; k < 2; ++k) dst[m][k] = *(const PG8_LAS bf16x8*)(lds + PG8_SA(b, h) + aoff + m * 2048 + k * 1024); } while (0)
#define PG8_LDB(dst, b, h) do { _Pragma("unroll") for (int n = 0; n < 2; ++n) _Pragma("unroll") for (int k = 0; k < 2; ++k) dst[n][k] = *(const PG8_LAS bf16x8*)(lds + PG8_SB(b, h) + boff + n * 2048 + k * 1024); } while (0)
#define PG8_MMA(ai, bj, At, Bt) do { __builtin_amdgcn_s_setprio(1); _Pragma("unroll") for (int m = 0; m < 4; ++m) _Pragma("unroll") for (int n = 0; n < 2; ++n) _Pragma("unroll") for (int k = 0; k < 2; ++k) \
        acc[ai][bj][m][n] = __builtin_amdgcn_mfma_f32_16x16x32_bf16(Bt[n][k], At[m][k], acc[ai][bj][m][n], 0, 0, 0); __builtin_amdgcn_s_setprio(0); } while (0)
#define PG8_WAIT_V(n) asm volatile("s_waitcnt vmcnt(" #n ")" ::: "memory")
#define PG8_WAIT_L(n) asm volatile("s_waitcnt lgkmcnt(" #n ")" ::: "memory")
#define PG8_BAR __builtin_amdgcn_s_barrier()
#define PG8_SCHED __builtin_amdgcn_sched_barrier(0)
#define PG8_ZERO do { _Pragma("unroll") for (int a = 0; a < 2; ++a) _Pragma("unroll") for (int b = 0; b < 2; ++b) _Pragma("unroll") for (int m = 0; m < 4; ++m) _Pragma("unroll") for (int n = 0; n < 2; ++n) acc[a][b][m][n] = (f32x4){0.f, 0.f, 0.f, 0.f}; } while (0)
    Unit cur, nxt; int ui = 0;
    if (!S.next(0, cur)) return;
    Acc acc;
    PG8_ZERO;
    bf16x8 At[4][2], B0[2][2], B1[2][2];
    const char* cA = (const char*)g.A + cur.aoff; const char* cB = (const char*)g.Bt + cur.boff;
    PG8_STAGE(PG8_SB(0, 0), cB, voffB); PG8_STAGE(PG8_SB(0, 1), cB + hstepB, voffB); PG8_STAGE(PG8_SA(0, 0), cA, voffA); PG8_STAGE(PG8_SA(0, 1), cA + hstepA, voffA);
    if (wr == 1) PG8_BAR;
    PG8_WAIT_V(2); PG8_BAR;
    PG8_STAGE(PG8_SB(1, 0), cB + kstep, voffB); PG8_STAGE(PG8_SA(1, 0), cA + kstep, voffA); PG8_STAGE(PG8_SB(1, 1), cB + hstepB + kstep, voffB);
    PG8_WAIT_V(6); PG8_BAR;
    for (;;) {
        const bool has_next = S.next(ui + 1, nxt);
        const char* nA = has_next ? (const char*)g.A + nxt.aoff : cA; const char* nB = has_next ? (const char*)g.Bt + nxt.boff : cB;
        for (int t = 0; t < nt; t += 2) {
            const bool last = (t == nt - 2);
            const char* a1 = cA + (size_t)(t + 1) * kstep;
            const char* a2 = last ? nA : cA + (size_t)(t + 2) * kstep; const char* b2 = last ? nB : cB + (size_t)(t + 2) * kstep;
            const char* a3 = a2 + kstep; const char* b3 = b2 + kstep;
            PG8_LDB(B0, 0, 0); PG8_LDB(B1, 0, 1); PG8_SCHED; PG8_LDA(At, 0, 0); PG8_STAGE(PG8_SA(1, 1), a1 + hstepA, voffA);
            PG8_WAIT_V(8); PG8_WAIT_L(0); PG8_BAR; PG8_MMA(0, 0, At, B0); PG8_MMA(0, 1, At, B1); PG8_BAR; PG8_SCHED;
            PG8_LDA(At, 0, 1); PG8_STAGE(PG8_SB(0, 0), b2, voffB); PG8_STAGE(PG8_SB(0, 1), b2 + hstepB, voffB); PG8_STAGE(PG8_SA(0, 0), a2, voffA);
            PG8_WAIT_V(8); PG8_WAIT_L(0); PG8_BAR; PG8_MMA(1, 0, At, B0); PG8_MMA(1, 1, At, B1); PG8_BAR; PG8_SCHED;
            PG8_LDB(B0, 1, 0); PG8_LDB(B1, 1, 1); PG8_SCHED; PG8_LDA(At, 1, 0); PG8_STAGE(PG8_SA(0, 1), a2 + hstepA, voffA);
            PG8_WAIT_V(8); PG8_WAIT_L(0); PG8_BAR; PG8_MMA(0, 0, At, B0); PG8_MMA(0, 1, At, B1); PG8_BAR; PG8_SCHED;
            PG8_LDA(At, 1, 1); PG8_STAGE(PG8_SB(1, 0), b3, voffB); PG8_STAGE(PG8_SB(1, 1), b3 + hstepB, voffB); PG8_STAGE(PG8_SA(1, 0), a3, voffA);
            PG8_WAIT_V(8); PG8_WAIT_L(0); PG8_BAR; PG8_MMA(1, 0, At, B0); PG8_MMA(1, 1, At, B1); PG8_BAR; PG8_SCHED;
        }
        if (wr == 0) PG8_BAR;
        PG8_WAIT_V(0);
        { int te = tid; asm volatile("" : "+v"(te));
          E(acc, cur, (te >> 8) & 1, (te >> 6) & 3, te & 15, (te >> 4) & 3, lds); }
        if (!has_next) break;
        if (!E.keep(cur)) PG8_ZERO;
        cur = nxt; cA = nA; cB = nB; ++ui;
        if (wr == 1) PG8_BAR;
    }
    PG8_WAIT_V(0);
    PG8_BAR;
#undef PG8_SA
#undef PG8_SB
#undef PG8_STAGE
#undef PG8_LDA
#undef PG8_LDB
#undef PG8_MMA
#undef PG8_WAIT_V
#undef PG8_WAIT_L
#undef PG8_BAR
#undef PG8_SCHED
#undef PG8_ZERO
}
}

using pg8::bf16_t; using pg8::f32x4; using pg8::u32x4; using pg8::u32x2; using pg8::bf16x8; using pg8::cvt_pk_bf16; using pg8::sigm;

constexpr int NWAVES = 8, NT = 512;
constexpr int D = 1024, MP = 16384, NSAMP = 128, M_TOK = MP + NSAMP, M_PAD = 16640, SEQ = 2048, NB = 8, FF = 2816, NMEM = 256;
constexpr float DN_ALPHA = 1.41421356237f, LN_EPS = 1e-5f;
constexpr size_t OUT_Y = 0, OUT_POOLP = 16908288, OUT_CONVP = 17031168, OUT_SCP = 17276928, OUT_MK = 17293312, OUT_MV = 21487616,
                 OUT_POOLS = 25681920, OUT_CONVS = 27648000, OUT_SCS = 31580160, OUT_GV = 31842304, OUT_END = 31973376;
constexpr size_t MiB = 1u << 20;
constexpr size_t WO_UP1 = 0, WO_DN1 = WO_UP1 + (size_t)5632 * 1024 * 2, WO_IN = WO_DN1 + (size_t)1024 * 2816 * 2, WO_PROJ = WO_IN + (size_t)8192 * 1024 * 2,
                 WO_WO = WO_PROJ + (size_t)1024 * 2048 * 2, WO_WQ = WO_WO + (size_t)1024 * 1024 * 2, WO_KV = WO_WQ + (size_t)1024 * 1024 * 2, WO_AO = WO_KV + (size_t)2048 * 1024 * 2,
                 WO_UP2 = WO_AO + (size_t)1024 * 1024 * 2, WO_DN2 = WO_UP2 + (size_t)5632 * 1024 * 2, W_LAYER = WO_DN2 + (size_t)1024 * 2816 * 2;
constexpr size_t WS_CTL = 0, CTL_BYTES = 16384 + 8 * 16384;
constexpr size_t WS_XBUF = 256 * 1024;
constexpr size_t WS_W = 1 * MiB, WS_XB = WS_W + 2 * W_LAYER, WS_XF = WS_XB + (size_t)M_PAD * 1024 * 2, WS_R1 = WS_XF + (size_t)M_PAD * 1024 * 4,
                 WS_R2 = WS_R1 + (size_t)M_PAD * 4096 * 2, WS_MIX = WS_R2 + (size_t)M_PAD * 3072 * 2, WS_MRG = WS_MIX + (size_t)M_PAD * 2048 * 2,
                 WS_MEMB = WS_MRG + (size_t)M_PAD * 1024 * 2, WS_KB = WS_MEMB + (size_t)2048 * 1024 * 2, WS_VT = WS_KB + (size_t)2 * 2048 * 1024 * 2, WS_END = WS_VT + (size_t)2 * 2048 * 1024 * 2;
static_assert(W_LAYER % 256 == 0, "align");
constexpr int LDS_BYTES = 147456;

enum { I_XP = 0, I_XS, I_MEM, I_SPOOL, I_SCONV, I_SSC, I_CK, I_CV, I_LN1G, I_LN1B, I_F1W1, I_F1W3, I_F1W2, I_WIN, I_WGATE, I_BGATE, I_POOLW, I_POOLS, I_POOLP,
       I_GLNG, I_GLNB, I_GWS, I_GB, I_GPROJ, I_CDW, I_CDB, I_CLNG, I_CLNB, I_CPROJ, I_SCW, I_SCPROJ, I_WO, I_LN2G, I_LN2B, I_WQ, I_WK, I_WV, I_XWO, I_LN3G, I_LN3B,
       I_F2W1, I_F2W3, I_F2W2, I_LN4G, I_LN4B, N_IN };

struct Args { const float* in[N_IN]; float* out; unsigned char* ws; int ph_lo, ph_hi; };
struct View { const Args* a; int z; unsigned char* ws; float* out; __device__ __forceinline__ const float* in(int i) const { return a->in[i + z]; } };

#define LAS __attribute__((address_space(3)))
__device__ __forceinline__ float wave_sum(float v) {
#pragma unroll
    for (int o = 1; o < 64; o <<= 1) v += __shfl_xor(v, o);
    return v;
}
__device__ __forceinline__ float wave_max(float v) {
#pragma unroll
    for (int o = 1; o < 64; o <<= 1) v = fmaxf(v, __shfl_xor(v, o));
    return v;
}
__device__ __forceinline__ void unpack8(u32x4 w, float (&f)[8]) {
    f[0] = __uint_as_float(w.x << 16); f[1] = __uint_as_float(w.x & 0xffff0000u); f[2] = __uint_as_float(w.y << 16); f[3] = __uint_as_float(w.y & 0xffff0000u);
    f[4] = __uint_as_float(w.z << 16); f[5] = __uint_as_float(w.z & 0xffff0000u); f[6] = __uint_as_float(w.w << 16); f[7] = __uint_as_float(w.w & 0xffff0000u);
}
__device__ __forceinline__ u32x4 pack8(const float (&f)[8]) { u32x4 w; w.x = cvt_pk_bf16(f[0], f[1]); w.y = cvt_pk_bf16(f[2], f[3]); w.z = cvt_pk_bf16(f[4], f[5]); w.w = cvt_pk_bf16(f[6], f[7]); return w; }
__device__ __forceinline__ void ldf8(const float* p, float (&f)[8]) { const f32x4 a = *(const f32x4*)p, b = *(const f32x4*)(p + 4); f[0] = a[0]; f[1] = a[1]; f[2] = a[2]; f[3] = a[3]; f[4] = b[0]; f[5] = b[1]; f[6] = b[2]; f[7] = b[3]; }
__device__ __forceinline__ void stf8(float* p, const float (&f)[8]) { *(f32x4*)p = (f32x4){f[0], f[1], f[2], f[3]}; *(f32x4*)(p + 4) = (f32x4){f[4], f[5], f[6], f[7]}; }
__device__ __forceinline__ void ldb8(const bf16_t* p, float (&f)[8]) { unpack8(*(const u32x4*)p, f); }

__device__ __forceinline__ void transpose_item(const float* W, int N, bf16_t* WT, int ldd, int koff, int k0, int n0, int drow0, LAS float* scr, int lane) {
    float wreg[32];
#pragma unroll
    for (int i = 0; i < 32; ++i) { const int kk = 2 * i + (lane >> 5); wreg[i] = W[(size_t)(k0 + kk) * N + n0 + (lane & 31)]; }
#pragma unroll
    for (int i = 0; i < 32; ++i) { const int kk = 2 * i + (lane >> 5); scr[kk * 33 + (lane & 31)] = wreg[i]; }
    asm volatile("s_waitcnt lgkmcnt(0)" ::: "memory");
    const int c = lane & 7;
#pragma unroll
    for (int j = 0; j < 4; ++j) { const int n = (lane >> 3) + 8 * j; const LAS float* s = scr + (8 * c) * 33 + n;
        u32x4 o; o.x = cvt_pk_bf16(s[0 * 33], s[1 * 33]); o.y = cvt_pk_bf16(s[2 * 33], s[3 * 33]); o.z = cvt_pk_bf16(s[4 * 33], s[5 * 33]); o.w = cvt_pk_bf16(s[6 * 33], s[7 * 33]);
        *(u32x4*)(WT + (size_t)(drow0 + n) * ldd + koff + k0 + 8 * c) = o; }
    asm volatile("s_waitcnt lgkmcnt(0)" ::: "memory");
}
__device__ __forceinline__ int map_pair(int n0, int half) { return 256 * (n0 >> 7) + 128 * half + (n0 & 127); }
__device__ __forceinline__ int map_win(int n0) {
    const int seg = n0 >> 9, o = n0 & 511;
    switch (seg) { case 0: case 1: case 2: return n0;
        case 3: return 1536 + map_pair(o, 0); case 4: return 1536 + map_pair(o, 1); case 5: return 2560 + o;
        case 6: return 3072 + map_pair(o, 0); default: return 3072 + map_pair(o, 1); }
}
#define NJOBS 16
template <int J> struct TJ;
#define DEF_TJ(J, SRC, K_, N_, LDD, KOFF, MAP, DST) template <> struct TJ<J> { static constexpr int src = SRC, K = K_, N = N_, ldd = LDD, koff = KOFF, map = MAP, items = (K_ / 64) * (N_ / 32); static constexpr size_t dst = DST; };
DEF_TJ(0, I_F1W1, 1024, 2816, 1024, 0, 1, WO_UP1)
DEF_TJ(1, I_F1W3, 1024, 2816, 1024, 0, 2, WO_UP1)
DEF_TJ(2, I_F1W2, 2816, 1024, 2816, 0, 0, WO_DN1)
DEF_TJ(3, I_WIN, 1024, 4096, 1024, 0, 3, WO_IN)
DEF_TJ(4, I_WGATE, 1024, 4096, 1024, 0, 4, WO_IN)
DEF_TJ(5, I_GPROJ, 512, 1024, 2048, 512, 0, WO_PROJ)
DEF_TJ(6, I_CPROJ, 512, 1024, 2048, 1024, 0, WO_PROJ)
DEF_TJ(7, I_SCPROJ, 512, 1024, 2048, 1536, 0, WO_PROJ)
DEF_TJ(8, I_WO, 1024, 1024, 1024, 0, 0, WO_WO)
DEF_TJ(9, I_WQ, 1024, 1024, 1024, 0, 0, WO_WQ)
DEF_TJ(10, I_WK, 1024, 1024, 1024, 0, 0, WO_KV)
DEF_TJ(11, I_WV, 1024, 1024, 1024, 0, 5, WO_KV)
DEF_TJ(12, I_XWO, 1024, 1024, 1024, 0, 0, WO_AO)
DEF_TJ(13, I_F2W1, 1024, 2816, 1024, 0, 1, WO_UP2)
DEF_TJ(14, I_F2W3, 1024, 2816, 1024, 0, 2, WO_UP2)
DEF_TJ(15, I_F2W2, 2816, 1024, 2816, 0, 0, WO_DN2)
template <int J> __device__ __forceinline__ void run_tjob(const View& a, LAS float* scr, int lane, int gw, int NGW, int& base) {
    typedef TJ<J> T;
    const float* W0 = a.in(T::src); unsigned char* wsW = a.ws + WS_W + T::dst;
    int r = (gw - base) % NGW; if (r < 0) r += NGW;
    for (; r < 2 * T::items; r += NGW) {
        const int l = r / T::items, q = r % T::items;
        constexpr int nblk = T::N / 32; const int kb = q / nblk, nb = q % nblk, n0 = nb * 32;
        int drow;
        if (T::map == 0) drow = n0; else if (T::map == 1) drow = map_pair(n0, 0); else if (T::map == 2) drow = map_pair(n0, 1); else if (T::map == 3) drow = map_win(n0); else if (T::map == 4) drow = 4096 + n0; else drow = 1024 + n0;
        transpose_item(W0 + (size_t)l * T::K * T::N, T::N, (bf16_t*)(wsW + (size_t)l * W_LAYER), T::ldd, T::koff, kb * 64, n0, drow, scr, lane);
    }
    base = (base + 2 * T::items) % NGW;
}

__device__ __forceinline__ void prologue(const View& a, unsigned char* lds_g, int G, int cid, const int wv_) {
    int tid_ = MK_TID; asm volatile("" : "+v"(tid_)); const int tid = tid_, lane = tid & 63, wave = __builtin_amdgcn_readfirstlane(tid >> 6);
    const int gw = cid * NWAVES + wave, NGW = G * NWAVES;
    LAS float* scr = (LAS float*)((LAS unsigned char*)lds_g + wave * 16384);
    { int base = 0;
      run_tjob<0>(a, scr, lane, gw, NGW, base); run_tjob<1>(a, scr, lane, gw, NGW, base); run_tjob<2>(a, scr, lane, gw, NGW, base); run_tjob<3>(a, scr, lane, gw, NGW, base);
      run_tjob<4>(a, scr, lane, gw, NGW, base); run_tjob<5>(a, scr, lane, gw, NGW, base); run_tjob<6>(a, scr, lane, gw, NGW, base); run_tjob<7>(a, scr, lane, gw, NGW, base);
      run_tjob<8>(a, scr, lane, gw, NGW, base); run_tjob<9>(a, scr, lane, gw, NGW, base); run_tjob<10>(a, scr, lane, gw, NGW, base); run_tjob<11>(a, scr, lane, gw, NGW, base);
      run_tjob<12>(a, scr, lane, gw, NGW, base); run_tjob<13>(a, scr, lane, gw, NGW, base); run_tjob<14>(a, scr, lane, gw, NGW, base); run_tjob<15>(a, scr, lane, gw, NGW, base); }
    for (int it = gw; it < 2048; it += NGW) {
        const int l = it >> 10, k0 = ((it >> 4) & 63) * 8, g = k0 >> 7, n = (it & 15) * 64 + lane;
        const float* pw = a.in(I_POOLW) + ((size_t)l * 512 + k0) * 128;
        const float* sc = a.in(I_POOLS) + l * 512 + g * 128;
        const float* pp = a.in(I_POOLP) + ((size_t)l * 512 + g * 128) * 1024 + n;
        float acc[8];
#pragma unroll
        for (int kk = 0; kk < 8; ++kk) acc[kk] = 0.f;
#pragma unroll 2
        for (int d = 0; d < 128; d += 4) {
            float p[4];
#pragma unroll
            for (int q = 0; q < 4; ++q) p[q] = pp[(size_t)(d + q) * 1024] * sc[d + q];
#pragma unroll
            for (int kk = 0; kk < 8; ++kk) { const f32x4 w = *(const f32x4*)(pw + kk * 128 + d); acc[kk] += (w[0] * p[0] + w[1] * p[1]) + (w[2] * p[2] + w[3] * p[3]); }
        }
        *(u32x4*)((bf16_t*)(a.ws + WS_W + (size_t)l * W_LAYER + WO_PROJ) + (size_t)n * 2048 + k0) = pack8(acc);
    }
    bf16_t* XB = (bf16_t*)(a.ws + WS_XB); bf16_t* MEMB = (bf16_t*)(a.ws + WS_MEMB);
    for (int r = gw; r < M_PAD + 2048; r += NGW) {
        if (r < M_PAD) {
            const float* src = r < MP ? a.in(I_XP) + (size_t)r * D : a.in(I_XS) + (size_t)(r - MP) * D;
#pragma unroll
            for (int j = 0; j < 4; ++j) {
                f32x4 v = (f32x4){0.f, 0.f, 0.f, 0.f};
                if (r < M_TOK) v = *(const f32x4*)(src + 256 * j + 4 * lane);
                *(u32x2*)(XB + (size_t)r * D + 256 * j + 4 * lane) = (u32x2){cvt_pk_bf16(v[0], v[1]), cvt_pk_bf16(v[2], v[3])};
            }
        } else {
            const int m = r - M_PAD; const float* src = a.in(I_MEM) + (size_t)m * D;
#pragma unroll
            for (int j = 0; j < 4; ++j) { const f32x4 v = *(const f32x4*)(src + 256 * j + 4 * lane);
                *(u32x2*)(MEMB + (size_t)m * D + 256 * j + 4 * lane) = (u32x2){cvt_pk_bf16(v[0], v[1]), cvt_pk_bf16(v[2], v[3])}; }
        }
    }
}

__device__ __forceinline__ void ln_pass_sample(const float* Ys, bf16_t* XB, const float* g, const float* b, float* out, int G, int cid, const int wv_) {
    int tid_ = MK_TID; asm volatile("" : "+v"(tid_)); const int tid = tid_, lane = tid & 63, wave = __builtin_amdgcn_readfirstlane(tid >> 6);
    const int gw = cid * NWAVES + wave, NGW = G * NWAVES;
    for (int r = gw; r < NSAMP; r += NGW) {
        const float* xr = Ys + (size_t)r * D + 4 * lane;
        f32x4 v[4]; float s = 0.f;
#pragma unroll
        for (int j = 0; j < 4; ++j) { v[j] = *(const f32x4*)(xr + 256 * j); s += (v[j][0] + v[j][1]) + (v[j][2] + v[j][3]); }
        const float mean = wave_sum(s) * (1.f / D); float s2 = 0.f;
#pragma unroll
        for (int j = 0; j < 4; ++j) { v[j] = v[j] - mean; s2 += (v[j][0] * v[j][0] + v[j][1] * v[j][1]) + (v[j][2] * v[j][2] + v[j][3] * v[j][3]); }
        const float rstd = 1.0f / sqrtf(wave_sum(s2) * (1.f / D) + LN_EPS);
#pragma unroll
        for (int j = 0; j < 4; ++j) {
            const f32x4 y = v[j] * rstd * *(const f32x4*)(g + 256 * j + 4 * lane) + *(const f32x4*)(b + 256 * j + 4 * lane);
            *(u32x2*)(XB + (size_t)(MP + r) * D + 256 * j + 4 * lane) = (u32x2){cvt_pk_bf16(y[0], y[1]), cvt_pk_bf16(y[2], y[3])};
            if (out) *(f32x4*)(out + (size_t)(MP + r) * D + 256 * j + 4 * lane) = y;
        }
    }
}

template <bool DO_C>
__device__ __forceinline__ void mix_row_p(const View& a, int l, int r, int lane, const bf16_t* P, bf16_t* MIX, const LAS float* DW, const LAS bf16_t* GLrow) {
    const int ch0 = lane * 8, b = r >> 11, t = r & 2047;
    const bf16_t* Pr = P + (size_t)r * 3072 + ch0; bf16_t* Mr = MIX + (size_t)r * 2048 + ch0; float* out = a.out + ch0;
    {
        const int win = 2 << (lane >> 4);
        float av[8], sacc[8]; ldb8(Pr, av);
#pragma unroll
        for (int c = 0; c < 8; ++c) sacc[c] = av[c];
        u32x4 x[15];
#pragma unroll
        for (int i = 1; i < 16; ++i) { const int dr = i > t ? t : i; x[i - 1] = *(const u32x4*)(Pr - (ptrdiff_t)dr * 3072); }
#pragma unroll
        for (int i = 1; i < 16; ++i) { float f[8]; unpack8(x[i - 1], f); const float mk = (i < win && i <= t) ? 1.f : 0.f;
#pragma unroll
            for (int c = 0; c < 8; ++c) sacc[c] += f[c] * mk; }
        const int cnt = t + 1 < win ? t + 1 : win; const float inv = 1.0f / (float)cnt; float o[8];
#pragma unroll
        for (int c = 0; c < 8; ++c) o[c] = sacc[c] * inv - av[c];
        *(u32x4*)(Mr) = pack8(o);
        if (t >= SEQ - 15) stf8(out + OUT_POOLP + ((size_t)(l * NB + b) * 15 + (t - (SEQ - 15))) * 512, av);
    }
    asm volatile("" ::: "memory");
    if constexpr (DO_C) {
        float cacc[8]; ldf8(a.in(I_CDB) + l * 512 + ch0, cacc);
#pragma unroll
        for (int jb = 0; jb < 31; jb += 8) {
            u32x4 x[8];
#pragma unroll
            for (int u = 0; u < 8; ++u) { const int j = jb + u; if (j < 31) x[u] = *(const LAS u32x4*)(GLrow - (30 - j) * 512 + ch0); }
#pragma unroll
            for (int u = 0; u < 8; ++u) { const int j = jb + u; if (j < 31) {
                float f[8]; unpack8(x[u], f); const float mk = (30 - j <= t) ? 1.f : 0.f;
                const f32x4 w0 = *(const LAS f32x4*)(DW + j * 512 + ch0) * mk, w1 = *(const LAS f32x4*)(DW + j * 512 + ch0 + 4) * mk;
                cacc[0] += f[0] * w0[0]; cacc[1] += f[1] * w0[1]; cacc[2] += f[2] * w0[2]; cacc[3] += f[3] * w0[3];
                cacc[4] += f[4] * w1[0]; cacc[5] += f[5] * w1[1]; cacc[6] += f[6] * w1[2]; cacc[7] += f[7] * w1[3];
            } }
            asm volatile("" ::: "memory");
        }
        float sm = 0.f;
#pragma unroll
        for (int c = 0; c < 8; ++c) sm += cacc[c];
        const float mean = wave_sum(sm) * (1.f / 512.f); float s2 = 0.f;
#pragma unroll
        for (int c = 0; c < 8; ++c) { cacc[c] -= mean; s2 += cacc[c] * cacc[c]; }
        const float rstd = 1.0f / sqrtf(wave_sum(s2) * (1.f / 512.f) + LN_EPS);
        float g[8], bb[8], o[8]; ldf8(a.in(I_CLNG) + l * 512 + ch0, g); ldf8(a.in(I_CLNB) + l * 512 + ch0, bb);
#pragma unroll
        for (int c = 0; c < 8; ++c) { const float y = cacc[c] * rstd * g[c] + bb[c]; o[c] = y * sigm(y); }
        *(u32x4*)(Mr + 1024) = pack8(o);
        if (t >= SEQ - 30) { float gl[8]; ldb8(Pr + 1536, gl); stf8(out + OUT_CONVP + ((size_t)(l * NB + b) * 30 + (t - (SEQ - 30))) * 512, gl); }
    }
    {
        const float* sw = a.in(I_SCW) + (size_t)l * 3 * 512 + ch0;
        float w0[8], w1[8], w2[8], z0[8], z1[8], z2[8], sb[8], o[8];
        ldf8(sw, w0); ldf8(sw + 512, w1); ldf8(sw + 1024, w2);
        const u32x4 xz2 = *(const u32x4*)(Pr + 2560), xsb = *(const u32x4*)(Pr + 2048);
        const u32x4 xz1 = *(const u32x4*)(Pr - (ptrdiff_t)(t >= 1 ? 1 : 0) * 3072 + 2560), xz0 = *(const u32x4*)(Pr - (ptrdiff_t)(t >= 2 ? 2 : 0) * 3072 + 2560);
        unpack8(xz2, z2); unpack8(xsb, sb); unpack8(xz1, z1); unpack8(xz0, z0);
        const float m1 = t >= 1 ? 1.f : 0.f, m0 = t >= 2 ? 1.f : 0.f;
#pragma unroll
        for (int c = 0; c < 8; ++c) o[c] = sb[c] * (w0[c] * z0[c] * m0 + w1[c] * z1[c] * m1 + w2[c] * z2[c]);
        *(u32x4*)(Mr + 1536) = pack8(o);
        if (t >= SEQ - 2) stf8(out + OUT_SCP + ((size_t)(l * NB + b) * 2 + (t - (SEQ - 2))) * 512, z2);
    }
}

__device__ __forceinline__ void conv4_lds(const View& a, int l, int r0, int lane, bf16_t* MIX, const LAS float* DW, const LAS bf16_t* GLw) {
    const int ch0 = lane * 8;
    float cacc[4][8];
    { float db[8]; ldf8(a.in(I_CDB) + l * 512 + ch0, db);
#pragma unroll
      for (int i = 0; i < 4; ++i)
#pragma unroll
          for (int c = 0; c < 8; ++c) cacc[i][c] = db[c]; }
    float wv[4][8];
#pragma unroll
    for (int q = 0; q < 34; ++q) {
        if (q <= 30) { const f32x4 w0 = *(const LAS f32x4*)(DW + q * 512 + ch0), w1 = *(const LAS f32x4*)(DW + q * 512 + ch0 + 4);
            wv[q & 3][0] = w0[0]; wv[q & 3][1] = w0[1]; wv[q & 3][2] = w0[2]; wv[q & 3][3] = w0[3]; wv[q & 3][4] = w1[0]; wv[q & 3][5] = w1[1]; wv[q & 3][6] = w1[2]; wv[q & 3][7] = w1[3]; }
        float f[8]; unpack8(*(const LAS u32x4*)(GLw + q * 512 + ch0), f);
#pragma unroll
        for (int i = 0; i < 4; ++i) { const int j = q - i; if (j >= 0 && j <= 30) {
#pragma unroll
                for (int c = 0; c < 8; ++c) cacc[i][c] += f[c] * wv[j & 3][c]; } }
    }
    float g[8], bb[8]; ldf8(a.in(I_CLNG) + l * 512 + ch0, g); ldf8(a.in(I_CLNB) + l * 512 + ch0, bb);
#pragma unroll
    for (int i = 0; i < 4; ++i) {
        float sm = 0.f;
#pragma unroll
        for (int c = 0; c < 8; ++c) sm += cacc[i][c];
        const float mean = wave_sum(sm) * (1.f / 512.f); float s2 = 0.f;
#pragma unroll
        for (int c = 0; c < 8; ++c) { cacc[i][c] -= mean; s2 += cacc[i][c] * cacc[i][c]; }
        const float rstd = 1.0f / sqrtf(wave_sum(s2) * (1.f / 512.f) + LN_EPS); float o[8];
#pragma unroll
        for (int c = 0; c < 8; ++c) { const float y = cacc[i][c] * rstd * g[c] + bb[c]; o[c] = y * sigm(y); }
        *(u32x4*)(MIX + (size_t)(r0 + i) * 2048 + 1024 + ch0) = pack8(o);
    }
    const int t0 = r0 & 2047, b = r0 >> 11;
    if (t0 + 3 >= SEQ - 30) {
        for (int i = 0; i < 4; ++i) { const int t = t0 + i; if (t >= SEQ - 30) { float f[8]; unpack8(*(const LAS u32x4*)(GLw + (30 + i) * 512 + ch0), f);
            stf8(a.out + OUT_CONVP + ((size_t)(l * NB + b) * 30 + (t - (SEQ - 30))) * 512 + ch0, f); } }
    }
}

__device__ __forceinline__ void mix_row_s(const View& a, int l, int bs, int lane, const bf16_t* P, bf16_t* MIX, const LAS float* DW) {
    const int ch0 = lane * 8, r = MP + bs;
    const bf16_t* Pr = P + (size_t)r * 3072 + ch0; bf16_t* Mr = MIX + (size_t)r * 2048 + ch0; float* out = a.out + ch0;
    {
        const int win = 2 << (lane >> 4);
        const float* sp = a.in(I_SPOOL) + ((size_t)(l * NSAMP + bs) * 15) * 512 + ch0;
        float* dp = out + OUT_POOLS + ((size_t)(l * NSAMP + bs) * 15) * 512;
        float av[8], sacc[8]; ldb8(Pr, av);
#pragma unroll
        for (int c = 0; c < 8; ++c) sacc[c] = av[c];
        f32x4 x0[15], x1[15];
#pragma unroll
        for (int i = 0; i < 15; ++i) { x0[i] = *(const f32x4*)(sp + i * 512); x1[i] = *(const f32x4*)(sp + i * 512 + 4); }
#pragma unroll
        for (int i = 0; i < 15; ++i) { const float mk = (15 - i < win) ? 1.f : 0.f;
            sacc[0] += x0[i][0] * mk; sacc[1] += x0[i][1] * mk; sacc[2] += x0[i][2] * mk; sacc[3] += x0[i][3] * mk; sacc[4] += x1[i][0] * mk; sacc[5] += x1[i][1] * mk; sacc[6] += x1[i][2] * mk; sacc[7] += x1[i][3] * mk;
            if (i >= 1) { *(f32x4*)(dp + (i - 1) * 512) = x0[i]; *(f32x4*)(dp + (i - 1) * 512 + 4) = x1[i]; } }
        stf8(dp + 14 * 512, av);
        const float inv = 1.0f / (float)win; float o[8];
#pragma unroll
        for (int c = 0; c < 8; ++c) o[c] = sacc[c] * inv - av[c];
        *(u32x4*)(Mr) = pack8(o);
    }
    asm volatile("" ::: "memory");
    {
        float cacc[8]; ldf8(a.in(I_CDB) + l * 512 + ch0, cacc);
        const float* sp = a.in(I_SCONV) + ((size_t)(l * NSAMP + bs) * 30) * 512 + ch0;
        float* dp = out + OUT_CONVS + ((size_t)(l * NSAMP + bs) * 30) * 512;
#pragma unroll
        for (int jb = 0; jb < 30; jb += 10) {
            f32x4 x0[10], x1[10];
#pragma unroll
            for (int u = 0; u < 10; ++u) { x0[u] = *(const f32x4*)(sp + (jb + u) * 512); x1[u] = *(const f32x4*)(sp + (jb + u) * 512 + 4); }
#pragma unroll
            for (int u = 0; u < 10; ++u) { const int j = jb + u;
                const f32x4 w0 = *(const LAS f32x4*)(DW + j * 512 + ch0), w1 = *(const LAS f32x4*)(DW + j * 512 + ch0 + 4);
                cacc[0] += x0[u][0] * w0[0]; cacc[1] += x0[u][1] * w0[1]; cacc[2] += x0[u][2] * w0[2]; cacc[3] += x0[u][3] * w0[3];
                cacc[4] += x1[u][0] * w1[0]; cacc[5] += x1[u][1] * w1[1]; cacc[6] += x1[u][2] * w1[2]; cacc[7] += x1[u][3] * w1[3];
                if (j >= 1) { *(f32x4*)(dp + (j - 1) * 512) = x0[u]; *(f32x4*)(dp + (j - 1) * 512 + 4) = x1[u]; } }
            asm volatile("" ::: "memory");
        }
        { float gl[8]; ldb8(Pr + 1536, gl);
          const f32x4 w0 = *(const LAS f32x4*)(DW + 30 * 512 + ch0), w1 = *(const LAS f32x4*)(DW + 30 * 512 + ch0 + 4);
          cacc[0] += gl[0] * w0[0]; cacc[1] += gl[1] * w0[1]; cacc[2] += gl[2] * w0[2]; cacc[3] += gl[3] * w0[3]; cacc[4] += gl[4] * w1[0]; cacc[5] += gl[5] * w1[1]; cacc[6] += gl[6] * w1[2]; cacc[7] += gl[7] * w1[3];
          stf8(dp + 29 * 512, gl); }
        float sm = 0.f;
#pragma unroll
        for (int c = 0; c < 8; ++c) sm += cacc[c];
        const float mean = wave_sum(sm) * (1.f / 512.f); float s2 = 0.f;
#pragma unroll
        for (int c = 0; c < 8; ++c) { cacc[c] -= mean; s2 += cacc[c] * cacc[c]; }
        const float rstd = 1.0f / sqrtf(wave_sum(s2) * (1.f / 512.f) + LN_EPS);
        float g[8], bb[8], o[8]; ldf8(a.in(I_CLNG) + l * 512 + ch0, g); ldf8(a.in(I_CLNB) + l * 512 + ch0, bb);
#pragma unroll
        for (int c = 0; c < 8; ++c) { const float y = cacc[c] * rstd * g[c] + bb[c]; o[c] = y * sigm(y); }
        *(u32x4*)(Mr + 1024) = pack8(o);
    }
    {
        const float* sw = a.in(I_SCW) + (size_t)l * 3 * 512 + ch0;
        float w0[8], w1[8], w2[8], z0[8], z1[8], z2[8], sb[8], o[8];
        ldf8(sw, w0); ldf8(sw + 512, w1); ldf8(sw + 1024, w2);
        ldb8(Pr + 2560, z2); ldb8(Pr + 2048, sb);
        const float* sp = a.in(I_SSC) + ((size_t)(l * NSAMP + bs) * 2) * 512 + ch0;
        float* dp = out + OUT_SCS + ((size_t)(l * NSAMP + bs) * 2) * 512;
        ldf8(sp, z0); ldf8(sp + 512, z1);
        stf8(dp, z1); stf8(dp + 512, z2);
#pragma unroll
        for (int c = 0; c < 8; ++c) o[c] = sb[c] * (w0[c] * z0[c] + w1[c] * z1[c] + w2[c] * z2[c]);
        *(u32x4*)(Mr + 1536) = pack8(o);
    }
    {
        float v[8]; ldb8(Pr + 1024, v);
        float sm = 0.f;
#pragma unroll
        for (int c = 0; c < 8; ++c) sm += v[c];
        const float mean = wave_sum(sm) * (1.f / 512.f); float s2 = 0.f;
#pragma unroll
        for (int c = 0; c < 8; ++c) { v[c] -= mean; s2 += v[c] * v[c]; }
        const float rstd = 1.0f / sqrtf(wave_sum(s2) * (1.f / 512.f) + LN_EPS);
        float g[8], bb[8], u[8], o[8]; ldf8(a.in(I_GLNG) + l * 512 + ch0, g); ldf8(a.in(I_GLNB) + l * 512 + ch0, bb); ldb8(Pr + 512, u);
        const int h = lane >> 4;
        const float w00 = a.in(I_GWS)[((size_t)(l * 4 + h) * 128) * 128], b0 = a.in(I_GB)[(l * 4 + h) * 128];
#pragma unroll
        for (int c = 0; c < 8; ++c) { v[c] = v[c] * rstd * g[c] + bb[c]; o[c] = u[c] * (w00 * v[c] + b0); }
        stf8(out + OUT_GV + (size_t)(l * NSAMP + bs) * 512, v);
        *(u32x4*)(Mr + 512) = pack8(o);
    }
}

__device__ __forceinline__ void sgu_unit(const View& a, int l, int un, unsigned char* lds_g, const bf16_t* P, bf16_t* MIX, const int wv_) {
    int tid_ = MK_TID; asm volatile("" : "+v"(tid_)); const int tid = tid_, lane = tid & 63, wave = __builtin_amdgcn_readfirstlane(tid >> 6);
    const int ck = un >> 1, h0 = (un & 1) * 2; const int r0 = ck * 128;
    LAS bf16_t* V = (LAS bf16_t*)lds_g;
    {
        float g[8], bb[8]; ldf8(a.in(I_GLNG) + l * 512 + lane * 8, g); ldf8(a.in(I_GLNB) + l * 512 + lane * 8, bb);
        u32x4 vr[16];
#pragma unroll
        for (int i = 0; i < 16; ++i) vr[i] = *(const u32x4*)(P + (size_t)(r0 + wave * 16 + i) * 3072 + 1024 + lane * 8);
#pragma unroll
        for (int i = 0; i < 16; ++i) {
            const int s_ = wave * 16 + i;
            float v[8]; unpack8(vr[i], v);
            float s = 0.f;
#pragma unroll
            for (int q = 0; q < 8; ++q) s += v[q];
            const float mean = wave_sum(s) * (1.f / 512.f); float s2 = 0.f;
#pragma unroll
            for (int q = 0; q < 8; ++q) { v[q] -= mean; s2 += v[q] * v[q]; }
            const float rstd = 1.0f / sqrtf(wave_sum(s2) * (1.f / 512.f) + LN_EPS);
            if ((lane >> 5) == (h0 >> 1)) {
                LAS unsigned* dst = (LAS unsigned*)(V + ((lane >> 4) & 1) * (128 * 130) + s_ * 130 + (lane & 15) * 8);
#pragma unroll
                for (int q = 0; q < 4; ++q) dst[q] = cvt_pk_bf16(v[2 * q] * rstd * g[2 * q] + bb[2 * q], v[2 * q + 1] * rstd * g[2 * q + 1] + bb[2 * q + 1]);
            }
        }
    }
    __syncthreads();
    for (int hh = 0; hh < 2; ++hh) {
        const int h = h0 + hh; const LAS bf16_t* Vh = V + hh * (128 * 130);
        const int t0 = wave * 16, nk = (t0 + 16 + 31) >> 5, fr = lane & 15, fq = lane >> 4;
        const int t = t0 + fr;
        const float* Wrow = a.in(I_GWS) + ((size_t)(l * 4 + h) * 128 + t) * 128;
        f32x4 acc[8];
#pragma unroll
        for (int n = 0; n < 8; ++n) acc[n] = (f32x4){0.f, 0.f, 0.f, 0.f};
        for (int kk = 0; kk < nk; ++kk) {
            const int s0 = kk * 32 + fq * 8;
            float w[8]; ldf8(Wrow + s0, w);
#pragma unroll
            for (int q = 0; q < 8; ++q) if (s0 + q > t) w[q] = 0.f;
            const u32x4 wp = pack8(w);
            const bf16x8 wf = __builtin_bit_cast(bf16x8, wp);
#pragma unroll
            for (int n = 0; n < 8; ++n) {
                bf16x8 vf;
#pragma unroll
                for (int q = 0; q < 8; ++q) vf[q] = (short)Vh[(s0 + q) * 130 + n * 16 + fr];
                acc[n] = __builtin_amdgcn_mfma_f32_16x16x32_bf16(vf, wf, acc[n], 0, 0, 0);
            }
        }
        const float bias = a.in(I_GB)[(l * 4 + h) * 128 + t];
        const bf16_t* up = P + (size_t)(r0 + t) * 3072 + 512 + h * 128 + fq * 4;
        bf16_t* op = MIX + (size_t)(r0 + t) * 2048 + 512 + h * 128 + fq * 4;
#pragma unroll
        for (int n = 0; n < 8; ++n) {
            const u32x2 uu = *(const u32x2*)(up + n * 16);
            const f32x4 u4 = pg8::bflo(uu.x, uu.y);
            const f32x4 z = (acc[n] + bias) * u4;
            *(u32x2*)(op + n * 16) = (u32x2){cvt_pk_bf16(z[0], z[1]), cvt_pk_bf16(z[2], z[3])};
        }
    }
    __syncthreads();
}

__device__ __forceinline__ void samp_attn_unit(const View& a, int l, int un, unsigned char* lds_g, const bf16_t* Q, bf16_t* O, const int wv_) {
    int tid_ = MK_TID; asm volatile("" : "+v"(tid_)); const int tid = tid_, lane = tid & 63, wave = __builtin_amdgcn_readfirstlane(tid >> 6);
    const int b = un >> 2, h = un & 3;
    LAS float* S = (LAS float*)lds_g;
    LAS float* Pl = S + 256;
    LAS float* RED = S + 512;
    const size_t base = (((size_t)(l * NSAMP + b) * NMEM) * 4 + h) * 256;
    const float* Kp = a.in(I_CK) + base + 4 * lane; const float* Vp = a.in(I_CV) + base + 4 * lane;
    const u32x2 qq = *(const u32x2*)(Q + (size_t)(MP + b) * D + h * 256 + 4 * lane);
    const f32x4 q4 = pg8::bflo(qq.x, qq.y);
    for (int mm = 0; mm < 32; mm += 8) {
        f32x4 k[8];
#pragma unroll
        for (int i = 0; i < 8; ++i) k[i] = __builtin_nontemporal_load((const f32x4*)(Kp + (size_t)(wave * 32 + mm + i) * 1024));
#pragma unroll
        for (int i = 0; i < 8; ++i) { float d = (q4[0] * k[i][0] + q4[1] * k[i][1]) + (q4[2] * k[i][2] + q4[3] * k[i][3]); d = wave_sum(d); if (lane == 0) S[wave * 32 + mm + i] = d; }
    }
    __syncthreads();
    {
        const float s0 = S[lane], s1 = S[64 + lane], s2 = S[128 + lane], s3 = S[192 + lane];
        const float mx = wave_max(fmaxf(fmaxf(s0, s1), fmaxf(s2, s3)));
        const float e0 = __expf(s0 - mx), e1 = __expf(s1 - mx), e2 = __expf(s2 - mx), e3 = __expf(s3 - mx);
        const float inv = 1.0f / wave_sum((e0 + e1) + (e2 + e3));
        if (wave == 0) { Pl[lane] = e0 * inv; Pl[64 + lane] = e1 * inv; Pl[128 + lane] = e2 * inv; Pl[192 + lane] = e3 * inv; }
    }
    __syncthreads();
    {
        f32x4 o = (f32x4){0.f, 0.f, 0.f, 0.f};
        for (int mm = 0; mm < 32; mm += 8) {
            f32x4 v[8];
#pragma unroll
            for (int i = 0; i < 8; ++i) v[i] = __builtin_nontemporal_load((const f32x4*)(Vp + (size_t)(wave * 32 + mm + i) * 1024));
#pragma unroll
            for (int i = 0; i < 8; ++i) o += v[i] * Pl[wave * 32 + mm + i];
        }
        *(LAS f32x4*)(RED + wave * 256 + 4 * lane) = o;
    }
    __syncthreads();
    if (tid < 256) {
        float s = 0.f;
#pragma unroll
        for (int w = 0; w < 8; ++w) s += RED[w * 256 + tid];
        const float other = __shfl_xor(s, 1);
        if ((tid & 1) == 0) *(unsigned*)(O + (size_t)(MP + b) * D + h * 256 + tid) = cvt_pk_bf16(s, other);
    }
    __syncthreads();
}

template <int MODE>
__device__ __forceinline__ void skinny_gemm(unsigned char* lds_g, const bf16_t* A, int lda, const bf16_t* Bt, int ldb, int Kq, float* X, bf16_t* O, const bf16_t* GATE, float alpha, float sc, int G, int cid, const int wv_) {
    int tid_ = MK_TID; asm volatile("" : "+v"(tid_)); const int tid = tid_, lane = tid & 63, wave = __builtin_amdgcn_readfirstlane(tid >> 6);
    const int rg = wave & 1, kq = wave >> 1, fr = lane & 15, fq = lane >> 4, nIt = Kq >> 5;
    LAS f32x4* RED = (LAS f32x4*)lds_g;
    for (int j = cid; j < 256; j += G) {
        const int rb = j & 3, cb = j >> 2;
        const bf16_t* ap = A + (size_t)(MP + rb * 32 + rg * 16 + fr) * lda + kq * Kq + fq * 8;
        const bf16_t* bp = Bt + (size_t)(cb * 16 + fr) * ldb + kq * Kq + fq * 8;
        f32x4 acc = (f32x4){0.f, 0.f, 0.f, 0.f};
        for (int k = 0; k < nIt; k += 4) {
            bf16x8 a[4], b[4];
#pragma unroll
            for (int u = 0; u < 4; ++u) {
                if (k + u < nIt) { a[u] = *(const bf16x8*)(ap + (k + u) * 32); b[u] = *(const bf16x8*)(bp + (k + u) * 32); }
                else { a[u] = (bf16x8){0, 0, 0, 0, 0, 0, 0, 0}; b[u] = a[u]; }
            }
#pragma unroll
            for (int u = 0; u < 4; ++u) acc = __builtin_amdgcn_mfma_f32_16x16x32_bf16(b[u], a[u], acc, 0, 0, 0);
        }
        RED[(kq * 2 + rg) * 64 + lane] = acc;
        __syncthreads();
        if (kq == 0) {
            const int orow = MP + rb * 32 + rg * 16 + fr, ocol = cb * 16 + 4 * fq;
            f32x4 v;
            if (MODE == 2) {
                v = (f32x4){0.f, 0.f, 0.f, 0.f};
#pragma unroll
                for (int q = 0; q < 4; ++q) { const u32x2 gq = *(const u32x2*)(GATE + (size_t)orow * 4096 + q * 1024 + ocol); v += RED[(q * 2 + rg) * 64 + lane] * pg8::bflo(gq.x, gq.y); }
            } else {
                v = (RED[(0 * 2 + rg) * 64 + lane] + RED[(1 * 2 + rg) * 64 + lane]) + (RED[(2 * 2 + rg) * 64 + lane] + RED[(3 * 2 + rg) * 64 + lane]);
            }
            if (MODE == 0) { const u32x2 xr = *(const u32x2*)(O + (size_t)orow * 1024 + ocol); *(f32x4*)(X + (size_t)(orow - MP) * 1024 + ocol) = pg8::bflo(xr.x, xr.y) * alpha + v * sc; }
            else { *(u32x2*)(O + (size_t)orow * 1024 + ocol) = (u32x2){cvt_pk_bf16(v[0] * sc, v[1] * sc), cvt_pk_bf16(v[2] * sc, v[3] * sc)}; }
        }
        __syncthreads();
    }
}

#define XB_TMO      128
#define XB_XCNT(j)  (256  + 64 * (j))
#define XB_XSUB(j)  (1280 + 64 * (j))
#define XB_XGEN(j)  (2304 + 64 * (j))
#define XB_TOP      3328
#define XB_TOPGEN   3392
#define XCD_BAR_WORDS 3456
#define XB_SPIN_CAP (1u << 18)

__device__ __forceinline__ unsigned xb_ld(unsigned* p)              { return __hip_atomic_load(p, __ATOMIC_RELAXED, __HIP_MEMORY_SCOPE_AGENT); }
__device__ __forceinline__ unsigned xb_add(unsigned* p, unsigned v) { return __hip_atomic_fetch_add(p, v, __ATOMIC_RELAXED, __HIP_MEMORY_SCOPE_AGENT); }
__device__ __forceinline__ unsigned xb_xcc_id() { return (unsigned)__builtin_amdgcn_s_getreg((3 << 11) | 20) & 0xFu; }
#define XB_SPIN(cond, bar) do { unsigned _sp = 0; while (cond) { __builtin_amdgcn_s_sleep(1); \
    if ((++_sp & 255u) == 0u) { if (xb_ld(&(bar)[XB_TMO])) break; if (_sp > XB_SPIN_CAP) { atomicAdd(&(bar)[XB_TMO], 1u); break; } } } } while (0)

struct XcdBarrier {
    unsigned* bar; unsigned x;
    volatile LAS unsigned* st;
};

__device__ __forceinline__ XcdBarrier xcd_barrier_post(unsigned* bar, volatile LAS unsigned* st) {
    XcdBarrier b; b.bar = bar; b.x = xb_xcc_id(); b.st = st;
    if (threadIdx.x == 0) (void)xb_add(&bar[XB_XCNT(b.x)], 1u);
    return b;
}
__device__ __forceinline__ void xcd_barrier_complete(unsigned* bar, unsigned x, unsigned& nloc, unsigned& nx) {
    const unsigned G = gridDim.x * gridDim.y * gridDim.z;
    unsigned sum, cnt, mine, sp = 0u;
    for (;;) {
        sum = 0u; cnt = 0u; mine = 0u;
#pragma unroll
        for (unsigned j = 0; j < 16; ++j) { const unsigned c = xb_ld(&bar[XB_XCNT(j)]); sum += c; cnt += (c > 0u) ? 1u : 0u; mine = (j == x) ? c : mine; }
        if (sum == G) break;
        __builtin_amdgcn_s_sleep(1);
        if ((++sp & 255u) == 0u) { if (xb_ld(&bar[XB_TMO])) break; if (sp > XB_SPIN_CAP) { atomicAdd(&bar[XB_TMO], 1u); break; } }
    }
    nloc = mine > 0u ? mine : 1u; nx = cnt > 0u ? cnt : 1u;
}

__device__ __forceinline__ void xcd_barrier(const XcdBarrier& b) {
    asm volatile("s_waitcnt vmcnt(0)" ::: "memory");
    __syncthreads();
    if (threadIdx.x == 0) {
        unsigned* bar = b.bar;
        __builtin_amdgcn_s_waitcnt(0);
        unsigned nloc = b.st[0], nx = b.st[1];
        if (nloc == 0u) { xcd_barrier_complete(bar, b.x, nloc, nx); b.st[0] = nloc; b.st[1] = nx; }
        const unsigned old = xb_add(&bar[XB_XSUB(b.x)], 1u);
        const unsigned gen = old / nloc;
        if (old + 1u == (gen + 1u) * nloc) {
            __builtin_amdgcn_fence(__ATOMIC_RELEASE, "agent");
            asm volatile("s_waitcnt vmcnt(0)" ::: "memory");
            const unsigned og = xb_add(&bar[XB_TOP], 1u);
            const unsigned tg = og / nx;
            if (og + 1u == (tg + 1u) * nx) xb_add(&bar[XB_TOPGEN], 1u);
            else XB_SPIN(xb_ld(&bar[XB_TOPGEN]) == tg, bar);
            __builtin_amdgcn_fence(__ATOMIC_ACQUIRE, "agent");
            xb_add(&bar[XB_XGEN(b.x)], 1u);
            asm volatile("s_waitcnt vmcnt(0)" ::: "memory");
        } else {
            XB_SPIN(xb_ld(&bar[XB_XGEN(b.x)]) == gen, bar);
            __builtin_amdgcn_fence(__ATOMIC_ACQUIRE, "agent");
            asm volatile("s_waitcnt vmcnt(0)" ::: "memory");
        }
    }
    __syncthreads();
}


constexpr int N_PHASES = 3 + 32;

template <int PH>
__device__ __forceinline__ void run_phase(const Args& args, unsigned char* lds, const int wv_) {
    constexpr int ph = PH, l = PH >= 3 ? (PH - 3) >> 4 : 0, s = PH >= 3 ? (PH - 3) & 15 : -1;
    PG8_LAS unsigned char* L = (PG8_LAS unsigned char*)lds;
        int z0 = 0; asm volatile("s_mov_b32 %0, 0" : "=s"(z0));
        unsigned char* ws = args.ws + z0;
        int tid_ = MK_TID; asm volatile("" : "+v"(tid_)); const int tid = tid_, lane = tid & 63, wave = __builtin_amdgcn_readfirstlane(tid >> 6);
        const View vw{&args, z0, ws, args.out + z0};
        const int G = (int)gridDim.x + z0, cid = (int)blockIdx.x + z0;
        bf16_t* XB = (bf16_t*)(ws + WS_XB); float* XF = (float*)(ws + WS_XF);
        bf16_t* GATE = (bf16_t*)(ws + WS_R1); bf16_t* HB = (bf16_t*)(ws + WS_R1);
        bf16_t* PB = (bf16_t*)(ws + WS_R2); bf16_t* QB = (bf16_t*)(ws + WS_R2); bf16_t* PRB = QB + (size_t)M_PAD * D; bf16_t* OB = PRB + (size_t)M_PAD * D;
        bf16_t* MIX = (bf16_t*)(ws + WS_MIX); bf16_t* MRG = (bf16_t*)(ws + WS_MRG); bf16_t* MEMB = (bf16_t*)(ws + WS_MEMB);

        const unsigned char* WL = ws + WS_W + (size_t)l * W_LAYER;
        if constexpr (ph == 0) {
#ifndef SK0
            prologue(vw, lds, G, cid, wv_);
#endif
        }
        if constexpr (s == 8 || s == 10) {
            constexpr int nj = 1;
            for (int j = 0; j < nj; ++j) {
                pg8::Gemm g; pg8::Sched S; pg8::EpiStore E;
                if constexpr (s == 8) {
                    g = pg8::Gemm{XB, (const bf16_t*)(WL + WO_WQ), 1024, 1024, 1024};
                    S.init(MP / 256, 4, 1, G, cid); S.a_pm = (size_t)256 * 1024 * 2; S.b_pn = (size_t)256 * 1024 * 2;
                    E = pg8::EpiStore{QB, 1024, 0.0625f};
                    skinny_gemm<1>(lds, XB, 1024, (const bf16_t*)(WL + WO_WQ), 1024, 256, nullptr, QB, nullptr, 0.f, 0.0625f, G, cid, wv_);
                } else {
                    g = pg8::Gemm{PRB, (const bf16_t*)(ws + WS_VT) + (size_t)l * 1024 * 2048, 1024, 2048, 256};
                    S.init(MP / 256, 4, 1, G, cid); S.a_pm = (size_t)256 * 1024 * 2; S.a_pn = 256 * 2; S.b_pn = (size_t)256 * 2048 * 2; S.b_b = 256 * 2;
                    E = pg8::EpiStore{OB, 1024, 1.0f};
                }
#ifndef SK2
                pg8::gemm_phase<pg8::EpiStore>(L, g, S, E, wv_);
#endif
            }
            if constexpr (s == 10) {
                __syncthreads();
                for (int un = 256 + cid; un < 512; un += G) samp_attn_unit(vw, l, un, lds, QB, OB, wv_);
            }
        } else if constexpr (s == 0 || s == 13) {
            pg8::Gemm g{XB, (const bf16_t*)(WL + (s == 0 ? WO_UP1 : WO_UP2)), 1024, 1024, 1024};
            pg8::Sched S; S.init(M_PAD / 256, 22, 1, G, cid); S.a_pm = (size_t)256 * 1024 * 2; S.b_pn = (size_t)256 * 1024 * 2;
            pg8::EpiUp E{HB, FF};
#ifndef SK3
            pg8::gemm_phase<pg8::EpiUp>(L, g, S, E, wv_);
#endif
            if constexpr (s == 0) {
                constexpr int c0 = (M_PAD / 256) * 22 % 256;
                {
                    pg8::Gemm g2{MEMB, (const bf16_t*)(WL + WO_KV), 1024, 1024, 1024};
                    pg8::Sched S2; S2.init(8, 8, 1, G, (cid + G - c0 % G) % G); S2.a_pm = (size_t)256 * 1024 * 2; S2.b_pn = (size_t)256 * 1024 * 2;
                    pg8::EpiKV E2{vw.out + OUT_MK + (size_t)l * 2048 * 1024, vw.out + OUT_MV + (size_t)l * 2048 * 1024, (bf16_t*)(ws + WS_KB) + (size_t)l * 2048 * 1024};
                    pg8::gemm_phase<pg8::EpiKV>(L, g2, S2, E2, wv_);
                }
                {
                    pg8::Gemm g3{(const bf16_t*)(WL + WO_KV) + (size_t)1024 * 1024, MEMB, 1024, 1024, 1024};
                    pg8::Sched S3; S3.init(4, 8, 1, G, (cid + G - (c0 + 64) % G) % G); S3.a_pm = (size_t)256 * 1024 * 2; S3.b_pn = (size_t)256 * 1024 * 2;
                    pg8::EpiStore E3{(bf16_t*)(ws + WS_VT) + (size_t)l * 1024 * 2048, 2048, 1.0f};
                    pg8::gemm_phase<pg8::EpiStore>(L, g3, S3, E3, wv_);
                }
            }
        } else if constexpr (s == 1 || s == 14 || s == 6 || s == 11) {
            pg8::Gemm g; float sc;
            if constexpr (s == 1 || s == 14) { g = pg8::Gemm{HB, (const bf16_t*)(WL + (s == 1 ? WO_DN1 : WO_DN2)), FF, FF, FF}; sc = 0.5f; }
            else if constexpr (s == 6) { g = pg8::Gemm{MRG, (const bf16_t*)(WL + WO_WO), 1024, 1024, 1024}; sc = 1.0f; }
            else { g = pg8::Gemm{OB, (const bf16_t*)(WL + WO_AO), 1024, 1024, 1024}; sc = 1.0f; }
            pg8::Sched S; S.init(MP / 256, 4, 1, G, cid); S.a_pm = (size_t)256 * g.lda * 2; S.b_pn = (size_t)256 * g.ldb * 2;
            constexpr int which = s == 1 ? 0 : s == 6 ? 1 : s == 11 ? 2 : 3;
            constexpr int gi = which == 0 ? I_LN1G : which == 1 ? I_LN2G : which == 2 ? I_LN3G : I_LN4G;
            constexpr size_t bank_off = WS_CTL + 16384 + (size_t)(l * 4 + which) * 16384;
            typedef pg8::EpiResidLN<(which == 0 || which == 3) ? 1 : 0> EpiT;
            EpiT E{XB, vw.in(gi) + l * D, vw.in(gi + 1) + l * D, (which == 3 && l == 1) ? vw.out + OUT_Y : nullptr, ws + bank_off, (long)WS_XBUF - (long)bank_off};
            skinny_gemm<0>(lds, g.A, g.lda, g.Bt, g.ldb, g.K / 4, XF, XB, nullptr, DN_ALPHA, sc, G, cid, wv_);
#ifndef SK4
            pg8::gemm_phase<EpiT>(L, g, S, E, wv_);
#endif
        } else if constexpr (s == 2 || s == 7 || s == 12 || s == 15) {
            constexpr int gi = s == 2 ? I_LN1G : s == 7 ? I_LN2G : s == 12 ? I_LN3G : I_LN4G;
#ifndef SK5
            ln_pass_sample(XF, XB, vw.in(gi) + l * D, vw.in(gi + 1) + l * D, (s == 15 && l == 1) ? vw.out + OUT_Y : nullptr, G, cid, wv_);
#endif
        } else if constexpr (s == 3) {
            pg8::Gemm g{XB, (const bf16_t*)(WL + WO_IN), 1024, 1024, 1024};
            pg8::Sched S; S.init(M_PAD / 256, 32, 1, G, cid); S.a_pm = (size_t)256 * 1024 * 2; S.b_pn = (size_t)256 * 1024 * 2;
            pg8::EpiIn E{PB, GATE, vw.in(I_BGATE) + l * 4096};
#ifndef SK6
            pg8::gemm_phase<pg8::EpiIn>(L, g, S, E, wv_);
#endif
        } else if constexpr (s == 4) {
#ifndef SK7
            for (int un = cid; un < 256; un += G) sgu_unit(vw, l, un, lds, PB, MIX, wv_);
#endif
#ifndef SK8
            if ((MP % (G * 64)) == 0 || true) {
                __syncthreads();
                LAS float* DW = (LAS float*)((LAS unsigned char*)lds + 65536);
                LAS bf16_t* GL = (LAS bf16_t*)lds;
                const float* dwg = vw.in(I_CDW) + (size_t)l * 31 * 512;
                { f32x4 tw[8];
#pragma unroll
                  for (int u = 0; u < 8; ++u) { const int e = tid + u * NT; tw[u] = *(const f32x4*)(dwg + 4 * (e < 31 * 512 / 4 ? e : 0)); }
#pragma unroll
                  for (int u = 0; u < 8; ++u) { const int e = tid + u * NT; if (e < 31 * 512 / 4) ((LAS f32x4*)DW)[e] = tw[u]; } }
                __syncthreads();
                { const int gw = cid * NWAVES + wave; if ((gw & 15) == 5 && (gw >> 4) < NSAMP) mix_row_s(vw, l, gw >> 4, lane, PB, MIX, DW); }
                const int per = MP / G;
                for (int p0 = 0; p0 < per; p0 += 32) {
                    const int T0 = cid * per + p0, tseq = T0 & 2047;
                    __syncthreads();
                    {
                        u32x4 tw[8]; int t3 = tid; asm volatile("" : "+v"(t3));
#pragma unroll
                        for (int u = 0; u < 8; ++u) { const int e = t3 + u * NT, row = e >> 6, c16 = e & 63; tw[u] = (u32x4){0u, 0u, 0u, 0u};
                            if (e < 62 * 64 && tseq - 30 + row >= 0) tw[u] = *(const u32x4*)(PB + (size_t)(T0 - 30 + row) * 3072 + 1536 + c16 * 8); }
#pragma unroll
                        for (int u = 0; u < 8; ++u) { const int e = t3 + u * NT; if (e < 62 * 64) ((LAS u32x4*)GL)[e] = tw[u]; }
                    }
                    __syncthreads();
                    conv4_lds(vw, l, T0 + wave * 4, lane, MIX, DW, GL + (wave * 4) * 512);
                    { int tb = T0 + wave * 4; asm volatile("" : "+s"(tb));
#pragma nounroll
                      for (int i = 0; i < 4; ++i) mix_row_p<false>(vw, l, tb + i, lane, PB, MIX, DW, GL); }
                }
            }
#endif
        } else if constexpr (s == 5) {
            pg8::Gemm g{MIX, (const bf16_t*)(WL + WO_PROJ), 2048, 2048, 512};
            pg8::Sched S; S.init(MP / 256, 4, 4, G, cid); S.a_pm = (size_t)256 * 2048 * 2; S.b_pn = (size_t)256 * 2048 * 2; S.a_sub = 512 * 2; S.b_sub = 512 * 2;
            pg8::EpiBranch E{GATE, MRG};
            skinny_gemm<2>(lds, MIX, 2048, (const bf16_t*)(WL + WO_PROJ), 2048, 512, nullptr, MRG, GATE, 0.f, 1.0f, G, cid, wv_);
#ifndef SK9
            pg8::gemm_phase<pg8::EpiBranch>(L, g, S, E, wv_);
#endif
        } else if constexpr (s == 9) {
            pg8::Gemm g{QB, (const bf16_t*)(ws + WS_KB) + (size_t)l * 2048 * 1024, 1024, 1024, 256};
            pg8::Sched S; S.init(MP / 256, 4, 1, G, cid); S.a_pm = (size_t)256 * 1024 * 2; S.a_pn = 256 * 2; S.b_pn = 256 * 2; S.b_b = (size_t)256 * 1024 * 2;
            pg8::EpiSoftmax E{PRB};
#ifndef SK10
            pg8::gemm_phase<pg8::EpiSoftmax>(L, g, S, E, wv_);
#endif
            asm volatile("s_waitcnt vmcnt(0)" ::: "memory");
            __syncthreads();
            {
                pg8::Gemm g2{PRB, (const bf16_t*)(ws + WS_VT) + (size_t)l * 1024 * 2048, 1024, 2048, 256};
                pg8::Sched S2; S2.init(MP / 256, 4, 1, G, cid); S2.a_pm = (size_t)256 * 1024 * 2; S2.a_pn = 256 * 2; S2.b_pn = (size_t)256 * 2048 * 2; S2.b_b = 256 * 2;
                pg8::EpiStore E2{OB, 1024, 1.0f};
                pg8::gemm_phase<pg8::EpiStore>(L, g2, S2, E2, wv_);
            }
            __syncthreads();
#ifndef SK11
            for (int un = cid; un < 512; un += G) samp_attn_unit(vw, l, un, lds, QB, OB, wv_);
#endif
        }
}

__global__ void __launch_bounds__(NT, 2) mega_fwd(Args args) {
    extern __shared__ __attribute__((aligned(16))) unsigned char lds[];
    cg::grid_group grid = cg::this_grid();
    const int lo = args.ph_lo, hi = args.ph_hi;
    const int wv_ = __builtin_amdgcn_readfirstlane((int)threadIdx.x >> 6);
    volatile LAS unsigned* MISC = (volatile LAS unsigned*)((LAS unsigned char*)lds + LDS_BYTES - 64);
    if (threadIdx.x < 16) MISC[threadIdx.x] = 0u;
    __syncthreads();
    const XcdBarrier bar = xcd_barrier_post((unsigned*)(args.ws + WS_CTL), MISC);
#define RUN(k) if (lo <= (k) && (k) < hi) { run_phase<(k)>(args, lds, wv_); if ((k) + 1 < hi) { if ((k) == 0) grid.sync(); else xcd_barrier(bar); } }
    RUN(0)
    RUN(3) RUN(4) RUN(5) RUN(6) RUN(7) RUN(8) RUN(9) RUN(10) RUN(11) RUN(12) RUN(14) RUN(15) RUN(16) RUN(17) RUN(18)
    RUN(19) RUN(20) RUN(21) RUN(22) RUN(23) RUN(24) RUN(25) RUN(26) RUN(27) RUN(28) RUN(30) RUN(31) RUN(32) RUN(33) RUN(34)
#undef RUN
}

extern "C" void kernel_launch(void* const* d_in, const int* in_sizes, int n_in, void* d_out, int out_size, void* d_ws, size_t ws_size, hipStream_t stream) {
    static int grid = 0;
    if (grid == 0) {
        if (n_in != N_IN || (size_t)out_size != OUT_END || ws_size < WS_END) { fprintf(stderr, "kernel_launch: unexpected shapes: n_in %d out %d ws %zu (need %zu)\n", n_in, out_size, ws_size, (size_t)WS_END); grid = -1; return; }
        int dev = 0, cus = 0, per_cu = 0;
        if (hipGetDevice(&dev) != hipSuccess || hipDeviceGetAttribute(&cus, hipDeviceAttributeMultiprocessorCount, dev) != hipSuccess) { grid = -1; return; }
        if (hipFuncSetAttribute((const void*)mega_fwd, hipFuncAttributeMaxDynamicSharedMemorySize, LDS_BYTES) != hipSuccess) { fprintf(stderr, "kernel_launch: hipFuncSetAttribute failed\n"); grid = -1; return; }
        if (hipOccupancyMaxActiveBlocksPerMultiprocessor(&per_cu, (const void*)mega_fwd, NT, LDS_BYTES) != hipSuccess || per_cu < 1) { fprintf(stderr, "kernel_launch: occupancy query says %d\n", per_cu); per_cu = 1; }
        (void)hipGetLastError();
        grid = cus * 1;
    }
    if (grid < 0) return;
    Args a{};
    for (int i = 0; i < N_IN; ++i) a.in[i] = (const float*)d_in[i];
    a.out = (float*)d_out; a.ws = (unsigned char*)d_ws;
#if MK_MULTI
#ifndef MK_LAST
#define MK_LAST N_PHASES
#endif
    for (int p = 0; p < MK_LAST; ++p) {
        a.ph_lo = p; a.ph_hi = p + 1;
        hipLaunchKernelGGL(mega_fwd, dim3(grid), dim3(NT), LDS_BYTES, stream, a);
    }
#else
    a.ph_lo = 0; a.ph_hi = N_PHASES;
    if (hipMemsetAsync((char*)d_ws + WS_CTL, 0, CTL_BYTES, stream) != hipSuccess) { fprintf(stderr, "kernel_launch: memset failed\n"); return; }
    void* kargs[] = {&a};
    hipError_t e = hipLaunchCooperativeKernel((const void*)mega_fwd, dim3(grid), dim3(NT), kargs, LDS_BYTES, stream);
    if (e != hipSuccess) fprintf(stderr, "cooperative launch failed: %s (grid %d)\n", hipGetErrorString(e), grid);
#endif
}
```

```cpp
#include <hip/hip_runtime.h>
#include <hip/hip_cooperative_groups.h>
#include <cstdio>
#include <cstdint>
namespace cg = cooperative_groups;
#define MK_TID (wv_ * 64 + (int)__builtin_amdgcn_mbcnt_hi(~0u, __builtin_amdgcn_mbcnt_lo(~0u, 0u)))

#ifndef MK_MULTI
#define MK_MULTI 0
#endif

namespace pg8 {
#define PG8_LAS __attribute__((address_space(3)))
typedef unsigned short bf16_t;
typedef short bf16x8 __attribute__((ext_vector_type(8)));
typedef float f32x4 __attribute__((ext_vector_type(4)));
typedef float f32x2 __attribute__((ext_vector_type(2)));
typedef unsigned u32x4 __attribute__((ext_vector_type(4)));
typedef unsigned u32x2 __attribute__((ext_vector_type(2)));
constexpr int BM = 256, BK = 64, HALF = 128, HTB = HALF * BK * 2, STAGE_BYTES = 8 * HTB, NXCD = 8, WGM = 8;

__host__ __device__ __forceinline__ int lds_byte(int r, int c) { const int st = (r >> 4) * 2 + (c >> 5), rr = r & 15, cc = c & 31, ob = rr * 64 + cc * 2; return st * 1024 + (ob ^ (((ob >> 9) & 1) << 5)); }
__host__ __device__ __forceinline__ void stage_rc(int b, int& R, int& C) { const int st = b / 1024, sb = b % 1024, swz = sb ^ (((sb >> 9) & 1) << 5); R = (st >> 1) * 16 + swz / 64; C = (st & 1) * 32 + (swz % 64) / 2; }
__host__ __device__ __forceinline__ int perm32(int rho) { const int n = rho >> 4, i = rho & 15; return 8 * (i >> 2) + 4 * n + (i & 3); }

struct Unit { int pm, pn, aux; size_t aoff, boff; };
struct Gemm { const bf16_t* A; const bf16_t* Bt; int lda, ldb, K; };

struct Sched {
    int nM, nN, nsub, nwg, G, c;
    size_t a_pm, a_pn, a_sub, a_b, b_pn, b_sub, b_b;
    __device__ __forceinline__ void init(int nM_, int nN_, int nsub_, int G_, int c_) { nM = nM_; nN = nN_; nsub = nsub_; nwg = nM_ * nN_; G = G_; c = c_; a_pm = a_pn = a_sub = a_b = b_pn = b_sub = b_b = 0; }
    __device__ __forceinline__ bool next(int i, Unit& u) const {
        const int sub = i % nsub; const long L = (long)(i / nsub) * G + c; if (L >= nwg) return false;
        int wgid = (int)L; { const int q = nwg / NXCD, r = nwg % NXCD, xcd = wgid % NXCD, off = wgid / NXCD; wgid = (xcd < r ? xcd * (q + 1) : r * (q + 1) + (xcd - r) * q) + off; }
        const int nig = WGM * nN, gid = wgid / nig, fm = gid * WGM, gsz = (nM - fm) < WGM ? (nM - fm) : WGM;
        u.pm = fm + ((wgid % nig) % gsz); u.pn = (wgid % nig) / gsz; u.aux = sub;
        u.aoff = (size_t)u.pm * a_pm + (size_t)u.pn * a_pn + (size_t)sub * a_sub + (size_t)(u.pm >> 3) * a_b;
        u.boff = (size_t)u.pn * b_pn + (size_t)sub * b_sub + (size_t)(u.pm >> 3) * b_b;
        return true;
    }
};

typedef __bf16 bf16v2 __attribute__((ext_vector_type(2)));
__device__ __forceinline__ unsigned cvt_pk_bf16(float lo, float hi) { const f32x2 v = {lo, hi}; return __builtin_bit_cast(unsigned, __builtin_convertvector(v, bf16v2)); }
__device__ __forceinline__ float sigm(float x) { return __builtin_amdgcn_rcpf(1.f + __expf(-x)); }
__device__ __forceinline__ f32x4 sigm4(f32x4 v) { return (f32x4){sigm(v[0]), sigm(v[1]), sigm(v[2]), sigm(v[3])}; }
__device__ __forceinline__ u32x4 pack2(f32x4 v0, f32x4 v1) { u32x4 w; w.x = cvt_pk_bf16(v0[0], v0[1]); w.y = cvt_pk_bf16(v0[2], v0[3]); w.z = cvt_pk_bf16(v1[0], v1[1]); w.w = cvt_pk_bf16(v1[2], v1[3]); return w; }
__device__ __forceinline__ f32x4 bflo(unsigned a, unsigned b) { return (f32x4){__uint_as_float(a << 16), __uint_as_float(a & 0xffff0000u), __uint_as_float(b << 16), __uint_as_float(b & 0xffff0000u)}; }

typedef f32x4 Acc[2][2][4][2];

struct EpiUp {
    bf16_t* H; int ldh;
    __device__ __forceinline__ bool keep(const Unit&) const { return false; }
    __device__ __forceinline__ void operator()(Acc& acc, const Unit& u, int wr, int wc, int fr, int fq, PG8_LAS unsigned char*) const {
        const int row0 = u.pm * BM + wr * 64 + fr, col = u.pn * 128 + wc * 32 + 8 * fq;
#pragma unroll
        for (int ai = 0; ai < 2; ++ai)
#pragma unroll
            for (int m = 0; m < 4; ++m) {
                const f32x4 a0 = acc[ai][0][m][0], a1 = acc[ai][0][m][1], b0 = acc[ai][1][m][0], b1 = acc[ai][1][m][1];
                const f32x4 h0 = a0 * sigm4(a0) * b0, h1 = a1 * sigm4(a1) * b1;
                *(u32x4*)(H + (size_t)(row0 + ai * HALF + m * 16) * ldh + col) = pack2(h0, h1);
            }
    }
};
template <int HALF_SCALE>
struct EpiResidLN {
    bf16_t* XB; const float* g; const float* b; float* out; unsigned char* ctl;
    long xoff;
    __device__ __forceinline__ bool keep(const Unit&) const { return false; }
    __device__ __forceinline__ void operator()(Acc& acc, const Unit& u, int wr, int wc, int fr, int fq, PG8_LAS unsigned char* lds) const {
        constexpr float alpha = 1.41421356237f, s = HALF_SCALE ? 0.5f : 1.0f;
        unsigned long long* xbuf = (unsigned long long*)(ctl + xoff); unsigned* cnt = (unsigned*)ctl;
        PG8_LAS f32x2* P = (PG8_LAS f32x2*)(lds + STAGE_BYTES);
        PG8_LAS f32x2* S = (PG8_LAS f32x2*)(lds + STAGE_BYTES + 8192);
        const int row0 = u.pm * BM + wr * 64 + fr, col = u.pn * BM + wc * 32 + 8 * fq, wid = wr * 4 + wc, lane = fq * 16 + fr;
#pragma unroll
        for (int ai = 0; ai < 2; ++ai) {
            u32x4 xr[4][2];
#pragma unroll
            for (int m = 0; m < 4; ++m)
#pragma unroll
                for (int bj = 0; bj < 2; ++bj) xr[m][bj] = *(const u32x4*)(XB + (size_t)(row0 + ai * HALF + m * 16) * 1024 + col + bj * HALF);
#pragma unroll
            for (int m = 0; m < 4; ++m)
#pragma unroll
                for (int bj = 0; bj < 2; ++bj) { const u32x4 x = xr[m][bj];
                    acc[ai][bj][m][0] = bflo(x.x, x.y) * alpha + acc[ai][bj][m][0] * s; acc[ai][bj][m][1] = bflo(x.z, x.w) * alpha + acc[ai][bj][m][1] * s; }
            asm volatile("" ::: "memory");
        }
#pragma unroll
        for (int ai = 0; ai < 2; ++ai)
#pragma unroll
            for (int m = 0; m < 4; ++m) {
                float sm = 0.f;
#pragma unroll
                for (int bj = 0; bj < 2; ++bj)
#pragma unroll
                    for (int n = 0; n < 2; ++n) { const f32x4 x = acc[ai][bj][m][n]; sm += (x[0] + x[1]) + (x[2] + x[3]); }
                sm += __shfl_xor(sm, 16); sm += __shfl_xor(sm, 32);
                const float mw = sm * (1.0f / 64.0f); float q = 0.f;
#pragma unroll
                for (int bj = 0; bj < 2; ++bj)
#pragma unroll
                    for (int n = 0; n < 2; ++n) { const f32x4 d = acc[ai][bj][m][n] - mw; q += (d[0] * d[0] + d[1] * d[1]) + (d[2] * d[2] + d[3] * d[3]); }
                q += __shfl_xor(q, 16); q += __shfl_xor(q, 32);
                if (fq == 0) P[(ai * HALF + wr * 64 + m * 16 + fr) * 4 + wc] = (f32x2){mw, q};
            }
        asm volatile("s_waitcnt lgkmcnt(0)" ::: "memory"); __builtin_amdgcn_s_barrier(); asm volatile("" ::: "memory");
        const int row = wid * 32 + (lane & 31);
        if (lane < 32) {
            const f32x2 a = P[row * 4 + 0], bb = P[row * 4 + 1], c = P[row * 4 + 2], d = P[row * 4 + 3];
            const float mt = (a.x + bb.x + c.x + d.x) * 0.25f;
            const float da = a.x - mt, db = bb.x - mt, dc = c.x - mt, dd = d.x - mt;
            const float m2 = (a.y + bb.y) + (c.y + d.y) + 64.0f * ((da * da + db * db) + (dc * dc + dd * dd));
            unsigned long long* slot = xbuf + ((size_t)(u.pm * BM + row) * 4 + u.pn);
            __hip_atomic_store(slot, ((unsigned long long)__float_as_uint(m2) << 32) | __float_as_uint(mt), __ATOMIC_RELAXED, __HIP_MEMORY_SCOPE_AGENT);
        }
        asm volatile("s_waitcnt vmcnt(0)" ::: "memory");
        if (lane == 0) __hip_atomic_fetch_add(cnt + 64 * u.pm, 1u, __ATOMIC_RELAXED, __HIP_MEMORY_SCOPE_AGENT);
        if (wid == 0) {
            unsigned sp = 0;
            while ((unsigned)__builtin_amdgcn_readfirstlane(__hip_atomic_load(cnt + 64 * u.pm, __ATOMIC_RELAXED, __HIP_MEMORY_SCOPE_AGENT)) < 32u) { __builtin_amdgcn_s_sleep(2); if (++sp > (1u << 22)) break; }
            __builtin_amdgcn_fence(__ATOMIC_ACQUIRE, "agent");
        }
        asm volatile("s_waitcnt vmcnt(0) lgkmcnt(0)" ::: "memory"); __builtin_amdgcn_s_barrier(); asm volatile("" ::: "memory");
        if (lane < 32) {
            const unsigned long long* slot = xbuf + (size_t)(u.pm * BM + row) * 4; float mt[4], m2[4]; float ms = 0.f;
#pragma unroll
            for (int t = 0; t < 4; ++t) { const unsigned long long w = __hip_atomic_load(slot + t, __ATOMIC_RELAXED, __HIP_MEMORY_SCOPE_AGENT); mt[t] = __uint_as_float((unsigned)w); m2[t] = __uint_as_float((unsigned)(w >> 32)); ms += mt[t]; }
            const float mean = ms * 0.25f; float q = 0.f;
#pragma unroll
            for (int t = 0; t < 4; ++t) { const float dm = mt[t] - mean; q += m2[t] + 256.0f * dm * dm; }
            S[row] = (f32x2){mean, 1.0f / sqrtf(q * (1.0f / 1024.0f) + 1e-5f)};
        }
        asm volatile("s_waitcnt lgkmcnt(0)" ::: "memory"); __builtin_amdgcn_s_barrier(); asm volatile("" ::: "memory");
#pragma unroll
        for (int bj = 0; bj < 2; ++bj) {
            const f32x4 g0 = *(const f32x4*)(g + col + bj * HALF), g1 = *(const f32x4*)(g + col + bj * HALF + 4), b0 = *(const f32x4*)(b + col + bj * HALF), b1 = *(const f32x4*)(b + col + bj * HALF + 4);
#pragma unroll
            for (int ai = 0; ai < 2; ++ai)
#pragma unroll
                for (int m = 0; m < 4; ++m) {
                    const f32x2 sr = S[ai * HALF + wr * 64 + m * 16 + fr];
                    const size_t o = (size_t)(row0 + ai * HALF + m * 16) * 1024 + col + bj * HALF;
                    const f32x4 y0 = (acc[ai][bj][m][0] - sr.x) * sr.y * g0 + b0, y1 = (acc[ai][bj][m][1] - sr.x) * sr.y * g1 + b1;
                    *(u32x4*)(XB + o) = pack2(y0, y1);
                    if (out) { *(f32x4*)(out + o) = y0; *(f32x4*)(out + o + 4) = y1; }
                    asm volatile("" ::: "memory");
                }
        }
    }
};
struct EpiStore {
    bf16_t* O; int ldo; float s;
    __device__ __forceinline__ bool keep(const Unit&) const { return false; }
    __device__ __forceinline__ void operator()(Acc& acc, const Unit& u, int wr, int wc, int fr, int fq, PG8_LAS unsigned char*) const {
        const int row0 = u.pm * BM + wr * 64 + fr, col = u.pn * BM + wc * 32 + 8 * fq;
#pragma unroll
        for (int ai = 0; ai < 2; ++ai)
#pragma unroll
            for (int m = 0; m < 4; ++m) {
                bf16_t* p = O + (size_t)(row0 + ai * HALF + m * 16) * ldo + col;
#pragma unroll
                for (int bj = 0; bj < 2; ++bj) *(u32x4*)(p + bj * HALF) = pack2(acc[ai][bj][m][0] * s, acc[ai][bj][m][1] * s);
            }
    }
};
struct EpiKV {
    float* mk; float* mv; bf16_t* KB;
    __device__ __forceinline__ bool keep(const Unit&) const { return false; }
    __device__ __forceinline__ void operator()(Acc& acc, const Unit& u, int wr, int wc, int fr, int fq, PG8_LAS unsigned char*) const {
        const int row0 = u.pm * BM + wr * 64 + fr; const bool isk = u.pn < 4; const int col = (u.pn & 3) * BM + wc * 32 + 8 * fq;
        float* dst = isk ? mk : mv;
#pragma unroll
        for (int ai = 0; ai < 2; ++ai)
#pragma unroll
            for (int m = 0; m < 4; ++m) {
                const size_t o = (size_t)(row0 + ai * HALF + m * 16) * 1024 + col;
#pragma unroll
                for (int bj = 0; bj < 2; ++bj) {
                    *(f32x4*)(dst + o + bj * HALF) = acc[ai][bj][m][0]; *(f32x4*)(dst + o + bj * HALF + 4) = acc[ai][bj][m][1];
                    if (isk) *(u32x4*)(KB + o + bj * HALF) = pack2(acc[ai][bj][m][0], acc[ai][bj][m][1]);
                }
            }
    }
};
struct EpiIn {
    bf16_t* P; bf16_t* GATE; const float* bg;
    __device__ __forceinline__ bool keep(const Unit&) const { return false; }
    __device__ __forceinline__ void operator()(Acc& acc, const Unit& u, int wr, int wc, int fr, int fq, PG8_LAS unsigned char*) const {
        const int row0 = u.pm * BM + wr * 64 + fr, cw = wc * 32 + 8 * fq, pn = u.pn;
        if (pn >= 16) {
            const int col = (pn - 16) * BM + cw;
            f32x4 bv[2][2];
#pragma unroll
            for (int bj = 0; bj < 2; ++bj) { bv[bj][0] = *(const f32x4*)(bg + col + bj * HALF); bv[bj][1] = *(const f32x4*)(bg + col + bj * HALF + 4); }
#pragma unroll
            for (int ai = 0; ai < 2; ++ai)
#pragma unroll
                for (int m = 0; m < 4; ++m) {
                    bf16_t* p = GATE + (size_t)(row0 + ai * HALF + m * 16) * 4096 + col;
#pragma unroll
                    for (int bj = 0; bj < 2; ++bj) *(u32x4*)(p + bj * HALF) = pack2(sigm4(acc[ai][bj][m][0] + bv[bj][0]), sigm4(acc[ai][bj][m][1] + bv[bj][1]));
                }
        } else if ((pn >= 6 && pn < 10) || pn >= 12) {
            const bool glu = pn < 10; const int col = (glu ? 1536 + (pn - 6) * 128 : 2560 + (pn - 12) * 128) + cw;
#pragma unroll
            for (int ai = 0; ai < 2; ++ai)
#pragma unroll
                for (int m = 0; m < 4; ++m) {
                    f32x4 b0 = acc[ai][1][m][0], b1 = acc[ai][1][m][1];
                    if (glu) { b0 = sigm4(b0); b1 = sigm4(b1); }
                    *(u32x4*)(P + (size_t)(row0 + ai * HALF + m * 16) * 3072 + col) = pack2(acc[ai][0][m][0] * b0, acc[ai][0][m][1] * b1);
                }
        } else {
            const int col = (pn < 6 ? pn * BM : 2048 + (pn - 10) * BM) + cw;
#pragma unroll
            for (int ai = 0; ai < 2; ++ai)
#pragma unroll
                for (int m = 0; m < 4; ++m) {
                    bf16_t* p = P + (size_t)(row0 + ai * HALF + m * 16) * 3072 + col;
#pragma unroll
                    for (int bj = 0; bj < 2; ++bj) *(u32x4*)(p + bj * HALF) = pack2(acc[ai][bj][m][0], acc[ai][bj][m][1]);
                }
        }
    }
};
struct EpiBranch {
    const bf16_t* GATE; bf16_t* O;
    __device__ __forceinline__ bool keep(const Unit& u) const { return u.aux < 3; }
    __device__ __forceinline__ void operator()(Acc& acc, const Unit& u, int wr, int wc, int fr, int fq, PG8_LAS unsigned char*) const {
        const int row0 = u.pm * BM + wr * 64 + fr, col = u.pn * BM + wc * 32 + 8 * fq, kb = u.aux;
#pragma unroll
        for (int ai = 0; ai < 2; ++ai)
#pragma unroll
            for (int m = 0; m < 4; ++m) {
                const size_t r = (size_t)(row0 + ai * HALF + m * 16);
                const bf16_t* gp = GATE + r * 4096 + kb * 1024 + col;
#pragma unroll
                for (int bj = 0; bj < 2; ++bj) {
                    const u32x4 g = *(const u32x4*)(gp + bj * HALF);
                    f32x4 g0 = bflo(g.x, g.y), g1 = bflo(g.z, g.w);
                    if (kb < 3) {
                        const u32x4 h = *(const u32x4*)(gp + 1024 + bj * HALF);
                        const f32x4 h0 = bflo(h.x, h.y), h1 = bflo(h.z, h.w);
#pragma unroll
                        for (int j = 0; j < 4; ++j) { g0[j] = g0[j] * __builtin_amdgcn_rcpf(fmaxf(h0[j], 1e-30f)); g1[j] = g1[j] * __builtin_amdgcn_rcpf(fmaxf(h1[j], 1e-30f)); }
                        acc[ai][bj][m][0] *= g0; acc[ai][bj][m][1] *= g1;
                    } else {
                        *(u32x4*)(O + r * 1024 + col + bj * HALF) = pack2(acc[ai][bj][m][0] * g0, acc[ai][bj][m][1] * g1);
                    }
                }
            }
    }
};
struct EpiSoftmax {
    bf16_t* PR;
    __device__ __forceinline__ bool keep(const Unit&) const { return false; }
    __device__ __forceinline__ void operator()(Acc& acc, const Unit& u, int wr, int wc, int fr, int fq, PG8_LAS unsigned char* lds) const {
        PG8_LAS f32x2* X = (PG8_LAS f32x2*)(lds + STAGE_BYTES);
        const int row0 = u.pm * BM + wr * 64 + fr, col = u.pn * BM + wc * 32 + 8 * fq;
        float mxs[2][4];
#pragma unroll
        for (int ai = 0; ai < 2; ++ai)
#pragma unroll
            for (int m = 0; m < 4; ++m) {
                float mx = -3.0e38f;
#pragma unroll
                for (int bj = 0; bj < 2; ++bj)
#pragma unroll
                    for (int n = 0; n < 2; ++n) { const f32x4 v = acc[ai][bj][m][n]; mx = fmaxf(mx, fmaxf(fmaxf(v[0], v[1]), fmaxf(v[2], v[3]))); }
                mx = fmaxf(mx, __shfl_xor(mx, 16)); mx = fmaxf(mx, __shfl_xor(mx, 32));
                float sm = 0.f;
#pragma unroll
                for (int bj = 0; bj < 2; ++bj)
#pragma unroll
                    for (int n = 0; n < 2; ++n) { f32x4 v = acc[ai][bj][m][n];
#pragma unroll
                        for (int j = 0; j < 4; ++j) v[j] = __expf(v[j] - mx);
                        acc[ai][bj][m][n] = v; sm += (v[0] + v[1]) + (v[2] + v[3]); }
                sm += __shfl_xor(sm, 16); sm += __shfl_xor(sm, 32);
                mxs[ai][m] = mx;
                if (fq == 0) X[(ai * HALF + wr * 64 + m * 16 + fr) * 4 + wc] = (f32x2){mx, sm};
                asm volatile("" ::: "memory");
            }
        asm volatile("s_waitcnt lgkmcnt(0)" ::: "memory"); __builtin_amdgcn_s_barrier(); asm volatile("" ::: "memory");
#pragma unroll
        for (int ai = 0; ai < 2; ++ai)
#pragma unroll
            for (int m = 0; m < 4; ++m) {
                const int rl = ai * HALF + wr * 64 + m * 16 + fr;
                const f32x2 p0 = X[rl * 4 + 0], p1 = X[rl * 4 + 1], p2 = X[rl * 4 + 2], p3 = X[rl * 4 + 3];
                const float M = fmaxf(fmaxf(p0.x, p1.x), fmaxf(p2.x, p3.x));
                const float L = (p0.y * __expf(p0.x - M) + p1.y * __expf(p1.x - M)) + (p2.y * __expf(p2.x - M) + p3.y * __expf(p3.x - M));
                const float f = __expf(mxs[ai][m] - M) * __builtin_amdgcn_rcpf(L);
                bf16_t* p = PR + (size_t)(row0 + ai * HALF + m * 16) * 1024 + col;
#pragma unroll
                for (int bj = 0; bj < 2; ++bj) *(u32x4*)(p + bj * HALF) = pack2(acc[ai][bj][m][0] * f, acc[ai][bj][m][1] * f);
                asm volatile("" ::: "memory");
            }
        asm volatile("s_waitcnt lgkmcnt(0)" ::: "memory"); __builtin_amdgcn_s_barrier(); asm volatile("" ::: "memory");
    }
};

template <class Epi>
__device__ __forceinline__ void gemm_phase(PG8_LAS unsigned char* lds, const Gemm g, const Sched& S, const Epi& E, const int wv_) {
    int tid_ = MK_TID; asm volatile("" : "+v"(tid_)); const int tid = tid_, wid = __builtin_amdgcn_readfirstlane(tid >> 6), lane = tid & 63, wr = wid >> 2, wc = wid & 3, fr = lane & 15, fq = lane >> 4;
    const int nt = g.K / BK;
    unsigned voffA[2], voffB[2];
#pragma unroll
    for (int i = 0; i < 2; ++i) { int R, C; stage_rc(tid * 16 + i * 8192, R, C); const int Rb = (R & ~31) + perm32(R & 31);
        voffA[i] = (unsigned)(R * g.lda + C) * 2u; voffB[i] = (unsigned)(Rb * g.ldb + C) * 2u; }
    const size_t kstep = (size_t)(BK * 2);
    const size_t hstepA = (size_t)HALF * g.lda * 2, hstepB = (size_t)HALF * g.ldb * 2;
    const unsigned ldsw = (unsigned)wid * 1024u;
    const int aoff = lds_byte(wr * 64 + fr, fq * 8), boff = lds_byte(wc * 32 + fr, fq * 8);
#define PG8_SA(b, h) (((b) * 2 + (h)) * HTB)
#define PG8_SB(b, h) ((4 + (b) * 2 + (h)) * HTB)
#define PG8_STAGE(bufoff, gbase, voff) do { _Pragma("unroll") for (int _i = 0; _i < 2; ++_i) \
        __builtin_amdgcn_global_load_lds((const unsigned*)((const char*)(gbase) + (voff)[_i]), (PG8_LAS unsigned*)(lds + (bufoff) + ldsw + _i * 8192), 16, 0, 0); } while (0)
#define PG8_LDA(dst, b, h) do { _Pragma("unroll") for (int m = 0; m < 4; ++m) _Pragma("unroll") for (int k = 0; k < 2; ++k) dst[m][k] = *(const PG8_LAS bf16x8*)(lds + PG8_SA(b, h) + aoff + m * 2048 + k * 1024); } while (0)
#define PG8_LDB(dst, b, h) do { _Pragma("unroll") for (int n = 0; n < 2; ++n) _Pragma("unroll") for (int k = 0; k < 2; ++k) dst[n][k] = *(const PG8_LAS bf16x8*)(lds + PG8_SB(b, h) + boff + n * 2048 + k * 1024); } while (0)
#define PG8_MMA(ai, bj, At, Bt) do { __builtin_amdgcn_s_setprio(1); _Pragma("unroll") for (int m = 0; m < 4; ++m) _Pragma("unroll") for (int n = 0; n < 2; ++n) _Pragma("unroll") for (int k = 0; k < 2; ++k) \
        acc[ai][bj][m][n] = __builtin_amdgcn_mfma_f32_16x16x32_bf16(Bt[n][k], At[m][k], acc[ai][bj][m][n], 0, 0, 0); __builtin_amdgcn_s_setprio(0); } while (0)
#define PG8_WAIT_V(n) asm volatile("s_waitcnt vmcnt(" #n ")" ::: "memory")
#define PG8_WAIT_L(n) asm volatile("s_waitcnt lgkmcnt(" #n ")" ::: "memory")
#define PG8_BAR __builtin_amdgcn_s_barrier()
#define PG8_SCHED __builtin_amdgcn_sched_barrier(0)
#define PG8_ZERO do { _Pragma("unroll") for (int a = 0; a < 2; ++a) _Pragma("unroll") for (int b = 0; b < 2; ++b) _Pragma("unroll") for (int m = 0; m < 4; ++m) _Pragma("unroll") for (int n = 0; n < 2; ++n) acc[a][b][m][n] = (f32x4){0.f, 0.f, 0.f, 0.f}; } while (0)
    Unit cur, nxt; int ui = 0;
    if (!S.next(0, cur)) return;
    Acc acc;
    PG8_ZERO;
    bf16x8 At[4][2], B0[2][2], B1[2][2];
    const char* cA = (const char*)g.A + cur.aoff; const char* cB = (const char*)g.Bt + cur.boff;
    PG8_STAGE(PG8_SB(0, 0), cB, voffB); PG8_STAGE(PG8_SB(0, 1), cB + hstepB, voffB); PG8_STAGE(PG8_SA(0, 0), cA, voffA); PG8_STAGE(PG8_SA(0, 1), cA + hstepA, voffA);
    if (wr == 1) PG8_BAR;
    PG8_WAIT_V(2); PG8_BAR;
    PG8_STAGE(PG8_SB(1, 0), cB + kstep, voffB); PG8_STAGE(PG8_SA(1, 0), cA + kstep, voffA); PG8_STAGE(PG8_SB(1, 1), cB + hstepB + kstep, voffB);
    PG8_WAIT_V(6); PG8_BAR;
    for (;;) {
        const bool has_next = S.next(ui + 1, nxt);
        const char* nA = has_next ? (const char*)g.A + nxt.aoff : cA; const char* nB = has_next ? (const char*)g.Bt + nxt.boff : cB;
        for (int t = 0; t < nt; t += 2) {
            const bool last = (t == nt - 2);
            const char* a1 = cA + (size_t)(t + 1) * kstep;
            const char* a2 = last ? nA : cA + (size_t)(t + 2) * kstep; const char* b2 = last ? nB : cB + (size_t)(t + 2) * kstep;
            const char* a3 = a2 + kstep; const char* b3 = b2 + kstep;
            PG8_LDB(B0, 0, 0); PG8_LDB(B1, 0, 1); PG8_SCHED; PG8_LDA(At, 0, 0); PG8_STAGE(PG8_SA(1, 1), a1 + hstepA, voffA);
            PG8_WAIT_V(8); PG8_WAIT_L(0); PG8_BAR; PG8_MMA(0, 0, At, B0); PG8_MMA(0, 1, At, B1); PG8_BAR; PG8_SCHED;
            PG8_LDA(At, 0, 1); PG8_STAGE(PG8_SB(0, 0), b2, voffB); PG8_STAGE(PG8_SB(0, 1), b2 + hstepB, voffB); PG8_STAGE(PG8_SA(0, 0), a2, voffA);
            PG8_WAIT_V(8); PG8_WAIT_L(0); PG8_BAR; PG8_MMA(1, 0, At, B0); PG8_MMA(1, 1, At, B1); PG8_BAR; PG8_SCHED;
            PG8_LDB(B0, 1, 0); PG8_LDB(B1, 1, 1); PG8_SCHED; PG8_LDA(At, 1, 0); PG8_STAGE(PG8_SA(0, 1), a2 + hstepA, voffA);
            PG8_WAIT_V(8); PG8_WAIT_L(0); PG8_BAR; PG8_MMA(0, 0, At, B0); PG8_MMA(0, 1, At, B1); PG8_BAR; PG8_SCHED;
            PG8_LDA(At, 1, 1); PG8_STAGE(PG8_SB(1, 0), b3, voffB); PG8_STAGE(PG8_SB(1, 1), b3 + hstepB, voffB); PG8_STAGE(PG8_SA(1, 0), a3, voffA);
            PG8_WAIT_V(8); PG8_WAIT_L(0); PG8_BAR; PG8_MMA(1, 0, At, B0); PG8_MMA(1, 1, At, B1); PG8_BAR; PG8_SCHED;
        }
        if (wr == 0) PG8_BAR;
        PG8_WAIT_V(0);
        { int te = tid; asm volatile("" : "+v"(te));
          E(acc, cur, (te >> 8) & 1, (te >> 6) & 3, te & 15, (te >> 4) & 3, lds); }
        if (!has_next) break;
        if (!E.keep(cur)) PG8_ZERO;
        cur = nxt; cA = nA; cB = nB; ++ui;
        if (wr == 1) PG8_BAR;
    }
    PG8_WAIT_V(0);
    PG8_BAR;
#undef PG8_SA
#undef PG8_SB
#undef PG8_STAGE
#undef PG8_LDA
#undef PG8_LDB
#undef PG8_MMA
#undef PG8_WAIT_V
#undef PG8_WAIT_L
#undef PG8_BAR
#undef PG8_SCHED
#undef PG8_ZERO
}
}

using pg8::bf16_t; using pg8::f32x4; using pg8::u32x4; using pg8::u32x2; using pg8::bf16x8; using pg8::cvt_pk_bf16; using pg8::sigm;

constexpr int NWAVES = 8, NT = 512;
constexpr int D = 1024, MP = 16384, NSAMP = 128, M_TOK = MP + NSAMP, M_PAD = 16640, SEQ = 2048, NB = 8, FF = 2816, NMEM = 256;
constexpr float DN_ALPHA = 1.41421356237f, LN_EPS = 1e-5f;
constexpr size_t OUT_Y = 0, OUT_POOLP = 16908288, OUT_CONVP = 17031168, OUT_SCP = 17276928, OUT_MK = 17293312, OUT_MV = 21487616,
                 OUT_POOLS = 25681920, OUT_CONVS = 27648000, OUT_SCS = 31580160, OUT_GV = 31842304, OUT_END = 31973376;
constexpr size_t MiB = 1u << 20;
constexpr size_t WO_UP1 = 0, WO_DN1 = WO_UP1 + (size_t)5632 * 1024 * 2, WO_IN = WO_DN1 + (size_t)1024 * 2816 * 2, WO_PROJ = WO_IN + (size_t)8192 * 1024 * 2,
                 WO_WO = WO_PROJ + (size_t)1024 * 2048 * 2, WO_WQ = WO_WO + (size_t)1024 * 1024 * 2, WO_KV = WO_WQ + (size_t)1024 * 1024 * 2, WO_AO = WO_KV + (size_t)2048 * 1024 * 2,
                 WO_UP2 = WO_AO + (size_t)1024 * 1024 * 2, WO_DN2 = WO_UP2 + (size_t)5632 * 1024 * 2, W_LAYER = WO_DN2 + (size_t)1024 * 2816 * 2;
constexpr size_t WS_CTL = 0, CTL_BYTES = 16384 + 8 * 16384;
constexpr size_t WS_XBUF = 256 * 1024;
constexpr size_t WS_W = 1 * MiB, WS_XB = WS_W + 2 * W_LAYER, WS_XF = WS_XB + (size_t)M_PAD * 1024 * 2, WS_R1 = WS_XF + (size_t)M_PAD * 1024 * 4,
                 WS_R2 = WS_R1 + (size_t)M_PAD * 4096 * 2, WS_MIX = WS_R2 + (size_t)M_PAD * 3072 * 2, WS_MRG = WS_MIX + (size_t)M_PAD * 2048 * 2,
                 WS_MEMB = WS_MRG + (size_t)M_PAD * 1024 * 2, WS_KB = WS_MEMB + (size_t)2048 * 1024 * 2, WS_VT = WS_KB + (size_t)2 * 2048 * 1024 * 2, WS_END = WS_VT + (size_t)2 * 2048 * 1024 * 2;
static_assert(W_LAYER % 256 == 0, "align");
constexpr int LDS_BYTES = 147456;

enum { I_XP = 0, I_XS, I_MEM, I_SPOOL, I_SCONV, I_SSC, I_CK, I_CV, I_LN1G, I_LN1B, I_F1W1, I_F1W3, I_F1W2, I_WIN, I_WGATE, I_BGATE, I_POOLW, I_POOLS, I_POOLP,
       I_GLNG, I_GLNB, I_GWS, I_GB, I_GPROJ, I_CDW, I_CDB, I_CLNG, I_CLNB, I_CPROJ, I_SCW, I_SCPROJ, I_WO, I_LN2G, I_LN2B, I_WQ, I_WK, I_WV, I_XWO, I_LN3G, I_LN3B,
       I_F2W1, I_F2W3, I_F2W2, I_LN4G, I_LN4B, N_IN };

struct Args { const float* in[N_IN]; float* out; unsigned char* ws; int ph_lo, ph_hi; };
struct View { const Args* a; int z; unsigned char* ws; float* out; __device__ __forceinline__ const float* in(int i) const { return a->in[i + z]; } };

#define LAS __attribute__((address_space(3)))
__device__ __forceinline__ float wave_sum(float v) {
#pragma unroll
    for (int o = 1; o < 64; o <<= 1) v += __shfl_xor(v, o);
    return v;
}
__device__ __forceinline__ float wave_max(float v) {
#pragma unroll
    for (int o = 1; o < 64; o <<= 1) v = fmaxf(v, __shfl_xor(v, o));
    return v;
}
__device__ __forceinline__ void unpack8(u32x4 w, float (&f)[8]) {
    f[0] = __uint_as_float(w.x << 16); f[1] = __uint_as_float(w.x & 0xffff0000u); f[2] = __uint_as_float(w.y << 16); f[3] = __uint_as_float(w.y & 0xffff0000u);
    f[4] = __uint_as_float(w.z << 16); f[5] = __uint_as_float(w.z & 0xffff0000u); f[6] = __uint_as_float(w.w << 16); f[7] = __uint_as_float(w.w & 0xffff0000u);
}
__device__ __forceinline__ u32x4 pack8(const float (&f)[8]) { u32x4 w; w.x = cvt_pk_bf16(f[0], f[1]); w.y = cvt_pk_bf16(f[2], f[3]); w.z = cvt_pk_bf16(f[4], f[5]); w.w = cvt_pk_bf16(f[6], f[7]); return w; }
__device__ __forceinline__ void ldf8(const float* p, float (&f)[8]) { const f32x4 a = *(const f32x4*)p, b = *(const f32x4*)(p + 4); f[0] = a[0]; f[1] = a[1]; f[2] = a[2]; f[3] = a[3]; f[4] = b[0]; f[5] = b[1]; f[6] = b[2]; f[7] = b[3]; }
__device__ __forceinline__ void stf8(float* p, const float (&f)[8]) { *(f32x4*)p = (f32x4){f[0], f[1], f[2], f[3]}; *(f32x4*)(p + 4) = (f32x4){f[4], f[5], f[6], f[7]}; }
__device__ __forceinline__ void ldb8(const bf16_t* p, float (&f)[8]) { unpack8(*(const u32x4*)p, f); }

__device__ __forceinline__ void transpose_item(const float* W, int N, bf16_t* WT, int ldd, int koff, int k0, int n0, int drow0, LAS float* scr, int lane) {
    float wreg[32];
#pragma unroll
    for (int i = 0; i < 32; ++i) { const int kk = 2 * i + (lane >> 5); wreg[i] = __builtin_nontemporal_load(W + (size_t)(k0 + kk) * N + n0 + (lane & 31)); }
#pragma unroll
    for (int i = 0; i < 32; ++i) { const int kk = 2 * i + (lane >> 5); scr[kk * 33 + (lane & 31)] = wreg[i]; }
    asm volatile("s_waitcnt lgkmcnt(0)" ::: "memory");
    const int c = lane & 7;
#pragma unroll
    for (int j = 0; j < 4; ++j) { const int n = (lane >> 3) + 8 * j; const LAS float* s = scr + (8 * c) * 33 + n;
        u32x4 o; o.x = cvt_pk_bf16(s[0 * 33], s[1 * 33]); o.y = cvt_pk_bf16(s[2 * 33], s[3 * 33]); o.z = cvt_pk_bf16(s[4 * 33], s[5 * 33]); o.w = cvt_pk_bf16(s[6 * 33], s[7 * 33]);
        *(u32x4*)(WT + (size_t)(drow0 + n) * ldd + koff + k0 + 8 * c) = o; }
    asm volatile("s_waitcnt lgkmcnt(0)" ::: "memory");
}
__device__ __forceinline__ int map_pair(int n0, int half) { return 256 * (n0 >> 7) + 128 * half + (n0 & 127); }
__device__ __forceinline__ int map_win(int n0) {
    const int seg = n0 >> 9, o = n0 & 511;
    switch (seg) { case 0: case 1: case 2: return n0;
        case 3: return 1536 + map_pair(o, 0); case 4: return 1536 + map_pair(o, 1); case 5: return 2560 + o;
        case 6: return 3072 + map_pair(o, 0); default: return 3072 + map_pair(o, 1); }
}
#define NJOBS 16
template <int J> struct TJ;
#define DEF_TJ(J, SRC, K_, N_, LDD, KOFF, MAP, DST) template <> struct TJ<J> { static constexpr int src = SRC, K = K_, N = N_, ldd = LDD, koff = KOFF, map = MAP, items = (K_ / 64) * (N_ / 32); static constexpr size_t dst = DST; };
DEF_TJ(0, I_F1W1, 1024, 2816, 1024, 0, 1, WO_UP1)
DEF_TJ(1, I_F1W3, 1024, 2816, 1024, 0, 2, WO_UP1)
DEF_TJ(2, I_F1W2, 2816, 1024, 2816, 0, 0, WO_DN1)
DEF_TJ(3, I_WIN, 1024, 4096, 1024, 0, 3, WO_IN)
DEF_TJ(4, I_WGATE, 1024, 4096, 1024, 0, 4, WO_IN)
DEF_TJ(5, I_GPROJ, 512, 1024, 2048, 512, 0, WO_PROJ)
DEF_TJ(6, I_CPROJ, 512, 1024, 2048, 1024, 0, WO_PROJ)
DEF_TJ(7, I_SCPROJ, 512, 1024, 2048, 1536, 0, WO_PROJ)
DEF_TJ(8, I_WO, 1024, 1024, 1024, 0, 0, WO_WO)
DEF_TJ(9, I_WQ, 1024, 1024, 1024, 0, 0, WO_WQ)
DEF_TJ(10, I_WK, 1024, 1024, 1024, 0, 0, WO_KV)
DEF_TJ(11, I_WV, 1024, 1024, 1024, 0, 5, WO_KV)
DEF_TJ(12, I_XWO, 1024, 1024, 1024, 0, 0, WO_AO)
DEF_TJ(13, I_F2W1, 1024, 2816, 1024, 0, 1, WO_UP2)
DEF_TJ(14, I_F2W3, 1024, 2816, 1024, 0, 2, WO_UP2)
DEF_TJ(15, I_F2W2, 2816, 1024, 2816, 0, 0, WO_DN2)
template <int J> __device__ __forceinline__ void run_tjob(const View& a, LAS float* scr, int lane, int gw, int NGW, int& base) {
    typedef TJ<J> T;
    const float* W0 = a.in(T::src); unsigned char* wsW = a.ws + WS_W + T::dst;
    int r = (gw - base) % NGW; if (r < 0) r += NGW;
    for (; r < 2 * T::items; r += NGW) {
        const int l = r / T::items, q = r % T::items;
        constexpr int nblk = T::N / 32; const int kb = q / nblk, nb = q % nblk, n0 = nb * 32;
        int drow;
        if (T::map == 0) drow = n0; else if (T::map == 1) drow = map_pair(n0, 0); else if (T::map == 2) drow = map_pair(n0, 1); else if (T::map == 3) drow = map_win(n0); else if (T::map == 4) drow = 4096 + n0; else drow = 1024 + n0;
        transpose_item(W0 + (size_t)l * T::K * T::N, T::N, (bf16_t*)(wsW + (size_t)l * W_LAYER), T::ldd, T::koff, kb * 64, n0, drow, scr, lane);
    }
    base = (base + 2 * T::items) % NGW;
}

__device__ __forceinline__ void prologue(const View& a, unsigned char* lds_g, int G, int cid, const int wv_) {
    int tid_ = MK_TID; asm volatile("" : "+v"(tid_)); const int tid = tid_, lane = tid & 63, wave = __builtin_amdgcn_readfirstlane(tid >> 6);
    const int gw = cid * NWAVES + wave, NGW = G * NWAVES;
    LAS float* scr = (LAS float*)((LAS unsigned char*)lds_g + wave * 16384);
    { int base = 0;
      run_tjob<0>(a, scr, lane, gw, NGW, base); run_tjob<1>(a, scr, lane, gw, NGW, base); run_tjob<2>(a, scr, lane, gw, NGW, base); run_tjob<3>(a, scr, lane, gw, NGW, base);
      run_tjob<4>(a, scr, lane, gw, NGW, base); run_tjob<5>(a, scr, lane, gw, NGW, base); run_tjob<6>(a, scr, lane, gw, NGW, base); run_tjob<7>(a, scr, lane, gw, NGW, base);
      run_tjob<8>(a, scr, lane, gw, NGW, base); run_tjob<9>(a, scr, lane, gw, NGW, base); run_tjob<10>(a, scr, lane, gw, NGW, base); run_tjob<11>(a, scr, lane, gw, NGW, base);
      run_tjob<12>(a, scr, lane, gw, NGW, base); run_tjob<13>(a, scr, lane, gw, NGW, base); run_tjob<14>(a, scr, lane, gw, NGW, base); run_tjob<15>(a, scr, lane, gw, NGW, base); }
    for (int it = gw; it < 2048; it += NGW) {
        const int l = it >> 10, k0 = ((it >> 4) & 63) * 8, g = k0 >> 7, n = (it & 15) * 64 + lane;
        const float* pw = a.in(I_POOLW) + ((size_t)l * 512 + k0) * 128;
        const float* sc = a.in(I_POOLS) + l * 512 + g * 128;
        const float* pp = a.in(I_POOLP) + ((size_t)l * 512 + g * 128) * 1024 + n;
        float acc[8];
#pragma unroll
        for (int kk = 0; kk < 8; ++kk) acc[kk] = 0.f;
#pragma unroll 2
        for (int d = 0; d < 128; d += 4) {
            float p[4];
#pragma unroll
            for (int q = 0; q < 4; ++q) p[q] = pp[(size_t)(d + q) * 1024] * sc[d + q];
#pragma unroll
            for (int kk = 0; kk < 8; ++kk) { const f32x4 w = *(const f32x4*)(pw + kk * 128 + d); acc[kk] += (w[0] * p[0] + w[1] * p[1]) + (w[2] * p[2] + w[3] * p[3]); }
        }
        *(u32x4*)((bf16_t*)(a.ws + WS_W + (size_t)l * W_LAYER + WO_PROJ) + (size_t)n * 2048 + k0) = pack8(acc);
    }
    bf16_t* XB = (bf16_t*)(a.ws + WS_XB); bf16_t* MEMB = (bf16_t*)(a.ws + WS_MEMB);
    for (int r = gw; r < M_PAD + 2048; r += NGW) {
        if (r < M_PAD) {
            const float* src = r < MP ? a.in(I_XP) + (size_t)r * D : a.in(I_XS) + (size_t)(r - MP) * D;
#pragma unroll
            for (int j = 0; j < 4; ++j) {
                f32x4 v = (f32x4){0.f, 0.f, 0.f, 0.f};
                if (r < M_TOK) v = __builtin_nontemporal_load((const f32x4*)(src + 256 * j + 4 * lane));
                *(u32x2*)(XB + (size_t)r * D + 256 * j + 4 * lane) = (u32x2){cvt_pk_bf16(v[0], v[1]), cvt_pk_bf16(v[2], v[3])};
            }
        } else {
            const int m = r - M_PAD; const float* src = a.in(I_MEM) + (size_t)m * D;
#pragma unroll
            for (int j = 0; j < 4; ++j) { const f32x4 v = __builtin_nontemporal_load((const f32x4*)(src + 256 * j + 4 * lane));
                *(u32x2*)(MEMB + (size_t)m * D + 256 * j + 4 * lane) = (u32x2){cvt_pk_bf16(v[0], v[1]), cvt_pk_bf16(v[2], v[3])}; }
        }
    }
}

__device__ __forceinline__ void ln_pass_sample(const float* Ys, bf16_t* XB, const float* g, const float* b, float* out, int G, int cid, const int wv_) {
    int tid_ = MK_TID; asm volatile("" : "+v"(tid_)); const int tid = tid_, lane = tid & 63, wave = __builtin_amdgcn_readfirstlane(tid >> 6);
    const int gw = cid * NWAVES + wave, NGW = G * NWAVES;
    for (int r = gw; r < NSAMP; r += NGW) {
        const float* xr = Ys + (size_t)r * D + 4 * lane;
        f32x4 v[4]; float s = 0.f;
#pragma unroll
        for (int j = 0; j < 4; ++j) { v[j] = *(const f32x4*)(xr + 256 * j); s += (v[j][0] + v[j][1]) + (v[j][2] + v[j][3]); }
        const float mean = wave_sum(s) * (1.f / D); float s2 = 0.f;
#pragma unroll
        for (int j = 0; j < 4; ++j) { v[j] = v[j] - mean; s2 += (v[j][0] * v[j][0] + v[j][1] * v[j][1]) + (v[j][2] * v[j][2] + v[j][3] * v[j][3]); }
        const float rstd = 1.0f / sqrtf(wave_sum(s2) * (1.f / D) + LN_EPS);
#pragma unroll
        for (int j = 0; j < 4; ++j) {
            const f32x4 y = v[j] * rstd * *(const f32x4*)(g + 256 * j + 4 * lane) + *(const f32x4*)(b + 256 * j + 4 * lane);
            *(u32x2*)(XB + (size_t)(MP + r) * D + 256 * j + 4 * lane) = (u32x2){cvt_pk_bf16(y[0], y[1]), cvt_pk_bf16(y[2], y[3])};
            if (out) *(f32x4*)(out + (size_t)(MP + r) * D + 256 * j + 4 * lane) = y;
        }
    }
}

template <bool DO_C>
__device__ __forceinline__ void mix_row_p(const View& a, int l, int r, int lane, const bf16_t* P, bf16_t* MIX, const LAS float* DW, const LAS bf16_t* GLrow) {
    const int ch0 = lane * 8, b = r >> 11, t = r & 2047;
    const bf16_t* Pr = P + (size_t)r * 3072 + ch0; bf16_t* Mr = MIX + (size_t)r * 2048 + ch0; float* out = a.out + ch0;
    {
        const int win = 2 << (lane >> 4);
        float av[8], sacc[8]; ldb8(Pr, av);
#pragma unroll
        for (int c = 0; c < 8; ++c) sacc[c] = av[c];
        u32x4 x[15];
#pragma unroll
        for (int i = 1; i < 16; ++i) { const int dr = i > t ? t : i; x[i - 1] = *(const u32x4*)(Pr - (ptrdiff_t)dr * 3072); }
#pragma unroll
        for (int i = 1; i < 16; ++i) { float f[8]; unpack8(x[i - 1], f); const float mk = (i < win && i <= t) ? 1.f : 0.f;
#pragma unroll
            for (int c = 0; c < 8; ++c) sacc[c] += f[c] * mk; }
        const int cnt = t + 1 < win ? t + 1 : win; const float inv = 1.0f / (float)cnt; float o[8];
#pragma unroll
        for (int c = 0; c < 8; ++c) o[c] = sacc[c] * inv - av[c];
        *(u32x4*)(Mr) = pack8(o);
        if (t >= SEQ - 15) stf8(out + OUT_POOLP + ((size_t)(l * NB + b) * 15 + (t - (SEQ - 15))) * 512, av);
    }
    asm volatile("" ::: "memory");
    if constexpr (DO_C) {
        float cacc[8]; ldf8(a.in(I_CDB) + l * 512 + ch0, cacc);
#pragma unroll
        for (int jb = 0; jb < 31; jb += 8) {
            u32x4 x[8];
#pragma unroll
            for (int u = 0; u < 8; ++u) { const int j = jb + u; if (j < 31) x[u] = *(const LAS u32x4*)(GLrow - (30 - j) * 512 + ch0); }
#pragma unroll
            for (int u = 0; u < 8; ++u) { const int j = jb + u; if (j < 31) {
                float f[8]; unpack8(x[u], f); const float mk = (30 - j <= t) ? 1.f : 0.f;
                const f32x4 w0 = *(const LAS f32x4*)(DW + j * 512 + ch0) * mk, w1 = *(const LAS f32x4*)(DW + j * 512 + ch0 + 4) * mk;
                cacc[0] += f[0] * w0[0]; cacc[1] += f[1] * w0[1]; cacc[2] += f[2] * w0[2]; cacc[3] += f[3] * w0[3];
                cacc[4] += f[4] * w1[0]; cacc[5] += f[5] * w1[1]; cacc[6] += f[6] * w1[2]; cacc[7] += f[7] * w1[3];
            } }
            asm volatile("" ::: "memory");
        }
        float sm = 0.f;
#pragma unroll
        for (int c = 0; c < 8; ++c) sm += cacc[c];
        const float mean = wave_sum(sm) * (1.f / 512.f); float s2 = 0.f;
#pragma unroll
        for (int c = 0; c < 8; ++c) { cacc[c] -= mean; s2 += cacc[c] * cacc[c]; }
        const float rstd = 1.0f / sqrtf(wave_sum(s2) * (1.f / 512.f) + LN_EPS);
        float g[8], bb[8], o[8]; ldf8(a.in(I_CLNG) + l * 512 + ch0, g); ldf8(a.in(I_CLNB) + l * 512 + ch0, bb);
#pragma unroll
        for (int c = 0; c < 8; ++c) { const float y = cacc[c] * rstd * g[c] + bb[c]; o[c] = y * sigm(y); }
        *(u32x4*)(Mr + 1024) = pack8(o);
        if (t >= SEQ - 30) { float gl[8]; ldb8(Pr + 1536, gl); stf8(out + OUT_CONVP + ((size_t)(l * NB + b) * 30 + (t - (SEQ - 30))) * 512, gl); }
    }
    {
        const float* sw = a.in(I_SCW) + (size_t)l * 3 * 512 + ch0;
        float w0[8], w1[8], w2[8], z0[8], z1[8], z2[8], sb[8], o[8];
        ldf8(sw, w0); ldf8(sw + 512, w1); ldf8(sw + 1024, w2);
        const u32x4 xz2 = *(const u32x4*)(Pr + 2560), xsb = *(const u32x4*)(Pr + 2048);
        const u32x4 xz1 = *(const u32x4*)(Pr - (ptrdiff_t)(t >= 1 ? 1 : 0) * 3072 + 2560), xz0 = *(const u32x4*)(Pr - (ptrdiff_t)(t >= 2 ? 2 : 0) * 3072 + 2560);
        unpack8(xz2, z2); unpack8(xsb, sb); unpack8(xz1, z1); unpack8(xz0, z0);
        const float m1 = t >= 1 ? 1.f : 0.f, m0 = t >= 2 ? 1.f : 0.f;
#pragma unroll
        for (int c = 0; c < 8; ++c) o[c] = sb[c] * (w0[c] * z0[c] * m0 + w1[c] * z1[c] * m1 + w2[c] * z2[c]);
        *(u32x4*)(Mr + 1536) = pack8(o);
        if (t >= SEQ - 2) stf8(out + OUT_SCP + ((size_t)(l * NB + b) * 2 + (t - (SEQ - 2))) * 512, z2);
    }
}

__device__ __forceinline__ void conv4_lds(const View& a, int l, int r0, int lane, bf16_t* MIX, const LAS float* DW, const LAS bf16_t* GLw) {
    const int ch0 = lane * 8;
    float cacc[4][8];
    { float db[8]; ldf8(a.in(I_CDB) + l * 512 + ch0, db);
#pragma unroll
      for (int i = 0; i < 4; ++i)
#pragma unroll
          for (int c = 0; c < 8; ++c) cacc[i][c] = db[c]; }
    float wv[4][8];
#pragma unroll
    for (int q = 0; q < 34; ++q) {
        if (q <= 30) { const f32x4 w0 = *(const LAS f32x4*)(DW + q * 512 + ch0), w1 = *(const LAS f32x4*)(DW + q * 512 + ch0 + 4);
            wv[q & 3][0] = w0[0]; wv[q & 3][1] = w0[1]; wv[q & 3][2] = w0[2]; wv[q & 3][3] = w0[3]; wv[q & 3][4] = w1[0]; wv[q & 3][5] = w1[1]; wv[q & 3][6] = w1[2]; wv[q & 3][7] = w1[3]; }
        float f[8]; unpack8(*(const LAS u32x4*)(GLw + q * 512 + ch0), f);
#pragma unroll
        for (int i = 0; i < 4; ++i) { const int j = q - i; if (j >= 0 && j <= 30) {
#pragma unroll
                for (int c = 0; c < 8; ++c) cacc[i][c] += f[c] * wv[j & 3][c]; } }
    }
    float g[8], bb[8]; ldf8(a.in(I_CLNG) + l * 512 + ch0, g); ldf8(a.in(I_CLNB) + l * 512 + ch0, bb);
#pragma unroll
    for (int i = 0; i < 4; ++i) {
        float sm = 0.f;
#pragma unroll
        for (int c = 0; c < 8; ++c) sm += cacc[i][c];
        const float mean = wave_sum(sm) * (1.f / 512.f); float s2 = 0.f;
#pragma unroll
        for (int c = 0; c < 8; ++c) { cacc[i][c] -= mean; s2 += cacc[i][c] * cacc[i][c]; }
        const float rstd = 1.0f / sqrtf(wave_sum(s2) * (1.f / 512.f) + LN_EPS); float o[8];
#pragma unroll
        for (int c = 0; c < 8; ++c) { const float y = cacc[i][c] * rstd * g[c] + bb[c]; o[c] = y * sigm(y); }
        *(u32x4*)(MIX + (size_t)(r0 + i) * 2048 + 1024 + ch0) = pack8(o);
    }
    const int t0 = r0 & 2047, b = r0 >> 11;
    if (t0 + 3 >= SEQ - 30) {
        for (int i = 0; i < 4; ++i) { const int t = t0 + i; if (t >= SEQ - 30) { float f[8]; unpack8(*(const LAS u32x4*)(GLw + (30 + i) * 512 + ch0), f);
            stf8(a.out + OUT_CONVP + ((size_t)(l * NB + b) * 30 + (t - (SEQ - 30))) * 512 + ch0, f); } }
    }
}

__device__ __forceinline__ void mix_row_s(const View& a, int l, int bs, int lane, const bf16_t* P, bf16_t* MIX, const LAS float* DW) {
    const int ch0 = lane * 8, r = MP + bs;
    const bf16_t* Pr = P + (size_t)r * 3072 + ch0; bf16_t* Mr = MIX + (size_t)r * 2048 + ch0; float* out = a.out + ch0;
    {
        const int win = 2 << (lane >> 4);
        const float* sp = a.in(I_SPOOL) + ((size_t)(l * NSAMP + bs) * 15) * 512 + ch0;
        float* dp = out + OUT_POOLS + ((size_t)(l * NSAMP + bs) * 15) * 512;
        float av[8], sacc[8]; ldb8(Pr, av);
#pragma unroll
        for (int c = 0; c < 8; ++c) sacc[c] = av[c];
        f32x4 x0[15], x1[15];
#pragma unroll
        for (int i = 0; i < 15; ++i) { x0[i] = *(const f32x4*)(sp + i * 512); x1[i] = *(const f32x4*)(sp + i * 512 + 4); }
#pragma unroll
        for (int i = 0; i < 15; ++i) { const float mk = (15 - i < win) ? 1.f : 0.f;
            sacc[0] += x0[i][0] * mk; sacc[1] += x0[i][1] * mk; sacc[2] += x0[i][2] * mk; sacc[3] += x0[i][3] * mk; sacc[4] += x1[i][0] * mk; sacc[5] += x1[i][1] * mk; sacc[6] += x1[i][2] * mk; sacc[7] += x1[i][3] * mk;
            if (i >= 1) { *(f32x4*)(dp + (i - 1) * 512) = x0[i]; *(f32x4*)(dp + (i - 1) * 512 + 4) = x1[i]; } }
        stf8(dp + 14 * 512, av);
        const float inv = 1.0f / (float)win; float o[8];
#pragma unroll
        for (int c = 0; c < 8; ++c) o[c] = sacc[c] * inv - av[c];
        *(u32x4*)(Mr) = pack8(o);
    }
    asm volatile("" ::: "memory");
    {
        float cacc[8]; ldf8(a.in(I_CDB) + l * 512 + ch0, cacc);
        const float* sp = a.in(I_SCONV) + ((size_t)(l * NSAMP + bs) * 30) * 512 + ch0;
        float* dp = out + OUT_CONVS + ((size_t)(l * NSAMP + bs) * 30) * 512;
#pragma unroll
        for (int jb = 0; jb < 30; jb += 10) {
            f32x4 x0[10], x1[10];
#pragma unroll
            for (int u = 0; u < 10; ++u) { x0[u] = *(const f32x4*)(sp + (jb + u) * 512); x1[u] = *(const f32x4*)(sp + (jb + u) * 512 + 4); }
#pragma unroll
            for (int u = 0; u < 10; ++u) { const int j = jb + u;
                const f32x4 w0 = *(const LAS f32x4*)(DW + j * 512 + ch0), w1 = *(const LAS f32x4*)(DW + j * 512 + ch0 + 4);
                cacc[0] += x0[u][0] * w0[0]; cacc[1] += x0[u][1] * w0[1]; cacc[2] += x0[u][2] * w0[2]; cacc[3] += x0[u][3] * w0[3];
                cacc[4] += x1[u][0] * w1[0]; cacc[5] += x1[u][1] * w1[1]; cacc[6] += x1[u][2] * w1[2]; cacc[7] += x1[u][3] * w1[3];
                if (j >= 1) { *(f32x4*)(dp + (j - 1) * 512) = x0[u]; *(f32x4*)(dp + (j - 1) * 512 + 4) = x1[u]; } }
            asm volatile("" ::: "memory");
        }
        { float gl[8]; ldb8(Pr + 1536, gl);
          const f32x4 w0 = *(const LAS f32x4*)(DW + 30 * 512 + ch0), w1 = *(const LAS f32x4*)(DW + 30 * 512 + ch0 + 4);
          cacc[0] += gl[0] * w0[0]; cacc[1] += gl[1] * w0[1]; cacc[2] += gl[2] * w0[2]; cacc[3] += gl[3] * w0[3]; cacc[4] += gl[4] * w1[0]; cacc[5] += gl[5] * w1[1]; cacc[6] += gl[6] * w1[2]; cacc[7] += gl[7] * w1[3];
          stf8(dp + 29 * 512, gl); }
        float sm = 0.f;
#pragma unroll
        for (int c = 0; c < 8; ++c) sm += cacc[c];
        const float mean = wave_sum(sm) * (1.f / 512.f); float s2 = 0.f;
#pragma unroll
        for (int c = 0; c < 8; ++c) { cacc[c] -= mean; s2 += cacc[c] * cacc[c]; }
        const float rstd = 1.0f / sqrtf(wave_sum(s2) * (1.f / 512.f) + LN_EPS);
        float g[8], bb[8], o[8]; ldf8(a.in(I_CLNG) + l * 512 + ch0, g); ldf8(a.in(I_CLNB) + l * 512 + ch0, bb);
#pragma unroll
        for (int c = 0; c < 8; ++c) { const float y = cacc[c] * rstd * g[c] + bb[c]; o[c] = y * sigm(y); }
        *(u32x4*)(Mr + 1024) = pack8(o);
    }
    {
        const float* sw = a.in(I_SCW) + (size_t)l * 3 * 512 + ch0;
        float w0[8], w1[8], w2[8], z0[8], z1[8], z2[8], sb[8], o[8];
        ldf8(sw, w0); ldf8(sw + 512, w1); ldf8(sw + 1024, w2);
        ldb8(Pr + 2560, z2); ldb8(Pr + 2048, sb);
        const float* sp = a.in(I_SSC) + ((size_t)(l * NSAMP + bs) * 2) * 512 + ch0;
        float* dp = out + OUT_SCS + ((size_t)(l * NSAMP + bs) * 2) * 512;
        ldf8(sp, z0); ldf8(sp + 512, z1);
        stf8(dp, z1); stf8(dp + 512, z2);
#pragma unroll
        for (int c = 0; c < 8; ++c) o[c] = sb[c] * (w0[c] * z0[c] + w1[c] * z1[c] + w2[c] * z2[c]);
        *(u32x4*)(Mr + 1536) = pack8(o);
    }
    {
        float v[8]; ldb8(Pr + 1024, v);
        float sm = 0.f;
#pragma unroll
        for (int c = 0; c < 8; ++c) sm += v[c];
        const float mean = wave_sum(sm) * (1.f / 512.f); float s2 = 0.f;
#pragma unroll
        for (int c = 0; c < 8; ++c) { v[c] -= mean; s2 += v[c] * v[c]; }
        const float rstd = 1.0f / sqrtf(wave_sum(s2) * (1.f / 512.f) + LN_EPS);
        float g[8], bb[8], u[8], o[8]; ldf8(a.in(I_GLNG) + l * 512 + ch0, g); ldf8(a.in(I_GLNB) + l * 512 + ch0, bb); ldb8(Pr + 512, u);
        const int h = lane >> 4;
        const float w00 = a.in(I_GWS)[((size_t)(l * 4 + h) * 128) * 128], b0 = a.in(I_GB)[(l * 4 + h) * 128];
#pragma unroll
        for (int c = 0; c < 8; ++c) { v[c] = v[c] * rstd * g[c] + bb[c]; o[c] = u[c] * (w00 * v[c] + b0); }
        stf8(out + OUT_GV + (size_t)(l * NSAMP + bs) * 512, v);
        *(u32x4*)(Mr + 512) = pack8(o);
    }
}

__device__ __forceinline__ void sgu_unit(const View& a, int l, int un, unsigned char* lds_g, const bf16_t* P, bf16_t* MIX, const int wv_) {
    int tid_ = MK_TID; asm volatile("" : "+v"(tid_)); const int tid = tid_, lane = tid & 63, wave = __builtin_amdgcn_readfirstlane(tid >> 6);
    const int ck = un >> 1, h0 = (un & 1) * 2; const int r0 = ck * 128;
    LAS bf16_t* V = (LAS bf16_t*)lds_g;
    {
        float g[8], bb[8]; ldf8(a.in(I_GLNG) + l * 512 + lane * 8, g); ldf8(a.in(I_GLNB) + l * 512 + lane * 8, bb);
        u32x4 vr[16];
#pragma unroll
        for (int i = 0; i < 16; ++i) vr[i] = *(const u32x4*)(P + (size_t)(r0 + wave * 16 + i) * 3072 + 1024 + lane * 8);
#pragma unroll
        for (int i = 0; i < 16; ++i) {
            const int s_ = wave * 16 + i;
            float v[8]; unpack8(vr[i], v);
            float s = 0.f;
#pragma unroll
            for (int q = 0; q < 8; ++q) s += v[q];
            const float mean = wave_sum(s) * (1.f / 512.f); float s2 = 0.f;
#pragma unroll
            for (int q = 0; q < 8; ++q) { v[q] -= mean; s2 += v[q] * v[q]; }
            const float rstd = 1.0f / sqrtf(wave_sum(s2) * (1.f / 512.f) + LN_EPS);
            if ((lane >> 5) == (h0 >> 1)) {
                LAS unsigned* dst = (LAS unsigned*)(V + ((lane >> 4) & 1) * (128 * 130) + s_ * 130 + (lane & 15) * 8);
#pragma unroll
                for (int q = 0; q < 4; ++q) dst[q] = cvt_pk_bf16(v[2 * q] * rstd * g[2 * q] + bb[2 * q], v[2 * q + 1] * rstd * g[2 * q + 1] + bb[2 * q + 1]);
            }
        }
    }
    __syncthreads();
    for (int hh = 0; hh < 2; ++hh) {
        const int h = h0 + hh; const LAS bf16_t* Vh = V + hh * (128 * 130);
        const int t0 = wave * 16, nk = (t0 + 16 + 31) >> 5, fr = lane & 15, fq = lane >> 4;
        const int t = t0 + fr;
        const float* Wrow = a.in(I_GWS) + ((size_t)(l * 4 + h) * 128 + t) * 128;
        f32x4 acc[8];
#pragma unroll
        for (int n = 0; n < 8; ++n) acc[n] = (f32x4){0.f, 0.f, 0.f, 0.f};
        for (int kk = 0; kk < nk; ++kk) {
            const int s0 = kk * 32 + fq * 8;
            float w[8]; ldf8(Wrow + s0, w);
#pragma unroll
            for (int q = 0; q < 8; ++q) if (s0 + q > t) w[q] = 0.f;
            const u32x4 wp = pack8(w);
            const bf16x8 wf = __builtin_bit_cast(bf16x8, wp);
#pragma unroll
            for (int n = 0; n < 8; ++n) {
                bf16x8 vf;
#pragma unroll
                for (int q = 0; q < 8; ++q) vf[q] = (short)Vh[(s0 + q) * 130 + n * 16 + fr];
                acc[n] = __builtin_amdgcn_mfma_f32_16x16x32_bf16(vf, wf, acc[n], 0, 0, 0);
            }
        }
        const float bias = a.in(I_GB)[(l * 4 + h) * 128 + t];
        const bf16_t* up = P + (size_t)(r0 + t) * 3072 + 512 + h * 128 + fq * 4;
        bf16_t* op = MIX + (size_t)(r0 + t) * 2048 + 512 + h * 128 + fq * 4;
#pragma unroll
        for (int n = 0; n < 8; ++n) {
            const u32x2 uu = *(const u32x2*)(up + n * 16);
            const f32x4 u4 = pg8::bflo(uu.x, uu.y);
            const f32x4 z = (acc[n] + bias) * u4;
            *(u32x2*)(op + n * 16) = (u32x2){cvt_pk_bf16(z[0], z[1]), cvt_pk_bf16(z[2], z[3])};
        }
    }
    __syncthreads();
}

__device__ __forceinline__ void samp_attn_unit(const View& a, int l, int un, unsigned char* lds_g, const bf16_t* Q, bf16_t* O, const int wv_) {
    int tid_ = MK_TID; asm volatile("" : "+v"(tid_)); const int tid = tid_, lane = tid & 63, wave = __builtin_amdgcn_readfirstlane(tid >> 6);
    const int b = un >> 2, h = un & 3;
    LAS float* S = (LAS float*)lds_g;
    LAS float* Pl = S + 256;
    LAS float* RED = S + 512;
    const size_t base = (((size_t)(l * NSAMP + b) * NMEM) * 4 + h) * 256;
    const float* Kp = a.in(I_CK) + base + 4 * lane; const float* Vp = a.in(I_CV) + base + 4 * lane;
    const u32x2 qq = *(const u32x2*)(Q + (size_t)(MP + b) * D + h * 256 + 4 * lane);
    const f32x4 q4 = pg8::bflo(qq.x, qq.y);
    for (int mm = 0; mm < 32; mm += 8) {
        f32x4 k[8];
#pragma unroll
        for (int i = 0; i < 8; ++i) k[i] = __builtin_nontemporal_load((const f32x4*)(Kp + (size_t)(wave * 32 + mm + i) * 1024));
#pragma unroll
        for (int i = 0; i < 8; ++i) { float d = (q4[0] * k[i][0] + q4[1] * k[i][1]) + (q4[2] * k[i][2] + q4[3] * k[i][3]); d = wave_sum(d); if (lane == 0) S[wave * 32 + mm + i] = d; }
    }
    __syncthreads();
    {
        const float s0 = S[lane], s1 = S[64 + lane], s2 = S[128 + lane], s3 = S[192 + lane];
        const float mx = wave_max(fmaxf(fmaxf(s0, s1), fmaxf(s2, s3)));
        const float e0 = __expf(s0 - mx), e1 = __expf(s1 - mx), e2 = __expf(s2 - mx), e3 = __expf(s3 - mx);
        const float inv = 1.0f / wave_sum((e0 + e1) + (e2 + e3));
        if (wave == 0) { Pl[lane] = e0 * inv; Pl[64 + lane] = e1 * inv; Pl[128 + lane] = e2 * inv; Pl[192 + lane] = e3 * inv; }
    }
    __syncthreads();
    {
        f32x4 o = (f32x4){0.f, 0.f, 0.f, 0.f};
        for (int mm = 0; mm < 32; mm += 8) {
            f32x4 v[8];
#pragma unroll
            for (int i = 0; i < 8; ++i) v[i] = __builtin_nontemporal_load((const f32x4*)(Vp + (size_t)(wave * 32 + mm + i) * 1024));
#pragma unroll
            for (int i = 0; i < 8; ++i) o += v[i] * Pl[wave * 32 + mm + i];
        }
        *(LAS f32x4*)(RED + wave * 256 + 4 * lane) = o;
    }
    __syncthreads();
    if (tid < 256) {
        float s = 0.f;
#pragma unroll
        for (int w = 0; w < 8; ++w) s += RED[w * 256 + tid];
        const float other = __shfl_xor(s, 1);
        if ((tid & 1) == 0) *(unsigned*)(O + (size_t)(MP + b) * D + h * 256 + tid) = cvt_pk_bf16(s, other);
    }
    __syncthreads();
}

template <int MODE>
__device__ __forceinline__ void skinny_gemm(unsigned char* lds_g, const bf16_t* A, int lda, const bf16_t* Bt, int ldb, int Kq, float* X, bf16_t* O, const bf16_t* GATE, float alpha, float sc, int G, int cid, const int wv_) {
    int tid_ = MK_TID; asm volatile("" : "+v"(tid_)); const int tid = tid_, lane = tid & 63, wave = __builtin_amdgcn_readfirstlane(tid >> 6);
    const int rg = wave & 1, kq = wave >> 1, fr = lane & 15, fq = lane >> 4, nIt = Kq >> 5;
    LAS f32x4* RED = (LAS f32x4*)lds_g;
    for (int j = cid; j < 256; j += G) {
        const int rb = j & 3, cb = j >> 2;
        const bf16_t* ap = A + (size_t)(MP + rb * 32 + rg * 16 + fr) * lda + kq * Kq + fq * 8;
        const bf16_t* bp = Bt + (size_t)(cb * 16 + fr) * ldb + kq * Kq + fq * 8;
        f32x4 acc = (f32x4){0.f, 0.f, 0.f, 0.f};
        for (int k = 0; k < nIt; k += 4) {
            bf16x8 a[4], b[4];
#pragma unroll
            for (int u = 0; u < 4; ++u) {
                if (k + u < nIt) { a[u] = *(const bf16x8*)(ap + (k + u) * 32); b[u] = *(const bf16x8*)(bp + (k + u) * 32); }
                else { a[u] = (bf16x8){0, 0, 0, 0, 0, 0, 0, 0}; b[u] = a[u]; }
            }
#pragma unroll
            for (int u = 0; u < 4; ++u) acc = __builtin_amdgcn_mfma_f32_16x16x32_bf16(b[u], a[u], acc, 0, 0, 0);
        }
        RED[(kq * 2 + rg) * 64 + lane] = acc;
        __syncthreads();
        if (kq == 0) {
            const int orow = MP + rb * 32 + rg * 16 + fr, ocol = cb * 16 + 4 * fq;
            f32x4 v;
            if (MODE == 2) {
                v = (f32x4){0.f, 0.f, 0.f, 0.f};
#pragma unroll
                for (int q = 0; q < 4; ++q) { const u32x2 gq = *(const u32x2*)(GATE + (size_t)orow * 4096 + q * 1024 + ocol); v += RED[(q * 2 + rg) * 64 + lane] * pg8::bflo(gq.x, gq.y); }
            } else {
                v = (RED[(0 * 2 + rg) * 64 + lane] + RED[(1 * 2 + rg) * 64 + lane]) + (RED[(2 * 2 + rg) * 64 + lane] + RED[(3 * 2 + rg) * 64 + lane]);
            }
            if (MODE == 0) { const u32x2 xr = *(const u32x2*)(O + (size_t)orow * 1024 + ocol); *(f32x4*)(X + (size_t)(orow - MP) * 1024 + ocol) = pg8::bflo(xr.x, xr.y) * alpha + v * sc; }
            else { *(u32x2*)(O + (size_t)orow * 1024 + ocol) = (u32x2){cvt_pk_bf16(v[0] * sc, v[1] * sc), cvt_pk_bf16(v[2] * sc, v[3] * sc)}; }
        }
        __syncthreads();
    }
}

#define XB_TMO      128
#define XB_XCNT(j)  (256  + 64 * (j))
#define XB_XSUB(j)  (1280 + 64 * (j))
#define XB_XGEN(j)  (2304 + 64 * (j))
#define XB_TOP      3328
#define XB_TOPGEN   3392
#define XCD_BAR_WORDS 3456
#define XB_SPIN_CAP (1u << 18)

__device__ __forceinline__ unsigned xb_ld(unsigned* p)              { return __hip_atomic_load(p, __ATOMIC_RELAXED, __HIP_MEMORY_SCOPE_AGENT); }
__device__ __forceinline__ unsigned xb_add(unsigned* p, unsigned v) { return __hip_atomic_fetch_add(p, v, __ATOMIC_RELAXED, __HIP_MEMORY_SCOPE_AGENT); }
__device__ __forceinline__ unsigned xb_xcc_id() { return (unsigned)__builtin_amdgcn_s_getreg((3 << 11) | 20) & 0xFu; }
#define XB_SPIN(cond, bar) do { unsigned _sp = 0; while (cond) { __builtin_amdgcn_s_sleep(1); \
    if ((++_sp & 255u) == 0u) { if (xb_ld(&(bar)[XB_TMO])) break; if (_sp > XB_SPIN_CAP) { atomicAdd(&(bar)[XB_TMO], 1u); break; } } } } while (0)

struct XcdBarrier {
    unsigned* bar; unsigned x;
    volatile LAS unsigned* st;
};

__device__ __forceinline__ XcdBarrier xcd_barrier_post(unsigned* bar, volatile LAS unsigned* st) {
    XcdBarrier b; b.bar = bar; b.x = xb_xcc_id(); b.st = st;
    if (threadIdx.x == 0) (void)xb_add(&bar[XB_XCNT(b.x)], 1u);
    return b;
}
__device__ __forceinline__ void xcd_barrier_complete(unsigned* bar, unsigned x, unsigned& nloc, unsigned& nx) {
    const unsigned G = gridDim.x * gridDim.y * gridDim.z;
    unsigned sum, cnt, mine, sp = 0u;
    for (;;) {
        sum = 0u; cnt = 0u; mine = 0u;
#pragma unroll
        for (unsigned j = 0; j < 16; ++j) { const unsigned c = xb_ld(&bar[XB_XCNT(j)]); sum += c; cnt += (c > 0u) ? 1u : 0u; mine = (j == x) ? c : mine; }
        if (sum == G) break;
        __builtin_amdgcn_s_sleep(1);
        if ((++sp & 255u) == 0u) { if (xb_ld(&bar[XB_TMO])) break; if (sp > XB_SPIN_CAP) { atomicAdd(&bar[XB_TMO], 1u); break; } }
    }
    nloc = mine > 0u ? mine : 1u; nx = cnt > 0u ? cnt : 1u;
}

__device__ __forceinline__ void xcd_barrier(const XcdBarrier& b) {
    asm volatile("s_waitcnt vmcnt(0)" ::: "memory");
    __syncthreads();
    if (threadIdx.x == 0) {
        unsigned* bar = b.bar;
        __builtin_amdgcn_s_waitcnt(0);
        unsigned nloc = b.st[0], nx = b.st[1];
        if (nloc == 0u) { xcd_barrier_complete(bar, b.x, nloc, nx); b.st[0] = nloc; b.st[1] = nx; }
        const unsigned old = xb_add(&bar[XB_XSUB(b.x)], 1u);
        const unsigned gen = old / nloc;
        if (old + 1u == (gen + 1u) * nloc) {
            __builtin_amdgcn_fence(__ATOMIC_RELEASE, "agent");
            asm volatile("s_waitcnt vmcnt(0)" ::: "memory");
            const unsigned og = xb_add(&bar[XB_TOP], 1u);
            const unsigned tg = og / nx;
            if (og + 1u == (tg + 1u) * nx) xb_add(&bar[XB_TOPGEN], 1u);
            else XB_SPIN(xb_ld(&bar[XB_TOPGEN]) == tg, bar);
            __builtin_amdgcn_fence(__ATOMIC_ACQUIRE, "agent");
            xb_add(&bar[XB_XGEN(b.x)], 1u);
            asm volatile("s_waitcnt vmcnt(0)" ::: "memory");
        } else {
            XB_SPIN(xb_ld(&bar[XB_XGEN(b.x)]) == gen, bar);
            __builtin_amdgcn_fence(__ATOMIC_ACQUIRE, "agent");
            asm volatile("s_waitcnt vmcnt(0)" ::: "memory");
        }
    }
    __syncthreads();
}


constexpr int N_PHASES = 3 + 32;

template <int PH>
__device__ __forceinline__ void run_phase(const Args& args, unsigned char* lds, const int wv_) {
    constexpr int ph = PH, l = PH >= 3 ? (PH - 3) >> 4 : 0, s = PH >= 3 ? (PH - 3) & 15 : -1;
    PG8_LAS unsigned char* L = (PG8_LAS unsigned char*)lds;
        int z0 = 0; asm volatile("s_mov_b32 %0, 0" : "=s"(z0));
        unsigned char* ws = args.ws + z0;
        int tid_ = MK_TID; asm volatile("" : "+v"(tid_)); const int tid = tid_, lane = tid & 63, wave = __builtin_amdgcn_readfirstlane(tid >> 6);
        const View vw{&args, z0, ws, args.out + z0};
        const int G = (int)gridDim.x + z0, cid = (int)blockIdx.x + z0;
        bf16_t* XB = (bf16_t*)(ws + WS_XB); float* XF = (float*)(ws + WS_XF);
        bf16_t* GATE = (bf16_t*)(ws + WS_R1); bf16_t* HB = (bf16_t*)(ws + WS_R1);
        bf16_t* PB = (bf16_t*)(ws + WS_R2); bf16_t* QB = (bf16_t*)(ws + WS_R2); bf16_t* PRB = QB + (size_t)M_PAD * D; bf16_t* OB = PRB + (size_t)M_PAD * D;
        bf16_t* MIX = (bf16_t*)(ws + WS_MIX); bf16_t* MRG = (bf16_t*)(ws + WS_MRG); bf16_t* MEMB = (bf16_t*)(ws + WS_MEMB);

        const unsigned char* WL = ws + WS_W + (size_t)l * W_LAYER;
        if constexpr (ph == 0) {
#ifndef SK0
            prologue(vw, lds, G, cid, wv_);
#endif
        }
        if constexpr (s == 8 || s == 10) {
            constexpr int nj = 1;
            for (int j = 0; j < nj; ++j) {
                pg8::Gemm g; pg8::Sched S; pg8::EpiStore E;
                if constexpr (s == 8) {
                    g = pg8::Gemm{XB, (const bf16_t*)(WL + WO_WQ), 1024, 1024, 1024};
                    S.init(MP / 256, 4, 1, G, cid); S.a_pm = (size_t)256 * 1024 * 2; S.b_pn = (size_t)256 * 1024 * 2;
                    E = pg8::EpiStore{QB, 1024, 0.0625f};
                    skinny_gemm<1>(lds, XB, 1024, (const bf16_t*)(WL + WO_WQ), 1024, 256, nullptr, QB, nullptr, 0.f, 0.0625f, G, cid, wv_);
                } else {
                    g = pg8::Gemm{PRB, (const bf16_t*)(ws + WS_VT) + (size_t)l * 1024 * 2048, 1024, 2048, 256};
                    S.init(MP / 256, 4, 1, G, cid); S.a_pm = (size_t)256 * 1024 * 2; S.a_pn = 256 * 2; S.b_pn = (size_t)256 * 2048 * 2; S.b_b = 256 * 2;
                    E = pg8::EpiStore{OB, 1024, 1.0f};
                }
#ifndef SK2
                pg8::gemm_phase<pg8::EpiStore>(L, g, S, E, wv_);
#endif
            }
            if constexpr (s == 10) {
                __syncthreads();
                for (int un = 256 + cid; un < 512; un += G) samp_attn_unit(vw, l, un, lds, QB, OB, wv_);
            }
        } else if constexpr (s == 0 || s == 13) {
            pg8::Gemm g{XB, (const bf16_t*)(WL + (s == 0 ? WO_UP1 : WO_UP2)), 1024, 1024, 1024};
            pg8::Sched S; S.init(M_PAD / 256, 22, 1, G, cid); S.a_pm = (size_t)256 * 1024 * 2; S.b_pn = (size_t)256 * 1024 * 2;
            pg8::EpiUp E{HB, FF};
#ifndef SK3
            pg8::gemm_phase<pg8::EpiUp>(L, g, S, E, wv_);
#endif
            if constexpr (s == 0) {
                constexpr int c0 = (M_PAD / 256) * 22 % 256;
                {
                    pg8::Gemm g2{MEMB, (const bf16_t*)(WL + WO_KV), 1024, 1024, 1024};
                    pg8::Sched S2; S2.init(8, 8, 1, G, (cid + G - c0 % G) % G); S2.a_pm = (size_t)256 * 1024 * 2; S2.b_pn = (size_t)256 * 1024 * 2;
                    pg8::EpiKV E2{vw.out + OUT_MK + (size_t)l * 2048 * 1024, vw.out + OUT_MV + (size_t)l * 2048 * 1024, (bf16_t*)(ws + WS_KB) + (size_t)l * 2048 * 1024};
                    pg8::gemm_phase<pg8::EpiKV>(L, g2, S2, E2, wv_);
                }
                {
                    pg8::Gemm g3{(const bf16_t*)(WL + WO_KV) + (size_t)1024 * 1024, MEMB, 1024, 1024, 1024};
                    pg8::Sched S3; S3.init(4, 8, 1, G, (cid + G - (c0 + 64) % G) % G); S3.a_pm = (size_t)256 * 1024 * 2; S3.b_pn = (size_t)256 * 1024 * 2;
                    pg8::EpiStore E3{(bf16_t*)(ws + WS_VT) + (size_t)l * 1024 * 2048, 2048, 1.0f};
                    pg8::gemm_phase<pg8::EpiStore>(L, g3, S3, E3, wv_);
                }
            }
        } else if constexpr (s == 1 || s == 14 || s == 6 || s == 11) {
            pg8::Gemm g; float sc;
            if constexpr (s == 1 || s == 14) { g = pg8::Gemm{HB, (const bf16_t*)(WL + (s == 1 ? WO_DN1 : WO_DN2)), FF, FF, FF}; sc = 0.5f; }
            else if constexpr (s == 6) { g = pg8::Gemm{MRG, (const bf16_t*)(WL + WO_WO), 1024, 1024, 1024}; sc = 1.0f; }
            else { g = pg8::Gemm{OB, (const bf16_t*)(WL + WO_AO), 1024, 1024, 1024}; sc = 1.0f; }
            pg8::Sched S; S.init(MP / 256, 4, 1, G, cid); S.a_pm = (size_t)256 * g.lda * 2; S.b_pn = (size_t)256 * g.ldb * 2;
            constexpr int which = s == 1 ? 0 : s == 6 ? 1 : s == 11 ? 2 : 3;
            constexpr int gi = which == 0 ? I_LN1G : which == 1 ? I_LN2G : which == 2 ? I_LN3G : I_LN4G;
            constexpr size_t bank_off = WS_CTL + 16384 + (size_t)(l * 4 + which) * 16384;
            typedef pg8::EpiResidLN<(which == 0 || which == 3) ? 1 : 0> EpiT;
            EpiT E{XB, vw.in(gi) + l * D, vw.in(gi + 1) + l * D, (which == 3 && l == 1) ? vw.out + OUT_Y : nullptr, ws + bank_off, (long)WS_XBUF - (long)bank_off};
            skinny_gemm<0>(lds, g.A, g.lda, g.Bt, g.ldb, g.K / 4, XF, XB, nullptr, DN_ALPHA, sc, G, cid, wv_);
#ifndef SK4
            pg8::gemm_phase<EpiT>(L, g, S, E, wv_);
#endif
        } else if constexpr (s == 2 || s == 7 || s == 12 || s == 15) {
            constexpr int gi = s == 2 ? I_LN1G : s == 7 ? I_LN2G : s == 12 ? I_LN3G : I_LN4G;
#ifndef SK5
            ln_pass_sample(XF, XB, vw.in(gi) + l * D, vw.in(gi + 1) + l * D, (s == 15 && l == 1) ? vw.out + OUT_Y : nullptr, G, cid, wv_);
#endif
        } else if constexpr (s == 3) {
            pg8::Gemm g{XB, (const bf16_t*)(WL + WO_IN), 1024, 1024, 1024};
            pg8::Sched S; S.init(M_PAD / 256, 32, 1, G, cid); S.a_pm = (size_t)256 * 1024 * 2; S.b_pn = (size_t)256 * 1024 * 2;
            pg8::EpiIn E{PB, GATE, vw.in(I_BGATE) + l * 4096};
#ifndef SK6
            pg8::gemm_phase<pg8::EpiIn>(L, g, S, E, wv_);
#endif
        } else if constexpr (s == 4) {
#ifndef SK7
            for (int un = cid; un < 256; un += G) sgu_unit(vw, l, un, lds, PB, MIX, wv_);
#endif
#ifndef SK8
            if ((MP % (G * 64)) == 0 || true) {
                __syncthreads();
                LAS float* DW = (LAS float*)((LAS unsigned char*)lds + 65536);
                LAS bf16_t* GL = (LAS bf16_t*)lds;
                const float* dwg = vw.in(I_CDW) + (size_t)l * 31 * 512;
                { f32x4 tw[8];
#pragma unroll
                  for (int u = 0; u < 8; ++u) { const int e = tid + u * NT; tw[u] = *(const f32x4*)(dwg + 4 * (e < 31 * 512 / 4 ? e : 0)); }
#pragma unroll
                  for (int u = 0; u < 8; ++u) { const int e = tid + u * NT; if (e < 31 * 512 / 4) ((LAS f32x4*)DW)[e] = tw[u]; } }
                __syncthreads();
                { const int gw = cid * NWAVES + wave; if ((gw & 15) == 5 && (gw >> 4) < NSAMP) mix_row_s(vw, l, gw >> 4, lane, PB, MIX, DW); }
                const int per = MP / G;
                for (int p0 = 0; p0 < per; p0 += 32) {
                    const int T0 = cid * per + p0, tseq = T0 & 2047;
                    __syncthreads();
                    {
                        u32x4 tw[8]; int t3 = tid; asm volatile("" : "+v"(t3));
#pragma unroll
                        for (int u = 0; u < 8; ++u) { const int e = t3 + u * NT, row = e >> 6, c16 = e & 63; tw[u] = (u32x4){0u, 0u, 0u, 0u};
                            if (e < 62 * 64 && tseq - 30 + row >= 0) tw[u] = *(const u32x4*)(PB + (size_t)(T0 - 30 + row) * 3072 + 1536 + c16 * 8); }
#pragma unroll
                        for (int u = 0; u < 8; ++u) { const int e = t3 + u * NT; if (e < 62 * 64) ((LAS u32x4*)GL)[e] = tw[u]; }
                    }
                    __syncthreads();
                    conv4_lds(vw, l, T0 + wave * 4, lane, MIX, DW, GL + (wave * 4) * 512);
                    { int tb = T0 + wave * 4; asm volatile("" : "+s"(tb));
#pragma nounroll
                      for (int i = 0; i < 4; ++i) mix_row_p<false>(vw, l, tb + i, lane, PB, MIX, DW, GL); }
                }
            }
#endif
        } else if constexpr (s == 5) {
            pg8::Gemm g{MIX, (const bf16_t*)(WL + WO_PROJ), 2048, 2048, 512};
            pg8::Sched S; S.init(MP / 256, 4, 4, G, cid); S.a_pm = (size_t)256 * 2048 * 2; S.b_pn = (size_t)256 * 2048 * 2; S.a_sub = 512 * 2; S.b_sub = 512 * 2;
            pg8::EpiBranch E{GATE, MRG};
            skinny_gemm<2>(lds, MIX, 2048, (const bf16_t*)(WL + WO_PROJ), 2048, 512, nullptr, MRG, GATE, 0.f, 1.0f, G, cid, wv_);
#ifndef SK9
            pg8::gemm_phase<pg8::EpiBranch>(L, g, S, E, wv_);
#endif
        } else if constexpr (s == 9) {
            pg8::Gemm g{QB, (const bf16_t*)(ws + WS_KB) + (size_t)l * 2048 * 1024, 1024, 1024, 256};
            pg8::Sched S; S.init(MP / 256, 4, 1, G, cid); S.a_pm = (size_t)256 * 1024 * 2; S.a_pn = 256 * 2; S.b_pn = 256 * 2; S.b_b = (size_t)256 * 1024 * 2;
            pg8::EpiSoftmax E{PRB};
#ifndef SK10
            pg8::gemm_phase<pg8::EpiSoftmax>(L, g, S, E, wv_);
#endif
            asm volatile("s_waitcnt vmcnt(0)" ::: "memory");
            __syncthreads();
            {
                pg8::Gemm g2{PRB, (const bf16_t*)(ws + WS_VT) + (size_t)l * 1024 * 2048, 1024, 2048, 256};
                pg8::Sched S2; S2.init(MP / 256, 4, 1, G, cid); S2.a_pm = (size_t)256 * 1024 * 2; S2.a_pn = 256 * 2; S2.b_pn = (size_t)256 * 2048 * 2; S2.b_b = 256 * 2;
                pg8::EpiStore E2{OB, 1024, 1.0f};
                pg8::gemm_phase<pg8::EpiStore>(L, g2, S2, E2, wv_);
            }
            __syncthreads();
#ifndef SK11
            for (int un = cid; un < 512; un += G) samp_attn_unit(vw, l, un, lds, QB, OB, wv_);
#endif
        }
}

__global__ void __launch_bounds__(NT, 2) mega_fwd(Args args) {
    extern __shared__ __attribute__((aligned(16))) unsigned char lds[];
    cg::grid_group grid = cg::this_grid();
    const int lo = args.ph_lo, hi = args.ph_hi;
    const int wv_ = __builtin_amdgcn_readfirstlane((int)threadIdx.x >> 6);
    volatile LAS unsigned* MISC = (volatile LAS unsigned*)((LAS unsigned char*)lds + LDS_BYTES - 64);
    if (threadIdx.x < 16) MISC[threadIdx.x] = 0u;
    __syncthreads();
    const XcdBarrier bar = xcd_barrier_post((unsigned*)(args.ws + WS_CTL), MISC);
#define RUN(k) if (lo <= (k) && (k) < hi) { run_phase<(k)>(args, lds, wv_); if ((k) + 1 < hi) { if ((k) == 0) grid.sync(); else xcd_barrier(bar); } }
    RUN(0)
    RUN(3) RUN(4) RUN(5) RUN(6) RUN(7) RUN(8) RUN(9) RUN(10) RUN(11) RUN(12) RUN(14) RUN(15) RUN(16) RUN(17) RUN(18)
    RUN(19) RUN(20) RUN(21) RUN(22) RUN(23) RUN(24) RUN(25) RUN(26) RUN(27) RUN(28) RUN(30) RUN(31) RUN(32) RUN(33) RUN(34)
#undef RUN
}

extern "C" void kernel_launch(void* const* d_in, const int* in_sizes, int n_in, void* d_out, int out_size, void* d_ws, size_t ws_size, hipStream_t stream) {
    static int grid = 0;
    if (grid == 0) {
        if (n_in != N_IN || (size_t)out_size != OUT_END || ws_size < WS_END) { fprintf(stderr, "kernel_launch: unexpected shapes: n_in %d out %d ws %zu (need %zu)\n", n_in, out_size, ws_size, (size_t)WS_END); grid = -1; return; }
        int dev = 0, cus = 0, per_cu = 0;
        if (hipGetDevice(&dev) != hipSuccess || hipDeviceGetAttribute(&cus, hipDeviceAttributeMultiprocessorCount, dev) != hipSuccess) { grid = -1; return; }
        if (hipFuncSetAttribute((const void*)mega_fwd, hipFuncAttributeMaxDynamicSharedMemorySize, LDS_BYTES) != hipSuccess) { fprintf(stderr, "kernel_launch: hipFuncSetAttribute failed\n"); grid = -1; return; }
        if (hipOccupancyMaxActiveBlocksPerMultiprocessor(&per_cu, (const void*)mega_fwd, NT, LDS_BYTES) != hipSuccess || per_cu < 1) { fprintf(stderr, "kernel_launch: occupancy query says %d\n", per_cu); per_cu = 1; }
        (void)hipGetLastError();
        grid = cus * 1;
    }
    if (grid < 0) return;
    Args a{};
    for (int i = 0; i < N_IN; ++i) a.in[i] = (const float*)d_in[i];
    a.out = (float*)d_out; a.ws = (unsigned char*)d_ws;
#if MK_MULTI
#ifndef MK_LAST
#define MK_LAST N_PHASES
#endif
    for (int p = 0; p < MK_LAST; ++p) {
        a.ph_lo = p; a.ph_hi = p + 1;
        hipLaunchKernelGGL(mega_fwd, dim3(grid), dim3(NT), LDS_BYTES, stream, a);
    }
#else
    a.ph_lo = 0; a.ph_hi = N_PHASES;
    if (hipMemsetAsync((char*)d_ws + WS_CTL, 0, CTL_BYTES, stream) != hipSuccess) { fprintf(stderr, "kernel_launch: memset failed\n"); return; }
    void* kargs[] = {&a};
    hipError_t e = hipLaunchCooperativeKernel((const void*)mega_fwd, dim3(grid), dim3(NT), kargs, LDS_BYTES, stream);
    if (e != hipSuccess) fprintf(stderr, "cooperative launch failed: %s (grid %d)\n", hipGetErrorString(e), grid);
#endif
}
```

```cpp
#include <hip/hip_runtime.h>
#include <hip/hip_cooperative_groups.h>
#include <cstdio>
#include <cstdint>
namespace cg = cooperative_groups;
#define MK_TID (wv_ * 64 + (int)__builtin_amdgcn_mbcnt_hi(~0u, __builtin_amdgcn_mbcnt_lo(~0u, 0u)))

#ifndef MK_MULTI
#define MK_MULTI 0
#endif

namespace pg8 {
#define PG8_LAS __attribute__((address_space(3)))
typedef unsigned short bf16_t;
typedef short bf16x8 __attribute__((ext_vector_type(8)));
typedef float f32x4 __attribute__((ext_vector_type(4)));
typedef float f32x2 __attribute__((ext_vector_type(2)));
typedef unsigned u32x4 __attribute__((ext_vector_type(4)));
typedef unsigned u32x2 __attribute__((ext_vector_type(2)));
constexpr int BM = 256, BK = 64, HALF = 128, HTB = HALF * BK * 2, STAGE_BYTES = 8 * HTB, NXCD = 8, WGM = 8;

__host__ __device__ __forceinline__ int lds_byte(int r, int c) { const int st = (r >> 4) * 2 + (c >> 5), rr = r & 15, cc = c & 31, ob = rr * 64 + cc * 2; return st * 1024 + (ob ^ (((ob >> 9) & 1) << 5)); }
__host__ __device__ __forceinline__ void stage_rc(int b, int& R, int& C) { const int st = b / 1024, sb = b % 1024, swz = sb ^ (((sb >> 9) & 1) << 5); R = (st >> 1) * 16 + swz / 64; C = (st & 1) * 32 + (swz % 64) / 2; }
__host__ __device__ __forceinline__ int perm32(int rho) { const int n = rho >> 4, i = rho & 15; return 8 * (i >> 2) + 4 * n + (i & 3); }

struct Unit { int pm, pn, aux; size_t aoff, boff; };
struct Gemm { const bf16_t* A; const bf16_t* Bt; int lda, ldb, K; };

struct Sched {
    int nM, nN, nsub, nwg, G, c;
    size_t a_pm, a_pn, a_sub, a_b, b_pn, b_sub, b_b;
    __device__ __forceinline__ void init(int nM_, int nN_, int nsub_, int G_, int c_) { nM = nM_; nN = nN_; nsub = nsub_; nwg = nM_ * nN_; G = G_; c = c_; a_pm = a_pn = a_sub = a_b = b_pn = b_sub = b_b = 0; }
    __device__ __forceinline__ bool next(int i, Unit& u) const {
        const int sub = i % nsub; const long L = (long)(i / nsub) * G + c; if (L >= nwg) return false;
        int wgid = (int)L; { const int q = nwg / NXCD, r = nwg % NXCD, xcd = wgid % NXCD, off = wgid / NXCD; wgid = (xcd < r ? xcd * (q + 1) : r * (q + 1) + (xcd - r) * q) + off; }
        const int nig = WGM * nN, gid = wgid / nig, fm = gid * WGM, gsz = (nM - fm) < WGM ? (nM - fm) : WGM;
        u.pm = fm + ((wgid % nig) % gsz); u.pn = (wgid % nig) / gsz; u.aux = sub;
        u.aoff = (size_t)u.pm * a_pm + (size_t)u.pn * a_pn + (size_t)sub * a_sub + (size_t)(u.pm >> 3) * a_b;
        u.boff = (size_t)u.pn * b_pn + (size_t)sub * b_sub + (size_t)(u.pm >> 3) * b_b;
        return true;
    }
};

typedef __bf16 bf16v2 __attribute__((ext_vector_type(2)));
__device__ __forceinline__ unsigned cvt_pk_bf16(float lo, float hi) { const f32x2 v = {lo, hi}; return __builtin_bit_cast(unsigned, __builtin_convertvector(v, bf16v2)); }
__device__ __forceinline__ float sigm(float x) { return __builtin_amdgcn_rcpf(1.f + __expf(-x)); }
__device__ __forceinline__ f32x4 sigm4(f32x4 v) { return (f32x4){sigm(v[0]), sigm(v[1]), sigm(v[2]), sigm(v[3])}; }
__device__ __forceinline__ u32x4 pack2(f32x4 v0, f32x4 v1) { u32x4 w; w.x = cvt_pk_bf16(v0[0], v0[1]); w.y = cvt_pk_bf16(v0[2], v0[3]); w.z = cvt_pk_bf16(v1[0], v1[1]); w.w = cvt_pk_bf16(v1[2], v1[3]); return w; }
__device__ __forceinline__ f32x4 bflo(unsigned a, unsigned b) { return (f32x4){__uint_as_float(a << 16), __uint_as_float(a & 0xffff0000u), __uint_as_float(b << 16), __uint_as_float(b & 0xffff0000u)}; }

typedef f32x4 Acc[2][2][4][2];

struct EpiUp {
    bf16_t* H; int ldh;
    __device__ __forceinline__ bool keep(const Unit&) const { return false; }
    __device__ __forceinline__ void operator()(Acc& acc, const Unit& u, int wr, int wc, int fr, int fq, PG8_LAS unsigned char*) const {
        const int row0 = u.pm * BM + wr * 64 + fr, col = u.pn * 128 + wc * 32 + 8 * fq;
#pragma unroll
        for (int ai = 0; ai < 2; ++ai)
#pragma unroll
            for (int m = 0; m < 4; ++m) {
                const f32x4 a0 = acc[ai][0][m][0], a1 = acc[ai][0][m][1], b0 = acc[ai][1][m][0], b1 = acc[ai][1][m][1];
                const f32x4 h0 = a0 * sigm4(a0) * b0, h1 = a1 * sigm4(a1) * b1;
                *(u32x4*)(H + (size_t)(row0 + ai * HALF + m * 16) * ldh + col) = pack2(h0, h1);
            }
    }
};
template <int HALF_SCALE>
struct EpiResidLN {
    bf16_t* XB; const float* g; const float* b; float* out; unsigned char* ctl;
    long xoff;
    __device__ __forceinline__ bool keep(const Unit&) const { return false; }
    __device__ __forceinline__ void operator()(Acc& acc, const Unit& u, int wr, int wc, int fr, int fq, PG8_LAS unsigned char* lds) const {
        constexpr float alpha = 1.41421356237f, s = HALF_SCALE ? 0.5f : 1.0f;
        unsigned long long* xbuf = (unsigned long long*)(ctl + xoff); unsigned* cnt = (unsigned*)ctl;
        PG8_LAS f32x2* P = (PG8_LAS f32x2*)(lds + STAGE_BYTES);
        PG8_LAS f32x2* S = (PG8_LAS f32x2*)(lds + STAGE_BYTES + 8192);
        const int row0 = u.pm * BM + wr * 64 + fr, col = u.pn * BM + wc * 32 + 8 * fq, wid = wr * 4 + wc, lane = fq * 16 + fr;
#pragma unroll
        for (int ai = 0; ai < 2; ++ai) {
            u32x4 xr[4][2];
#pragma unroll
            for (int m = 0; m < 4; ++m)
#pragma unroll
                for (int bj = 0; bj < 2; ++bj) xr[m][bj] = __builtin_nontemporal_load((const u32x4*)(XB + (size_t)(row0 + ai * HALF + m * 16) * 1024 + col + bj * HALF));
#pragma unroll
            for (int m = 0; m < 4; ++m)
#pragma unroll
                for (int bj = 0; bj < 2; ++bj) { const u32x4 x = xr[m][bj];
                    acc[ai][bj][m][0] = bflo(x.x, x.y) * alpha + acc[ai][bj][m][0] * s; acc[ai][bj][m][1] = bflo(x.z, x.w) * alpha + acc[ai][bj][m][1] * s; }
            asm volatile("" ::: "memory");
        }
#pragma unroll
        for (int ai = 0; ai < 2; ++ai)
#pragma unroll
            for (int m = 0; m < 4; ++m) {
                float sm = 0.f;
#pragma unroll
                for (int bj = 0; bj < 2; ++bj)
#pragma unroll
                    for (int n = 0; n < 2; ++n) { const f32x4 x = acc[ai][bj][m][n]; sm += (x[0] + x[1]) + (x[2] + x[3]); }
                sm += __shfl_xor(sm, 16); sm += __shfl_xor(sm, 32);
                const float mw = sm * (1.0f / 64.0f); float q = 0.f;
#pragma unroll
                for (int bj = 0; bj < 2; ++bj)
#pragma unroll
                    for (int n = 0; n < 2; ++n) { const f32x4 d = acc[ai][bj][m][n] - mw; q += (d[0] * d[0] + d[1] * d[1]) + (d[2] * d[2] + d[3] * d[3]); }
                q += __shfl_xor(q, 16); q += __shfl_xor(q, 32);
                if (fq == 0) P[(ai * HALF + wr * 64 + m * 16 + fr) * 4 + wc] = (f32x2){mw, q};
            }
        asm volatile("s_waitcnt lgkmcnt(0)" ::: "memory"); __builtin_amdgcn_s_barrier(); asm volatile("" ::: "memory");
        const int row = wid * 32 + (lane & 31);
        if (lane < 32) {
            const f32x2 a = P[row * 4 + 0], bb = P[row * 4 + 1], c = P[row * 4 + 2], d = P[row * 4 + 3];
            const float mt = (a.x + bb.x + c.x + d.x) * 0.25f;
            const float da = a.x - mt, db = bb.x - mt, dc = c.x - mt, dd = d.x - mt;
            const float m2 = (a.y + bb.y) + (c.y + d.y) + 64.0f * ((da * da + db * db) + (dc * dc + dd * dd));
            unsigned long long* slot = xbuf + ((size_t)(u.pm * BM + row) * 4 + u.pn);
            __hip_atomic_store(slot, ((unsigned long long)__float_as_uint(m2) << 32) | __float_as_uint(mt), __ATOMIC_RELAXED, __HIP_MEMORY_SCOPE_AGENT);
        }
        asm volatile("s_waitcnt vmcnt(0)" ::: "memory");
        if (lane == 0) __hip_atomic_fetch_add(cnt + 64 * u.pm, 1u, __ATOMIC_RELAXED, __HIP_MEMORY_SCOPE_AGENT);
        if (wid == 0) {
            unsigned sp = 0;
            while ((unsigned)__builtin_amdgcn_readfirstlane(__hip_atomic_load(cnt + 64 * u.pm, __ATOMIC_RELAXED, __HIP_MEMORY_SCOPE_AGENT)) < 32u) { __builtin_amdgcn_s_sleep(2); if (++sp > (1u << 22)) break; }
            __builtin_amdgcn_fence(__ATOMIC_ACQUIRE, "agent");
        }
        asm volatile("s_waitcnt vmcnt(0) lgkmcnt(0)" ::: "memory"); __builtin_amdgcn_s_barrier(); asm volatile("" ::: "memory");
        if (lane < 32) {
            const unsigned long long* slot = xbuf + (size_t)(u.pm * BM + row) * 4; float mt[4], m2[4]; float ms = 0.f;
#pragma unroll
            for (int t = 0; t < 4; ++t) { const unsigned long long w = __hip_atomic_load(slot + t, __ATOMIC_RELAXED, __HIP_MEMORY_SCOPE_AGENT); mt[t] = __uint_as_float((unsigned)w); m2[t] = __uint_as_float((unsigned)(w >> 32)); ms += mt[t]; }
            const float mean = ms * 0.25f; float q = 0.f;
#pragma unroll
            for (int t = 0; t < 4; ++t) { const float dm = mt[t] - mean; q += m2[t] + 256.0f * dm * dm; }
            S[row] = (f32x2){mean, 1.0f / sqrtf(q * (1.0f / 1024.0f) + 1e-5f)};
        }
        asm volatile("s_waitcnt lgkmcnt(0)" ::: "memory"); __builtin_amdgcn_s_barrier(); asm volatile("" ::: "memory");
#pragma unroll
        for (int bj = 0; bj < 2; ++bj) {
            const f32x4 g0 = *(const f32x4*)(g + col + bj * HALF), g1 = *(const f32x4*)(g + col + bj * HALF + 4), b0 = *(const f32x4*)(b + col + bj * HALF), b1 = *(const f32x4*)(b + col + bj * HALF + 4);
#pragma unroll
            for (int ai = 0; ai < 2; ++ai)
#pragma unroll
                for (int m = 0; m < 4; ++m) {
                    const f32x2 sr = S[ai * HALF + wr * 64 + m * 16 + fr];
                    const size_t o = (size_t)(row0 + ai * HALF + m * 16) * 1024 + col + bj * HALF;
                    const f32x4 y0 = (acc[ai][bj][m][0] - sr.x) * sr.y * g0 + b0, y1 = (acc[ai][bj][m][1] - sr.x) * sr.y * g1 + b1;
                    *(u32x4*)(XB + o) = pack2(y0, y1);
                    if (out) { __builtin_nontemporal_store(y0, (f32x4*)(out + o)); __builtin_nontemporal_store(y1, (f32x4*)(out + o + 4)); }
                    asm volatile("" ::: "memory");
                }
        }
    }
};
struct EpiStore {
    bf16_t* O; int ldo; float s;
    __device__ __forceinline__ bool keep(const Unit&) const { return false; }
    __device__ __forceinline__ void operator()(Acc& acc, const Unit& u, int wr, int wc, int fr, int fq, PG8_LAS unsigned char*) const {
        const int row0 = u.pm * BM + wr * 64 + fr, col = u.pn * BM + wc * 32 + 8 * fq;
#pragma unroll
        for (int ai = 0; ai < 2; ++ai)
#pragma unroll
            for (int m = 0; m < 4; ++m) {
                bf16_t* p = O + (size_t)(row0 + ai * HALF + m * 16) * ldo + col;
#pragma unroll
                for (int bj = 0; bj < 2; ++bj) *(u32x4*)(p + bj * HALF) = pack2(acc[ai][bj][m][0] * s, acc[ai][bj][m][1] * s);
            }
    }
};
struct EpiKV {
    float* mk; float* mv; bf16_t* KB;
    __device__ __forceinline__ bool keep(const Unit&) const { return false; }
    __device__ __forceinline__ void operator()(Acc& acc, const Unit& u, int wr, int wc, int fr, int fq, PG8_LAS unsigned char*) const {
        const int row0 = u.pm * BM + wr * 64 + fr; const bool isk = u.pn < 4; const int col = (u.pn & 3) * BM + wc * 32 + 8 * fq;
        float* dst = isk ? mk : mv;
#pragma unroll
        for (int ai = 0; ai < 2; ++ai)
#pragma unroll
            for (int m = 0; m < 4; ++m) {
                const size_t o = (size_t)(row0 + ai * HALF + m * 16) * 1024 + col;
#pragma unroll
                for (int bj = 0; bj < 2; ++bj) {
                    __builtin_nontemporal_store(acc[ai][bj][m][0], (f32x4*)(dst + o + bj * HALF)); __builtin_nontemporal_store(acc[ai][bj][m][1], (f32x4*)(dst + o + bj * HALF + 4));
                    if (isk) *(u32x4*)(KB + o + bj * HALF) = pack2(acc[ai][bj][m][0], acc[ai][bj][m][1]);
                }
            }
    }
};
struct EpiIn {
    bf16_t* P; bf16_t* GATE; const float* bg;
    __device__ __forceinline__ bool keep(const Unit&) const { return false; }
    __device__ __forceinline__ void operator()(Acc& acc, const Unit& u, int wr, int wc, int fr, int fq, PG8_LAS unsigned char*) const {
        const int row0 = u.pm * BM + wr * 64 + fr, cw = wc * 32 + 8 * fq, pn = u.pn;
        if (pn >= 16) {
            const int col = (pn - 16) * BM + cw;
            f32x4 bv[2][2];
#pragma unroll
            for (int bj = 0; bj < 2; ++bj) { bv[bj][0] = *(const f32x4*)(bg + col + bj * HALF); bv[bj][1] = *(const f32x4*)(bg + col + bj * HALF + 4); }
#pragma unroll
            for (int ai = 0; ai < 2; ++ai)
#pragma unroll
                for (int m = 0; m < 4; ++m) {
                    bf16_t* p = GATE + (size_t)(row0 + ai * HALF + m * 16) * 4096 + col;
#pragma unroll
                    for (int bj = 0; bj < 2; ++bj) *(u32x4*)(p + bj * HALF) = pack2(sigm4(acc[ai][bj][m][0] + bv[bj][0]), sigm4(acc[ai][bj][m][1] + bv[bj][1]));
                }
        } else if ((pn >= 6 && pn < 10) || pn >= 12) {
            const bool glu = pn < 10; const int col = (glu ? 1536 + (pn - 6) * 128 : 2560 + (pn - 12) * 128) + cw;
#pragma unroll
            for (int ai = 0; ai < 2; ++ai)
#pragma unroll
                for (int m = 0; m < 4; ++m) {
                    f32x4 b0 = acc[ai][1][m][0], b1 = acc[ai][1][m][1];
                    if (glu) { b0 = sigm4(b0); b1 = sigm4(b1); }
                    *(u32x4*)(P + (size_t)(row0 + ai * HALF + m * 16) * 3072 + col) = pack2(acc[ai][0][m][0] * b0, acc[ai][0][m][1] * b1);
                }
        } else {
            const int col = (pn < 6 ? pn * BM : 2048 + (pn - 10) * BM) + cw;
#pragma unroll
            for (int ai = 0; ai < 2; ++ai)
#pragma unroll
                for (int m = 0; m < 4; ++m) {
                    bf16_t* p = P + (size_t)(row0 + ai * HALF + m * 16) * 3072 + col;
#pragma unroll
                    for (int bj = 0; bj < 2; ++bj) *(u32x4*)(p + bj * HALF) = pack2(acc[ai][bj][m][0], acc[ai][bj][m][1]);
                }
        }
    }
};
struct EpiBranch {
    const bf16_t* GATE; bf16_t* O;
    __device__ __forceinline__ bool keep(const Unit& u) const { return u.aux < 3; }
    __device__ __forceinline__ void operator()(Acc& acc, const Unit& u, int wr, int wc, int fr, int fq, PG8_LAS unsigned char*) const {
        const int row0 = u.pm * BM + wr * 64 + fr, col = u.pn * BM + wc * 32 + 8 * fq, kb = u.aux;
#pragma unroll
        for (int ai = 0; ai < 2; ++ai)
#pragma unroll
            for (int m = 0; m < 4; ++m) {
                const size_t r = (size_t)(row0 + ai * HALF + m * 16);
                const bf16_t* gp = GATE + r * 4096 + kb * 1024 + col;
#pragma unroll
                for (int bj = 0; bj < 2; ++bj) {
                    const u32x4 g = __builtin_nontemporal_load((const u32x4*)(gp + bj * HALF));
                    f32x4 g0 = bflo(g.x, g.y), g1 = bflo(g.z, g.w);
                    if (kb < 3) {
                        const u32x4 h = __builtin_nontemporal_load((const u32x4*)(gp + 1024 + bj * HALF));
                        const f32x4 h0 = bflo(h.x, h.y), h1 = bflo(h.z, h.w);
#pragma unroll
                        for (int j = 0; j < 4; ++j) { g0[j] = g0[j] * __builtin_amdgcn_rcpf(fmaxf(h0[j], 1e-30f)); g1[j] = g1[j] * __builtin_amdgcn_rcpf(fmaxf(h1[j], 1e-30f)); }
                        acc[ai][bj][m][0] *= g0; acc[ai][bj][m][1] *= g1;
                    } else {
                        *(u32x4*)(O + r * 1024 + col + bj * HALF) = pack2(acc[ai][bj][m][0] * g0, acc[ai][bj][m][1] * g1);
                    }
                }
            }
    }
};
struct EpiSoftmax {
    bf16_t* PR;
    __device__ __forceinline__ bool keep(const Unit&) const { return false; }
    __device__ __forceinline__ void operator()(Acc& acc, const Unit& u, int wr, int wc, int fr, int fq, PG8_LAS unsigned char* lds) const {
        PG8_LAS f32x2* X = (PG8_LAS f32x2*)(lds + STAGE_BYTES);
        const int row0 = u.pm * BM + wr * 64 + fr, col = u.pn * BM + wc * 32 + 8 * fq;
        float mxs[2][4];
#pragma unroll
        for (int ai = 0; ai < 2; ++ai)
#pragma unroll
            for (int m = 0; m < 4; ++m) {
                float mx = -3.0e38f;
#pragma unroll
                for (int bj = 0; bj < 2; ++bj)
#pragma unroll
                    for (int n = 0; n < 2; ++n) { const f32x4 v = acc[ai][bj][m][n]; mx = fmaxf(mx, fmaxf(fmaxf(v[0], v[1]), fmaxf(v[2], v[3]))); }
                mx = fmaxf(mx, __shfl_xor(mx, 16)); mx = fmaxf(mx, __shfl_xor(mx, 32));
                float sm = 0.f;
#pragma unroll
                for (int bj = 0; bj < 2; ++bj)
#pragma unroll
                    for (int n = 0; n < 2; ++n) { f32x4 v = acc[ai][bj][m][n];
#pragma unroll
                        for (int j = 0; j < 4; ++j) v[j] = __expf(v[j] - mx);
                        acc[ai][bj][m][n] = v; sm += (v[0] + v[1]) + (v[2] + v[3]); }
                sm += __shfl_xor(sm, 16); sm += __shfl_xor(sm, 32);
                mxs[ai][m] = mx;
                if (fq == 0) X[(ai * HALF + wr * 64 + m * 16 + fr) * 4 + wc] = (f32x2){mx, sm};
                asm volatile("" ::: "memory");
            }
        asm volatile("s_waitcnt lgkmcnt(0)" ::: "memory"); __builtin_amdgcn_s_barrier(); asm volatile("" ::: "memory");
#pragma unroll
        for (int ai = 0; ai < 2; ++ai)
#pragma unroll
            for (int m = 0; m < 4; ++m) {
                const int rl = ai * HALF + wr * 64 + m * 16 + fr;
                const f32x2 p0 = X[rl * 4 + 0], p1 = X[rl * 4 + 1], p2 = X[rl * 4 + 2], p3 = X[rl * 4 + 3];
                const float M = fmaxf(fmaxf(p0.x, p1.x), fmaxf(p2.x, p3.x));
                const float L = (p0.y * __expf(p0.x - M) + p1.y * __expf(p1.x - M)) + (p2.y * __expf(p2.x - M) + p3.y * __expf(p3.x - M));
                const float f = __expf(mxs[ai][m] - M) * __builtin_amdgcn_rcpf(L);
                bf16_t* p = PR + (size_t)(row0 + ai * HALF + m * 16) * 1024 + col;
#pragma unroll
                for (int bj = 0; bj < 2; ++bj) *(u32x4*)(p + bj * HALF) = pack2(acc[ai][bj][m][0] * f, acc[ai][bj][m][1] * f);
                asm volatile("" ::: "memory");
            }
        asm volatile("s_waitcnt lgkmcnt(0)" ::: "memory"); __builtin_amdgcn_s_barrier(); asm volatile("" ::: "memory");
    }
};

template <class Epi>
__device__ __forceinline__ void gemm_phase(PG8_LAS unsigned char* lds, const Gemm g, const Sched& S, const Epi& E, const int wv_) {
    int tid_ = MK_TID; asm volatile("" : "+v"(tid_)); const int tid = tid_, wid = __builtin_amdgcn_readfirstlane(tid >> 6), lane = tid & 63, wr = wid >> 2, wc = wid & 3, fr = lane & 15, fq = lane >> 4;
    const int nt = g.K / BK;
    unsigned voffA[2], voffB[2];
#pragma unroll
    for (int i = 0; i < 2; ++i) { int R, C; stage_rc(tid * 16 + i * 8192, R, C); const int Rb = (R & ~31) + perm32(R & 31);
        voffA[i] = (unsigned)(R * g.lda + C) * 2u; voffB[i] = (unsigned)(Rb * g.ldb + C) * 2u; }
    const size_t kstep = (size_t)(BK * 2);
    const size_t hstepA = (size_t)HALF * g.lda * 2, hstepB = (size_t)HALF * g.ldb * 2;
    const unsigned ldsw = (unsigned)wid * 1024u;
    const int aoff = lds_byte(wr * 64 + fr, fq * 8), boff = lds_byte(wc * 32 + fr, fq * 8);
#define PG8_SA(b, h) (((b) * 2 + (h)) * HTB)
#define PG8_SB(b, h) ((4 + (b) * 2 + (h)) * HTB)
#define PG8_STAGE(bufoff, gbase, voff) do { _Pragma("unroll") for (int _i = 0; _i < 2; ++_i) \
        __builtin_amdgcn_global_load_lds((const unsigned*)((const char*)(gbase) + (voff)[_i]), (PG8_LAS unsigned*)(lds + (bufoff) + ldsw + _i * 8192), 16, 0, 0); } while (0)
#define PG8_LDA(dst, b, h) do { _Pragma("unroll") for (int m = 0; m < 4; ++m) _Pragma("unroll") for (int k = 0; k < 2; ++k) dst[m][k] = *(const PG8_LAS bf16x8*)(lds + PG8_SA(b, h) + aoff + m * 2048 + k * 1024); } while (0)
#define PG8_LDB(dst, b, h) do { _Pragma("unroll") for (int n = 0; n < 2; ++n) _Pragma("unroll") for (int k = 0; k < 2; ++k) dst[n][k] = *(const PG8_LAS bf16x8*)(lds + PG8_SB(b, h) + boff + n * 2048 + k * 1024); } while (0)
#define PG8_MMA(ai, bj, At, Bt) do { __builtin_amdgcn_s_setprio(1); _Pragma("unroll") for (int m = 0; m < 4; ++m) _Pragma("unroll") for (int n = 0; n < 2; ++n) _Pragma("unroll") for (int k = 0; k < 2; ++k) \
        acc[ai][bj][m][n] = __builtin_amdgcn_mfma_f32_16x16x32_bf16(Bt[n][k], At[m][k], acc[ai][bj][m][n], 0, 0, 0); __builtin_amdgcn_s_setprio(0); } while (0)
#define PG8_WAIT_V(n) asm volatile("s_waitcnt vmcnt(" #n ")" ::: "memory")
#define PG8_WAIT_L(n) asm volatile("s_waitcnt lgkmcnt(" #n ")" ::: "memory")
#define PG8_BAR __builtin_amdgcn_s_barrier()
#define PG8_SCHED __builtin_amdgcn_sched_barrier(0)
#define PG8_ZERO do { _Pragma("unroll") for (int a = 0; a < 2; ++a) _Pragma("unroll") for (int b = 0; b < 2; ++b) _Pragma("unroll") for (int m = 0; m < 4; ++m) _Pragma("unroll") for (int n = 0; n < 2; ++n) acc[a][b][m][n] = (f32x4){0.f, 0.f, 0.f, 0.f}; } while (0)
    Unit cur, nxt; int ui = 0;
    if (!S.next(0, cur)) return;
    Acc acc;
    PG8_ZERO;
    bf16x8 At[4][2], B0[2][2], B1[2][2];
    const char* cA = (const char*)g.A + cur.aoff; const char* cB = (const char*)g.Bt + cur.boff;
    PG8_STAGE(PG8_SB(0, 0), cB, voffB); PG8_STAGE(PG8_SB(0, 1), cB + hstepB, voffB); PG8_STAGE(PG8_SA(0, 0), cA, voffA); PG8_STAGE(PG8_SA(0, 1), cA + hstepA, voffA);
    if (wr == 1) PG8_BAR;
    PG8_WAIT_V(2); PG8_BAR;
    PG8_STAGE(PG8_SB(1, 0), cB + kstep, voffB); PG8_STAGE(PG8_SA(1, 0), cA + kstep, voffA); PG8_STAGE(PG8_SB(1, 1), cB + hstepB + kstep, voffB);
    PG8_WAIT_V(6); PG8_BAR;
    for (;;) {
        const bool has_next = S.next(ui + 1, nxt);
        const char* nA = has_next ? (const char*)g.A + nxt.aoff : cA; const char* nB = has_next ? (const char*)g.Bt + nxt.boff : cB;
        for (int t = 0; t < nt; t += 2) {
            const bool last = (t == nt - 2);
            const char* a1 = cA + (size_t)(t + 1) * kstep;
            const char* a2 = last ? nA : cA + (size_t)(t + 2) * kstep; const char* b2 = last ? nB : cB + (size_t)(t + 2) * kstep;
            const char* a3 = a2 + kstep; const char* b3 = b2 + kstep;
            PG8_LDB(B0, 0, 0); PG8_LDB(B1, 0, 1); PG8_SCHED; PG8_LDA(At, 0, 0); PG8_STAGE(PG8_SA(1, 1), a1 + hstepA, voffA);
            PG8_WAIT_V(8); PG8_WAIT_L(0); PG8_BAR; PG8_MMA(0, 0, At, B0); PG8_MMA(0, 1, At, B1); PG8_BAR; PG8_SCHED;
            PG8_LDA(At, 0, 1); PG8_STAGE(PG8_SB(0, 0), b2, voffB); PG8_STAGE(PG8_SB(0, 1), b2 + hstepB, voffB); PG8_STAGE(PG8_SA(0, 0), a2, voffA);
            PG8_WAIT_V(8); PG8_WAIT_L(0); PG8_BAR; PG8_MMA(1, 0, At, B0); PG8_MMA(1, 1, At, B1); PG8_BAR; PG8_SCHED;
            PG8_LDB(B0, 1, 0); PG8_LDB(B1, 1, 1); PG8_SCHED; PG8_LDA(At, 1, 0); PG8_STAGE(PG8_SA(0, 1), a2 + hstepA, voffA);
            PG8_WAIT_V(8); PG8_WAIT_L(0); PG8_BAR; PG8_MMA(0, 0, At, B0); PG8_MMA(0, 1, At, B1); PG8_BAR; PG8_SCHED;
            PG8_LDA(At, 1, 1); PG8_STAGE(PG8_SB(1, 0), b3, voffB); PG8_STAGE(PG8_SB(1, 1), b3 + hstepB, voffB); PG8_STAGE(PG8_SA(1, 0), a3, voffA);
            PG8_WAIT_V(8); PG8_WAIT_L(0); PG8_BAR; PG8_MMA(1, 0, At, B0); PG8_MMA(1, 1, At, B1); PG8_BAR; PG8_SCHED;
        }
        if (wr == 0) PG8_BAR;
        PG8_WAIT_V(0);
        { int te = tid; asm volatile("" : "+v"(te));
          E(acc, cur, (te >> 8) & 1, (te >> 6) & 3, te & 15, (te >> 4) & 3, lds); }
        if (!has_next) break;
        if (!E.keep(cur)) PG8_ZERO;
        cur = nxt; cA = nA; cB = nB; ++ui;
        if (wr == 1) PG8_BAR;
    }
    PG8_WAIT_V(0);
    PG8_BAR;
#undef PG8_SA
#undef PG8_SB
#undef PG8_STAGE
#undef PG8_LDA
#undef PG8_LDB
#undef PG8_MMA
#undef PG8_WAIT_V
#undef PG8_WAIT_L
#undef PG8_BAR
#undef PG8_SCHED
#undef PG8_ZERO
}
}

using pg8::bf16_t; using pg8::f32x4; using pg8::u32x4; using pg8::u32x2; using pg8::bf16x8; using pg8::cvt_pk_bf16; using pg8::sigm;

constexpr int NWAVES = 8, NT = 512;
constexpr int D = 1024, MP = 16384, NSAMP = 128, M_TOK = MP + NSAMP, M_PAD = 16640, SEQ = 2048, NB = 8, FF = 2816, NMEM = 256;
constexpr float DN_ALPHA = 1.41421356237f, LN_EPS = 1e-5f;
constexpr size_t OUT_Y = 0, OUT_POOLP = 16908288, OUT_CONVP = 17031168, OUT_SCP = 17276928, OUT_MK = 17293312, OUT_MV = 21487616,
                 OUT_POOLS = 25681920, OUT_CONVS = 27648000, OUT_SCS = 31580160, OUT_GV = 31842304, OUT_END = 31973376;
constexpr size_t MiB = 1u << 20;
constexpr size_t WO_UP1 = 0, WO_DN1 = WO_UP1 + (size_t)5632 * 1024 * 2, WO_IN = WO_DN1 + (size_t)1024 * 2816 * 2, WO_PROJ = WO_IN + (size_t)8192 * 1024 * 2,
                 WO_WO = WO_PROJ + (size_t)1024 * 2048 * 2, WO_WQ = WO_WO + (size_t)1024 * 1024 * 2, WO_KV = WO_WQ + (size_t)1024 * 1024 * 2, WO_AO = WO_KV + (size_t)2048 * 1024 * 2,
                 WO_UP2 = WO_AO + (size_t)1024 * 1024 * 2, WO_DN2 = WO_UP2 + (size_t)5632 * 1024 * 2, W_LAYER = WO_DN2 + (size_t)1024 * 2816 * 2;
constexpr size_t WS_CTL = 0, CTL_BYTES = 16384 + 8 * 16384;
constexpr size_t WS_XBUF = 256 * 1024;
constexpr size_t WS_W = 1 * MiB, WS_XB = WS_W + 2 * W_LAYER, WS_XF = WS_XB + (size_t)M_PAD * 1024 * 2, WS_R1 = WS_XF + (size_t)M_PAD * 1024 * 4,
                 WS_R2 = WS_R1 + (size_t)M_PAD * 4096 * 2, WS_MIX = WS_R2 + (size_t)M_PAD * 3072 * 2, WS_MRG = WS_MIX + (size_t)M_PAD * 2048 * 2,
                 WS_MEMB = WS_MRG + (size_t)M_PAD * 1024 * 2, WS_KB = WS_MEMB + (size_t)2048 * 1024 * 2, WS_VT = WS_KB + (size_t)2 * 2048 * 1024 * 2, WS_END = WS_VT + (size_t)2 * 2048 * 1024 * 2;
static_assert(W_LAYER % 256 == 0, "align");
constexpr int LDS_BYTES = 147456;

enum { I_XP = 0, I_XS, I_MEM, I_SPOOL, I_SCONV, I_SSC, I_CK, I_CV, I_LN1G, I_LN1B, I_F1W1, I_F1W3, I_F1W2, I_WIN, I_WGATE, I_BGATE, I_POOLW, I_POOLS, I_POOLP,
       I_GLNG, I_GLNB, I_GWS, I_GB, I_GPROJ, I_CDW, I_CDB, I_CLNG, I_CLNB, I_CPROJ, I_SCW, I_SCPROJ, I_WO, I_LN2G, I_LN2B, I_WQ, I_WK, I_WV, I_XWO, I_LN3G, I_LN3B,
       I_F2W1, I_F2W3, I_F2W2, I_LN4G, I_LN4B, N_IN };

struct Args { const float* in[N_IN]; float* out; unsigned char* ws; int ph_lo, ph_hi; };
struct View { const Args* a; int z; unsigned char* ws; float* out; __device__ __forceinline__ const float* in(int i) const { return a->in[i + z]; } };

#define LAS __attribute__((address_space(3)))
__device__ __forceinline__ float wave_sum(float v) {
#pragma unroll
    for (int o = 1; o < 64; o <<= 1) v += __shfl_xor(v, o);
    return v;
}
__device__ __forceinline__ float wave_max(float v) {
#pragma unroll
    for (int o = 1; o < 64; o <<= 1) v = fmaxf(v, __shfl_xor(v, o));
    return v;
}
__device__ __forceinline__ void unpack8(u32x4 w, float (&f)[8]) {
    f[0] = __uint_as_float(w.x << 16); f[1] = __uint_as_float(w.x & 0xffff0000u); f[2] = __uint_as_float(w.y << 16); f[3] = __uint_as_float(w.y & 0xffff0000u);
    f[4] = __uint_as_float(w.z << 16); f[5] = __uint_as_float(w.z & 0xffff0000u); f[6] = __uint_as_float(w.w << 16); f[7] = __uint_as_float(w.w & 0xffff0000u);
}
__device__ __forceinline__ u32x4 pack8(const float (&f)[8]) { u32x4 w; w.x = cvt_pk_bf16(f[0], f[1]); w.y = cvt_pk_bf16(f[2], f[3]); w.z = cvt_pk_bf16(f[4], f[5]); w.w = cvt_pk_bf16(f[6], f[7]); return w; }
__device__ __forceinline__ void ldf8(const float* p, float (&f)[8]) { const f32x4 a = *(const f32x4*)p, b = *(const f32x4*)(p + 4); f[0] = a[0]; f[1] = a[1]; f[2] = a[2]; f[3] = a[3]; f[4] = b[0]; f[5] = b[1]; f[6] = b[2]; f[7] = b[3]; }
__device__ __forceinline__ void stf8(float* p, const float (&f)[8]) { *(f32x4*)p = (f32x4){f[0], f[1], f[2], f[3]}; *(f32x4*)(p + 4) = (f32x4){f[4], f[5], f[6], f[7]}; }
__device__ __forceinline__ void ldb8(const bf16_t* p, float (&f)[8]) { unpack8(*(const u32x4*)p, f); }

__device__ __forceinline__ void transpose_item(const float* W, int N, bf16_t* WT, int ldd, int koff, int k0, int n0, int drow0, LAS float* scr, int lane) {
    float wreg[32];
#pragma unroll
    for (int i = 0; i < 32; ++i) { const int kk = 2 * i + (lane >> 5); wreg[i] = __builtin_nontemporal_load(W + (size_t)(k0 + kk) * N + n0 + (lane & 31)); }
#pragma unroll
    for (int i = 0; i < 32; ++i) { const int kk = 2 * i + (lane >> 5); scr[kk * 33 + (lane & 31)] = wreg[i]; }
    asm volatile("s_waitcnt lgkmcnt(0)" ::: "memory");
    const int c = lane & 7;
#pragma unroll
    for (int j = 0; j < 4; ++j) { const int n = (lane >> 3) + 8 * j; const LAS float* s = scr + (8 * c) * 33 + n;
        u32x4 o; o.x = cvt_pk_bf16(s[0 * 33], s[1 * 33]); o.y = cvt_pk_bf16(s[2 * 33], s[3 * 33]); o.z = cvt_pk_bf16(s[4 * 33], s[5 * 33]); o.w = cvt_pk_bf16(s[6 * 33], s[7 * 33]);
        *(u32x4*)(WT + (size_t)(drow0 + n) * ldd + koff + k0 + 8 * c) = o; }
    asm volatile("s_waitcnt lgkmcnt(0)" ::: "memory");
}
__device__ __forceinline__ int map_pair(int n0, int half) { return 256 * (n0 >> 7) + 128 * half + (n0 & 127); }
__device__ __forceinline__ int map_win(int n0) {
    const int seg = n0 >> 9, o = n0 & 511;
    switch (seg) { case 0: case 1: case 2: return n0;
        case 3: return 1536 + map_pair(o, 0); case 4: return 1536 + map_pair(o, 1); case 5: return 2560 + o;
        case 6: return 3072 + map_pair(o, 0); default: return 3072 + map_pair(o, 1); }
}
#define NJOBS 16
template <int J> struct TJ;
#define DEF_TJ(J, SRC, K_, N_, LDD, KOFF, MAP, DST) template <> struct TJ<J> { static constexpr int src = SRC, K = K_, N = N_, ldd = LDD, koff = KOFF, map = MAP, items = (K_ / 64) * (N_ / 32); static constexpr size_t dst = DST; };
DEF_TJ(0, I_F1W1, 1024, 2816, 1024, 0, 1, WO_UP1)
DEF_TJ(1, I_F1W3, 1024, 2816, 1024, 0, 2, WO_UP1)
DEF_TJ(2, I_F1W2, 2816, 1024, 2816, 0, 0, WO_DN1)
DEF_TJ(3, I_WIN, 1024, 4096, 1024, 0, 3, WO_IN)
DEF_TJ(4, I_WGATE, 1024, 4096, 1024, 0, 4, WO_IN)
DEF_TJ(5, I_GPROJ, 512, 1024, 2048, 512, 0, WO_PROJ)
DEF_TJ(6, I_CPROJ, 512, 1024, 2048, 1024, 0, WO_PROJ)
DEF_TJ(7, I_SCPROJ, 512, 1024, 2048, 1536, 0, WO_PROJ)
DEF_TJ(8, I_WO, 1024, 1024, 1024, 0, 0, WO_WO)
DEF_TJ(9, I_WQ, 1024, 1024, 1024, 0, 0, WO_WQ)
DEF_TJ(10, I_WK, 1024, 1024, 1024, 0, 0, WO_KV)
DEF_TJ(11, I_WV, 1024, 1024, 1024, 0, 5, WO_KV)
DEF_TJ(12, I_XWO, 1024, 1024, 1024, 0, 0, WO_AO)
DEF_TJ(13, I_F2W1, 1024, 2816, 1024, 0, 1, WO_UP2)
DEF_TJ(14, I_F2W3, 1024, 2816, 1024, 0, 2, WO_UP2)
DEF_TJ(15, I_F2W2, 2816, 1024, 2816, 0, 0, WO_DN2)
template <int J> __device__ __forceinline__ void run_tjob(const View& a, LAS float* scr, int lane, int gw, int NGW, int& base) {
    typedef TJ<J> T;
    const float* W0 = a.in(T::src); unsigned char* wsW = a.ws + WS_W + T::dst;
    int r = (gw - base) % NGW; if (r < 0) r += NGW;
    for (; r < 2 * T::items; r += NGW) {
        const int l = r / T::items, q = r % T::items;
        constexpr int nblk = T::N / 32; const int kb = q / nblk, nb = q % nblk, n0 = nb * 32;
        int drow;
        if (T::map == 0) drow = n0; else if (T::map == 1) drow = map_pair(n0, 0); else if (T::map == 2) drow = map_pair(n0, 1); else if (T::map == 3) drow = map_win(n0); else if (T::map == 4) drow = 4096 + n0; else drow = 1024 + n0;
        transpose_item(W0 + (size_t)l * T::K * T::N, T::N, (bf16_t*)(wsW + (size_t)l * W_LAYER), T::ldd, T::koff, kb * 64, n0, drow, scr, lane);
    }
    base = (base + 2 * T::items) % NGW;
}

__device__ __forceinline__ void prologue(const View& a, unsigned char* lds_g, int G, int cid, const int wv_) {
    int tid_ = MK_TID; asm volatile("" : "+v"(tid_)); const int tid = tid_, lane = tid & 63, wave = __builtin_amdgcn_readfirstlane(tid >> 6);
    const int gw = cid * NWAVES + wave, NGW = G * NWAVES;
    LAS float* scr = (LAS float*)((LAS unsigned char*)lds_g + wave * 16384);
    { int base = 0;
      run_tjob<0>(a, scr, lane, gw, NGW, base); run_tjob<1>(a, scr, lane, gw, NGW, base); run_tjob<2>(a, scr, lane, gw, NGW, base); run_tjob<3>(a, scr, lane, gw, NGW, base);
      run_tjob<4>(a, scr, lane, gw, NGW, base); run_tjob<5>(a, scr, lane, gw, NGW, base); run_tjob<6>(a, scr, lane, gw, NGW, base); run_tjob<7>(a, scr, lane, gw, NGW, base);
      run_tjob<8>(a, scr, lane, gw, NGW, base); run_tjob<9>(a, scr, lane, gw, NGW, base); run_tjob<10>(a, scr, lane, gw, NGW, base); run_tjob<11>(a, scr, lane, gw, NGW, base);
      run_tjob<12>(a, scr, lane, gw, NGW, base); run_tjob<13>(a, scr, lane, gw, NGW, base); run_tjob<14>(a, scr, lane, gw, NGW, base); run_tjob<15>(a, scr, lane, gw, NGW, base); }
    for (int it = gw; it < 2048; it += NGW) {
        const int l = it >> 10, k0 = ((it >> 4) & 63) * 8, g = k0 >> 7, n = (it & 15) * 64 + lane;
        const float* pw = a.in(I_POOLW) + ((size_t)l * 512 + k0) * 128;
        const float* sc = a.in(I_POOLS) + l * 512 + g * 128;
        const float* pp = a.in(I_POOLP) + ((size_t)l * 512 + g * 128) * 1024 + n;
        float acc[8];
#pragma unroll
        for (int kk = 0; kk < 8; ++kk) acc[kk] = 0.f;
#pragma unroll 2
        for (int d = 0; d < 128; d += 4) {
            float p[4];
#pragma unroll
            for (int q = 0; q < 4; ++q) p[q] = pp[(size_t)(d + q) * 1024] * sc[d + q];
#pragma unroll
            for (int kk = 0; kk < 8; ++kk) { const f32x4 w = *(const f32x4*)(pw + kk * 128 + d); acc[kk] += (w[0] * p[0] + w[1] * p[1]) + (w[2] * p[2] + w[3] * p[3]); }
        }
        *(u32x4*)((bf16_t*)(a.ws + WS_W + (size_t)l * W_LAYER + WO_PROJ) + (size_t)n * 2048 + k0) = pack8(acc);
    }
    bf16_t* XB = (bf16_t*)(a.ws + WS_XB); bf16_t* MEMB = (bf16_t*)(a.ws + WS_MEMB);
    for (int r = gw; r < M_PAD + 2048; r += NGW) {
        if (r < M_PAD) {
            const float* src = r < MP ? a.in(I_XP) + (size_t)r * D : a.in(I_XS) + (size_t)(r - MP) * D;
#pragma unroll
            for (int j = 0; j < 4; ++j) {
                f32x4 v = (f32x4){0.f, 0.f, 0.f, 0.f};
                if (r < M_TOK) v = __builtin_nontemporal_load((const f32x4*)(src + 256 * j + 4 * lane));
                *(u32x2*)(XB + (size_t)r * D + 256 * j + 4 * lane) = (u32x2){cvt_pk_bf16(v[0], v[1]), cvt_pk_bf16(v[2], v[3])};
            }
        } else {
            const int m = r - M_PAD; const float* src = a.in(I_MEM) + (size_t)m * D;
#pragma unroll
            for (int j = 0; j < 4; ++j) { const f32x4 v = __builtin_nontemporal_load((const f32x4*)(src + 256 * j + 4 * lane));
                *(u32x2*)(MEMB + (size_t)m * D + 256 * j + 4 * lane) = (u32x2){cvt_pk_bf16(v[0], v[1]), cvt_pk_bf16(v[2], v[3])}; }
        }
    }
}

__device__ __forceinline__ void ln_pass_sample(const float* Ys, bf16_t* XB, const float* g, const float* b, float* out, int G, int cid, const int wv_) {
    int tid_ = MK_TID; asm volatile("" : "+v"(tid_)); const int tid = tid_, lane = tid & 63, wave = __builtin_amdgcn_readfirstlane(tid >> 6);
    const int gw = cid * NWAVES + wave, NGW = G * NWAVES;
    for (int r = gw; r < NSAMP; r += NGW) {
        const float* xr = Ys + (size_t)r * D + 4 * lane;
        f32x4 v[4]; float s = 0.f;
#pragma unroll
        for (int j = 0; j < 4; ++j) { v[j] = *(const f32x4*)(xr + 256 * j); s += (v[j][0] + v[j][1]) + (v[j][2] + v[j][3]); }
        const float mean = wave_sum(s) * (1.f / D); float s2 = 0.f;
#pragma unroll
        for (int j = 0; j < 4; ++j) { v[j] = v[j] - mean; s2 += (v[j][0] * v[j][0] + v[j][1] * v[j][1]) + (v[j][2] * v[j][2] + v[j][3] * v[j][3]); }
        const float rstd = 1.0f / sqrtf(wave_sum(s2) * (1.f / D) + LN_EPS);
#pragma unroll
        for (int j = 0; j < 4; ++j) {
            const f32x4 y = v[j] * rstd * *(const f32x4*)(g + 256 * j + 4 * lane) + *(const f32x4*)(b + 256 * j + 4 * lane);
            *(u32x2*)(XB + (size_t)(MP + r) * D + 256 * j + 4 * lane) = (u32x2){cvt_pk_bf16(y[0], y[1]), cvt_pk_bf16(y[2], y[3])};
            if (out) *(f32x4*)(out + (size_t)(MP + r) * D + 256 * j + 4 * lane) = y;
        }
    }
}

template <bool DO_C>
__device__ __forceinline__ void mix_row_p(const View& a, int l, int r, int lane, const bf16_t* P, bf16_t* MIX, const LAS float* DW, const LAS bf16_t* GLrow) {
    const int ch0 = lane * 8, b = r >> 11, t = r & 2047;
    const bf16_t* Pr = P + (size_t)r * 3072 + ch0; bf16_t* Mr = MIX + (size_t)r * 2048 + ch0; float* out = a.out + ch0;
    {
        const int win = 2 << (lane >> 4);
        float av[8], sacc[8]; ldb8(Pr, av);
#pragma unroll
        for (int c = 0; c < 8; ++c) sacc[c] = av[c];
        u32x4 x[15];
#pragma unroll
        for (int i = 1; i < 16; ++i) { const int dr = i > t ? t : i; x[i - 1] = *(const u32x4*)(Pr - (ptrdiff_t)dr * 3072); }
#pragma unroll
        for (int i = 1; i < 16; ++i) { float f[8]; unpack8(x[i - 1], f); const float mk = (i < win && i <= t) ? 1.f : 0.f;
#pragma unroll
            for (int c = 0; c < 8; ++c) sacc[c] += f[c] * mk; }
        const int cnt = t + 1 < win ? t + 1 : win; const float inv = 1.0f / (float)cnt; float o[8];
#pragma unroll
        for (int c = 0; c < 8; ++c) o[c] = sacc[c] * inv - av[c];
        *(u32x4*)(Mr) = pack8(o);
        if (t >= SEQ - 15) stf8(out + OUT_POOLP + ((size_t)(l * NB + b) * 15 + (t - (SEQ - 15))) * 512, av);
    }
    asm volatile("" ::: "memory");
    if constexpr (DO_C) {
        float cacc[8]; ldf8(a.in(I_CDB) + l * 512 + ch0, cacc);
#pragma unroll
        for (int jb = 0; jb < 31; jb += 8) {
            u32x4 x[8];
#pragma unroll
            for (int u = 0; u < 8; ++u) { const int j = jb + u; if (j < 31) x[u] = *(const LAS u32x4*)(GLrow - (30 - j) * 512 + ch0); }
#pragma unroll
            for (int u = 0; u < 8; ++u) { const int j = jb + u; if (j < 31) {
                float f[8]; unpack8(x[u], f); const float mk = (30 - j <= t) ? 1.f : 0.f;
                const f32x4 w0 = *(const LAS f32x4*)(DW + j * 512 + ch0) * mk, w1 = *(const LAS f32x4*)(DW + j * 512 + ch0 + 4) * mk;
                cacc[0] += f[0] * w0[0]; cacc[1] += f[1] * w0[1]; cacc[2] += f[2] * w0[2]; cacc[3] += f[3] * w0[3];
                cacc[4] += f[4] * w1[0]; cacc[5] += f[5] * w1[1]; cacc[6] += f[6] * w1[2]; cacc[7] += f[7] * w1[3];
            } }
            asm volatile("" ::: "memory");
        }
        float sm = 0.f;
#pragma unroll
        for (int c = 0; c < 8; ++c) sm += cacc[c];
        const float mean = wave_sum(sm) * (1.f / 512.f); float s2 = 0.f;
#pragma unroll
        for (int c = 0; c < 8; ++c) { cacc[c] -= mean; s2 += cacc[c] * cacc[c]; }
        const float rstd = 1.0f / sqrtf(wave_sum(s2) * (1.f / 512.f) + LN_EPS);
        float g[8], bb[8], o[8]; ldf8(a.in(I_CLNG) + l * 512 + ch0, g); ldf8(a.in(I_CLNB) + l * 512 + ch0, bb);
#pragma unroll
        for (int c = 0; c < 8; ++c) { const float y = cacc[c] * rstd * g[c] + bb[c]; o[c] = y * sigm(y); }
        *(u32x4*)(Mr + 1024) = pack8(o);
        if (t >= SEQ - 30) { float gl[8]; ldb8(Pr + 1536, gl); stf8(out + OUT_CONVP + ((size_t)(l * NB + b) * 30 + (t - (SEQ - 30))) * 512, gl); }
    }
    {
        const float* sw = a.in(I_SCW) + (size_t)l * 3 * 512 + ch0;
        float w0[8], w1[8], w2[8], z0[8], z1[8], z2[8], sb[8], o[8];
        ldf8(sw, w0); ldf8(sw + 512, w1); ldf8(sw + 1024, w2);
        const u32x4 xz2 = *(const u32x4*)(Pr + 2560), xsb = *(const u32x4*)(Pr + 2048);
        const u32x4 xz1 = *(const u32x4*)(Pr - (ptrdiff_t)(t >= 1 ? 1 : 0) * 3072 + 2560), xz0 = *(const u32x4*)(Pr - (ptrdiff_t)(t >= 2 ? 2 : 0) * 3072 + 2560);
        unpack8(xz2, z2); unpack8(xsb, sb); unpack8(xz1, z1); unpack8(xz0, z0);
        const float m1 = t >= 1 ? 1.f : 0.f, m0 = t >= 2 ? 1.f : 0.f;
#pragma unroll
        for (int c = 0; c < 8; ++c) o[c] = sb[c] * (w0[c] * z0[c] * m0 + w1[c] * z1[c] * m1 + w2[c] * z2[c]);
        *(u32x4*)(Mr + 1536) = pack8(o);
        if (t >= SEQ - 2) stf8(out + OUT_SCP + ((size_t)(l * NB + b) * 2 + (t - (SEQ - 2))) * 512, z2);
    }
}

__device__ __forceinline__ void conv4_lds(const View& a, int l, int r0, int lane, bf16_t* MIX, const LAS float* DW, const LAS bf16_t* GLw) {
    const int ch0 = lane * 8;
    float cacc[4][8];
    { float db[8]; ldf8(a.in(I_CDB) + l * 512 + ch0, db);
#pragma unroll
      for (int i = 0; i < 4; ++i)
#pragma unroll
          for (int c = 0; c < 8; ++c) cacc[i][c] = db[c]; }
    float wv[4][8];
#pragma unroll
    for (int q = 0; q < 34; ++q) {
        if (q <= 30) { const f32x4 w0 = *(const LAS f32x4*)(DW + q * 512 + ch0), w1 = *(const LAS f32x4*)(DW + q * 512 + ch0 + 4);
            wv[q & 3][0] = w0[0]; wv[q & 3][1] = w0[1]; wv[q & 3][2] = w0[2]; wv[q & 3][3] = w0[3]; wv[q & 3][4] = w1[0]; wv[q & 3][5] = w1[1]; wv[q & 3][6] = w1[2]; wv[q & 3][7] = w1[3]; }
        float f[8]; unpack8(*(const LAS u32x4*)(GLw + q * 512 + ch0), f);
#pragma unroll
        for (int i = 0; i < 4; ++i) { const int j = q - i; if (j >= 0 && j <= 30) {
#pragma unroll
                for (int c = 0; c < 8; ++c) cacc[i][c] += f[c] * wv[j & 3][c]; } }
    }
    float g[8], bb[8]; ldf8(a.in(I_CLNG) + l * 512 + ch0, g); ldf8(a.in(I_CLNB) + l * 512 + ch0, bb);
#pragma unroll
    for (int i = 0; i < 4; ++i) {
        float sm = 0.f;
#pragma unroll
        for (int c = 0; c < 8; ++c) sm += cacc[i][c];
        const float mean = wave_sum(sm) * (1.f / 512.f); float s2 = 0.f;
#pragma unroll
        for (int c = 0; c < 8; ++c) { cacc[i][c] -= mean; s2 += cacc[i][c] * cacc[i][c]; }
        const float rstd = 1.0f / sqrtf(wave_sum(s2) * (1.f / 512.f) + LN_EPS); float o[8];
#pragma unroll
        for (int c = 0; c < 8; ++c) { const float y = cacc[i][c] * rstd * g[c] + bb[c]; o[c] = y * sigm(y); }
        *(u32x4*)(MIX + (size_t)(r0 + i) * 2048 + 1024 + ch0) = pack8(o);
    }
    const int t0 = r0 & 2047, b = r0 >> 11;
    if (t0 + 3 >= SEQ - 30) {
        for (int i = 0; i < 4; ++i) { const int t = t0 + i; if (t >= SEQ - 30) { float f[8]; unpack8(*(const LAS u32x4*)(GLw + (30 + i) * 512 + ch0), f);
            stf8(a.out + OUT_CONVP + ((size_t)(l * NB + b) * 30 + (t - (SEQ - 30))) * 512 + ch0, f); } }
    }
}

__device__ __forceinline__ void mix_row_s(const View& a, int l, int bs, int lane, const bf16_t* P, bf16_t* MIX, const LAS float* DW) {
    const int ch0 = lane * 8, r = MP + bs;
    const bf16_t* Pr = P + (size_t)r * 3072 + ch0; bf16_t* Mr = MIX + (size_t)r * 2048 + ch0; float* out = a.out + ch0;
    {
        const int win = 2 << (lane >> 4);
        const float* sp = a.in(I_SPOOL) + ((size_t)(l * NSAMP + bs) * 15) * 512 + ch0;
        float* dp = out + OUT_POOLS + ((size_t)(l * NSAMP + bs) * 15) * 512;
        float av[8], sacc[8]; ldb8(Pr, av);
#pragma unroll
        for (int c = 0; c < 8; ++c) sacc[c] = av[c];
        f32x4 x0[15], x1[15];
#pragma unroll
        for (int i = 0; i < 15; ++i) { x0[i] = *(const f32x4*)(sp + i * 512); x1[i] = *(const f32x4*)(sp + i * 512 + 4); }
#pragma unroll
        for (int i = 0; i < 15; ++i) { const float mk = (15 - i < win) ? 1.f : 0.f;
            sacc[0] += x0[i][0] * mk; sacc[1] += x0[i][1] * mk; sacc[2] += x0[i][2] * mk; sacc[3] += x0[i][3] * mk; sacc[4] += x1[i][0] * mk; sacc[5] += x1[i][1] * mk; sacc[6] += x1[i][2] * mk; sacc[7] += x1[i][3] * mk;
            if (i >= 1) { *(f32x4*)(dp + (i - 1) * 512) = x0[i]; *(f32x4*)(dp + (i - 1) * 512 + 4) = x1[i]; } }
        stf8(dp + 14 * 512, av);
        const float inv = 1.0f / (float)win; float o[8];
#pragma unroll
        for (int c = 0; c < 8; ++c) o[c] = sacc[c] * inv - av[c];
        *(u32x4*)(Mr) = pack8(o);
    }
    asm volatile("" ::: "memory");
    {
        float cacc[8]; ldf8(a.in(I_CDB) + l * 512 + ch0, cacc);
        const float* sp = a.in(I_SCONV) + ((size_t)(l * NSAMP + bs) * 30) * 512 + ch0;
        float* dp = out + OUT_CONVS + ((size_t)(l * NSAMP + bs) * 30) * 512;
#pragma unroll
        for (int jb = 0; jb < 30; jb += 10) {
            f32x4 x0[10], x1[10];
#pragma unroll
            for (int u = 0; u < 10; ++u) { x0[u] = *(const f32x4*)(sp + (jb + u) * 512); x1[u] = *(const f32x4*)(sp + (jb + u) * 512 + 4); }
#pragma unroll
            for (int u = 0; u < 10; ++u) { const int j = jb + u;
                const f32x4 w0 = *(const LAS f32x4*)(DW + j * 512 + ch0), w1 = *(const LAS f32x4*)(DW + j * 512 + ch0 + 4);
                cacc[0] += x0[u][0] * w0[0]; cacc[1] += x0[u][1] * w0[1]; cacc[2] += x0[u][2] * w0[2]; cacc[3] += x0[u][3] * w0[3];
                cacc[4] += x1[u][0] * w1[0]; cacc[5] += x1[u][1] * w1[1]; cacc[6] += x1[u][2] * w1[2]; cacc[7] += x1[u][3] * w1[3];
                if (j >= 1) { *(f32x4*)(dp + (j - 1) * 512) = x0[u]; *(f32x4*)(dp + (j - 1) * 512 + 4) = x1[u]; } }
            asm volatile("" ::: "memory");
        }
        { float gl[8]; ldb8(Pr + 1536, gl);
          const f32x4 w0 = *(const LAS f32x4*)(DW + 30 * 512 + ch0), w1 = *(const LAS f32x4*)(DW + 30 * 512 + ch0 + 4);
          cacc[0] += gl[0] * w0[0]; cacc[1] += gl[1] * w0[1]; cacc[2] += gl[2] * w0[2]; cacc[3] += gl[3] * w0[3]; cacc[4] += gl[4] * w1[0]; cacc[5] += gl[5] * w1[1]; cacc[6] += gl[6] * w1[2]; cacc[7] += gl[7] * w1[3];
          stf8(dp + 29 * 512, gl); }
        float sm = 0.f;
#pragma unroll
        for (int c = 0; c < 8; ++c) sm += cacc[c];
        const float mean = wave_sum(sm) * (1.f / 512.f); float s2 = 0.f;
#pragma unroll
        for (int c = 0; c < 8; ++c) { cacc[c] -= mean; s2 += cacc[c] * cacc[c]; }
        const float rstd = 1.0f / sqrtf(wave_sum(s2) * (1.f / 512.f) + LN_EPS);
        float g[8], bb[8], o[8]; ldf8(a.in(I_CLNG) + l * 512 + ch0, g); ldf8(a.in(I_CLNB) + l * 512 + ch0, bb);
#pragma unroll
        for (int c = 0; c < 8; ++c) { const float y = cacc[c] * rstd * g[c] + bb[c]; o[c] = y * sigm(y); }
        *(u32x4*)(Mr + 1024) = pack8(o);
    }
    {
        const float* sw = a.in(I_SCW) + (size_t)l * 3 * 512 + ch0;
        float w0[8], w1[8], w2[8], z0[8], z1[8], z2[8], sb[8], o[8];
        ldf8(sw, w0); ldf8(sw + 512, w1); ldf8(sw + 1024, w2);
        ldb8(Pr + 2560, z2); ldb8(Pr + 2048, sb);
        const float* sp = a.in(I_SSC) + ((size_t)(l * NSAMP + bs) * 2) * 512 + ch0;
        float* dp = out + OUT_SCS + ((size_t)(l * NSAMP + bs) * 2) * 512;
        ldf8(sp, z0); ldf8(sp + 512, z1);
        stf8(dp, z1); stf8(dp + 512, z2);
#pragma unroll
        for (int c = 0; c < 8; ++c) o[c] = sb[c] * (w0[c] * z0[c] + w1[c] * z1[c] + w2[c] * z2[c]);
        *(u32x4*)(Mr + 1536) = pack8(o);
    }
    {
        float v[8]; ldb8(Pr + 1024, v);
        float sm = 0.f;
#pragma unroll
        for (int c = 0; c < 8; ++c) sm += v[c];
        const float mean = wave_sum(sm) * (1.f / 512.f); float s2 = 0.f;
#pragma unroll
        for (int c = 0; c < 8; ++c) { v[c] -= mean; s2 += v[c] * v[c]; }
        const float rstd = 1.0f / sqrtf(wave_sum(s2) * (1.f / 512.f) + LN_EPS);
        float g[8], bb[8], u[8], o[8]; ldf8(a.in(I_GLNG) + l * 512 + ch0, g); ldf8(a.in(I_GLNB) + l * 512 + ch0, bb); ldb8(Pr + 512, u);
        const int h = lane >> 4;
        const float w00 = a.in(I_GWS)[((size_t)(l * 4 + h) * 128) * 128], b0 = a.in(I_GB)[(l * 4 + h) * 128];
#pragma unroll
        for (int c = 0; c < 8; ++c) { v[c] = v[c] * rstd * g[c] + bb[c]; o[c] = u[c] * (w00 * v[c] + b0); }
        stf8(out + OUT_GV + (size_t)(l * NSAMP + bs) * 512, v);
        *(u32x4*)(Mr + 512) = pack8(o);
    }
}

__device__ __forceinline__ void sgu_unit(const View& a, int l, int un, unsigned char* lds_g, const bf16_t* P, bf16_t* MIX, const int wv_) {
    int tid_ = MK_TID; asm volatile("" : "+v"(tid_)); const int tid = tid_, lane = tid & 63, wave = __builtin_amdgcn_readfirstlane(tid >> 6);
    const int ck = un >> 1, h0 = (un & 1) * 2; const int r0 = ck * 128;
    LAS bf16_t* V = (LAS bf16_t*)lds_g;
    {
        float g[8], bb[8]; ldf8(a.in(I_GLNG) + l * 512 + lane * 8, g); ldf8(a.in(I_GLNB) + l * 512 + lane * 8, bb);
        u32x4 vr[16];
#pragma unroll
        for (int i = 0; i < 16; ++i) vr[i] = *(const u32x4*)(P + (size_t)(r0 + wave * 16 + i) * 3072 + 1024 + lane * 8);
#pragma unroll
        for (int i = 0; i < 16; ++i) {
            const int s_ = wave * 16 + i;
            float v[8]; unpack8(vr[i], v);
            float s = 0.f;
#pragma unroll
            for (int q = 0; q < 8; ++q) s += v[q];
            const float mean = wave_sum(s) * (1.f / 512.f); float s2 = 0.f;
#pragma unroll
            for (int q = 0; q < 8; ++q) { v[q] -= mean; s2 += v[q] * v[q]; }
            const float rstd = 1.0f / sqrtf(wave_sum(s2) * (1.f / 512.f) + LN_EPS);
            if ((lane >> 5) == (h0 >> 1)) {
                LAS unsigned* dst = (LAS unsigned*)(V + ((lane >> 4) & 1) * (128 * 130) + s_ * 130 + (lane & 15) * 8);
#pragma unroll
                for (int q = 0; q < 4; ++q) dst[q] = cvt_pk_bf16(v[2 * q] * rstd * g[2 * q] + bb[2 * q], v[2 * q + 1] * rstd * g[2 * q + 1] + bb[2 * q + 1]);
            }
        }
    }
    __syncthreads();
    for (int hh = 0; hh < 2; ++hh) {
        const int h = h0 + hh; const LAS bf16_t* Vh = V + hh * (128 * 130);
        const int t0 = wave * 16, nk = (t0 + 16 + 31) >> 5, fr = lane & 15, fq = lane >> 4;
        const int t = t0 + fr;
        const float* Wrow = a.in(I_GWS) + ((size_t)(l * 4 + h) * 128 + t) * 128;
        f32x4 acc[8];
#pragma unroll
        for (int n = 0; n < 8; ++n) acc[n] = (f32x4){0.f, 0.f, 0.f, 0.f};
        for (int kk = 0; kk < nk; ++kk) {
            const int s0 = kk * 32 + fq * 8;
            float w[8]; ldf8(Wrow + s0, w);
#pragma unroll
            for (int q = 0; q < 8; ++q) if (s0 + q > t) w[q] = 0.f;
            const u32x4 wp = pack8(w);
            const bf16x8 wf = __builtin_bit_cast(bf16x8, wp);
#pragma unroll
            for (int n = 0; n < 8; ++n) {
                bf16x8 vf;
#pragma unroll
                for (int q = 0; q < 8; ++q) vf[q] = (short)Vh[(s0 + q) * 130 + n * 16 + fr];
                acc[n] = __builtin_amdgcn_mfma_f32_16x16x32_bf16(vf, wf, acc[n], 0, 0, 0);
            }
        }
        const float bias = a.in(I_GB)[(l * 4 + h) * 128 + t];
        const bf16_t* up = P + (size_t)(r0 + t) * 3072 + 512 + h * 128 + fq * 4;
        bf16_t* op = MIX + (size_t)(r0 + t) * 2048 + 512 + h * 128 + fq * 4;
#pragma unroll
        for (int n = 0; n < 8; ++n) {
            const u32x2 uu = *(const u32x2*)(up + n * 16);
            const f32x4 u4 = pg8::bflo(uu.x, uu.y);
            const f32x4 z = (acc[n] + bias) * u4;
            *(u32x2*)(op + n * 16) = (u32x2){cvt_pk_bf16(z[0], z[1]), cvt_pk_bf16(z[2], z[3])};
        }
    }
    __syncthreads();
}

__device__ __forceinline__ void samp_attn_unit(const View& a, int l, int un, unsigned char* lds_g, const bf16_t* Q, bf16_t* O, const int wv_) {
    int tid_ = MK_TID; asm volatile("" : "+v"(tid_)); const int tid = tid_, lane = tid & 63, wave = __builtin_amdgcn_readfirstlane(tid >> 6);
    const int b = un >> 2, h = un & 3;
    LAS float* S = (LAS float*)lds_g;
    LAS float* Pl = S + 256;
    LAS float* RED = S + 512;
    const size_t base = (((size_t)(l * NSAMP + b) * NMEM) * 4 + h) * 256;
    const float* Kp = a.in(I_CK) + base + 4 * lane; const float* Vp = a.in(I_CV) + base + 4 * lane;
    const u32x2 qq = *(const u32x2*)(Q + (size_t)(MP + b) * D + h * 256 + 4 * lane);
    const f32x4 q4 = pg8::bflo(qq.x, qq.y);
    for (int mm = 0; mm < 32; mm += 8) {
        f32x4 k[8];
#pragma unroll
        for (int i = 0; i < 8; ++i) k[i] = __builtin_nontemporal_load((const f32x4*)(Kp + (size_t)(wave * 32 + mm + i) * 1024));
#pragma unroll
        for (int i = 0; i < 8; ++i) { float d = (q4[0] * k[i][0] + q4[1] * k[i][1]) + (q4[2] * k[i][2] + q4[3] * k[i][3]); d = wave_sum(d); if (lane == 0) S[wave * 32 + mm + i] = d; }
    }
    __syncthreads();
    {
        const float s0 = S[lane], s1 = S[64 + lane], s2 = S[128 + lane], s3 = S[192 + lane];
        const float mx = wave_max(fmaxf(fmaxf(s0, s1), fmaxf(s2, s3)));
        const float e0 = __expf(s0 - mx), e1 = __expf(s1 - mx), e2 = __expf(s2 - mx), e3 = __expf(s3 - mx);
        const float inv = 1.0f / wave_sum((e0 + e1) + (e2 + e3));
        if (wave == 0) { Pl[lane] = e0 * inv; Pl[64 + lane] = e1 * inv; Pl[128 + lane] = e2 * inv; Pl[192 + lane] = e3 * inv; }
    }
    __syncthreads();
    {
        f32x4 o = (f32x4){0.f, 0.f, 0.f, 0.f};
        for (int mm = 0; mm < 32; mm += 8) {
            f32x4 v[8];
#pragma unroll
            for (int i = 0; i < 8; ++i) v[i] = __builtin_nontemporal_load((const f32x4*)(Vp + (size_t)(wave * 32 + mm + i) * 1024));
#pragma unroll
            for (int i = 0; i < 8; ++i) o += v[i] * Pl[wave * 32 + mm + i];
        }
        *(LAS f32x4*)(RED + wave * 256 + 4 * lane) = o;
    }
    __syncthreads();
    if (tid < 256) {
        float s = 0.f;
#pragma unroll
        for (int w = 0; w < 8; ++w) s += RED[w * 256 + tid];
        const float other = __shfl_xor(s, 1);
        if ((tid & 1) == 0) *(unsigned*)(O + (size_t)(MP + b) * D + h * 256 + tid) = cvt_pk_bf16(s, other);
    }
    __syncthreads();
}

template <int MODE>
__device__ __forceinline__ void skinny_gemm(unsigned char* lds_g, const bf16_t* A, int lda, const bf16_t* Bt, int ldb, int Kq, float* X, bf16_t* O, const bf16_t* GATE, float alpha, float sc, int G, int cid, const int wv_) {
    int tid_ = MK_TID; asm volatile("" : "+v"(tid_)); const int tid = tid_, lane = tid & 63, wave = __builtin_amdgcn_readfirstlane(tid >> 6);
    const int rg = wave & 1, kq = wave >> 1, fr = lane & 15, fq = lane >> 4, nIt = Kq >> 5;
    LAS f32x4* RED = (LAS f32x4*)lds_g;
    for (int j = cid; j < 256; j += G) {
        const int rb = j & 3, cb = j >> 2;
        const bf16_t* ap = A + (size_t)(MP + rb * 32 + rg * 16 + fr) * lda + kq * Kq + fq * 8;
        const bf16_t* bp = Bt + (size_t)(cb * 16 + fr) * ldb + kq * Kq + fq * 8;
        f32x4 acc = (f32x4){0.f, 0.f, 0.f, 0.f};
        for (int k = 0; k < nIt; k += 4) {
            bf16x8 a[4], b[4];
#pragma unroll
            for (int u = 0; u < 4; ++u) {
                if (k + u < nIt) { a[u] = *(const bf16x8*)(ap + (k + u) * 32); b[u] = *(const bf16x8*)(bp + (k + u) * 32); }
                else { a[u] = (bf16x8){0, 0, 0, 0, 0, 0, 0, 0}; b[u] = a[u]; }
            }
#pragma unroll
            for (int u = 0; u < 4; ++u) acc = __builtin_amdgcn_mfma_f32_16x16x32_bf16(b[u], a[u], acc, 0, 0, 0);
        }
        RED[(kq * 2 + rg) * 64 + lane] = acc;
        __syncthreads();
        if (kq == 0) {
            const int orow = MP + rb * 32 + rg * 16 + fr, ocol = cb * 16 + 4 * fq;
            f32x4 v;
            if (MODE == 2) {
                v = (f32x4){0.f, 0.f, 0.f, 0.f};
#pragma unroll
                for (int q = 0; q < 4; ++q) { const u32x2 gq = *(const u32x2*)(GATE + (size_t)orow * 4096 + q * 1024 + ocol); v += RED[(q * 2 + rg) * 64 + lane] * pg8::bflo(gq.x, gq.y); }
            } else {
                v = (RED[(0 * 2 + rg) * 64 + lane] + RED[(1 * 2 + rg) * 64 + lane]) + (RED[(2 * 2 + rg) * 64 + lane] + RED[(3 * 2 + rg) * 64 + lane]);
            }
            if (MODE == 0) { const u32x2 xr = *(const u32x2*)(O + (size_t)orow * 1024 + ocol); *(f32x4*)(X + (size_t)(orow - MP) * 1024 + ocol) = pg8::bflo(xr.x, xr.y) * alpha + v * sc; }
            else { *(u32x2*)(O + (size_t)orow * 1024 + ocol) = (u32x2){cvt_pk_bf16(v[0] * sc, v[1] * sc), cvt_pk_bf16(v[2] * sc, v[3] * sc)}; }
        }
        __syncthreads();
    }
}

#define XB_TMO      128
#define XB_XCNT(j)  (256  + 64 * (j))
#define XB_XSUB(j)  (1280 + 64 * (j))
#define XB_XGEN(j)  (2304 + 64 * (j))
#define XB_TOP      3328
#define XB_TOPGEN   3392
#define XCD_BAR_WORDS 3456
#define XB_SPIN_CAP (1u << 18)

__device__ __forceinline__ unsigned xb_ld(unsigned* p)              { return __hip_atomic_load(p, __ATOMIC_RELAXED, __HIP_MEMORY_SCOPE_AGENT); }
__device__ __forceinline__ unsigned xb_add(unsigned* p, unsigned v) { return __hip_atomic_fetch_add(p, v, __ATOMIC_RELAXED, __HIP_MEMORY_SCOPE_AGENT); }
__device__ __forceinline__ unsigned xb_xcc_id() { return (unsigned)__builtin_amdgcn_s_getreg((3 << 11) | 20) & 0xFu; }
#define XB_SPIN(cond, bar) do { unsigned _sp = 0; while (cond) { __builtin_amdgcn_s_sleep(1); \
    if ((++_sp & 255u) == 0u) { if (xb_ld(&(bar)[XB_TMO])) break; if (_sp > XB_SPIN_CAP) { atomicAdd(&(bar)[XB_TMO], 1u); break; } } } } while (0)

struct XcdBarrier {
    unsigned* bar; unsigned x;
    volatile LAS unsigned* st;
};

__device__ __forceinline__ XcdBarrier xcd_barrier_post(unsigned* bar, volatile LAS unsigned* st) {
    XcdBarrier b; b.bar = bar; b.x = xb_xcc_id(); b.st = st;
    if (threadIdx.x == 0) (void)xb_add(&bar[XB_XCNT(b.x)], 1u);
    return b;
}
__device__ __forceinline__ void xcd_barrier_complete(unsigned* bar, unsigned x, unsigned& nloc, unsigned& nx) {
    const unsigned G = gridDim.x * gridDim.y * gridDim.z;
    unsigned sum, cnt, mine, sp = 0u;
    for (;;) {
        sum = 0u; cnt = 0u; mine = 0u;
#pragma unroll
        for (unsigned j = 0; j < 16; ++j) { const unsigned c = xb_ld(&bar[XB_XCNT(j)]); sum += c; cnt += (c > 0u) ? 1u : 0u; mine = (j == x) ? c : mine; }
        if (sum == G) break;
        __builtin_amdgcn_s_sleep(1);
        if ((++sp & 255u) == 0u) { if (xb_ld(&bar[XB_TMO])) break; if (sp > XB_SPIN_CAP) { atomicAdd(&bar[XB_TMO], 1u); break; } }
    }
    nloc = mine > 0u ? mine : 1u; nx = cnt > 0u ? cnt : 1u;
}

__device__ __forceinline__ void xcd_barrier(const XcdBarrier& b) {
    asm volatile("s_waitcnt vmcnt(0)" ::: "memory");
    __syncthreads();
    if (threadIdx.x == 0) {
        unsigned* bar = b.bar;
        __builtin_amdgcn_s_waitcnt(0);
        unsigned nloc = b.st[0], nx = b.st[1];
        if (nloc == 0u) { xcd_barrier_complete(bar, b.x, nloc, nx); b.st[0] = nloc; b.st[1] = nx; }
        const unsigned old = xb_add(&bar[XB_XSUB(b.x)], 1u);
        const unsigned gen = old / nloc;
        if (old + 1u == (gen + 1u) * nloc) {
            __builtin_amdgcn_fence(__ATOMIC_RELEASE, "agent");
            asm volatile("s_waitcnt vmcnt(0)" ::: "memory");
            const unsigned og = xb_add(&bar[XB_TOP], 1u);
            const unsigned tg = og / nx;
            if (og + 1u == (tg + 1u) * nx) xb_add(&bar[XB_TOPGEN], 1u);
            else XB_SPIN(xb_ld(&bar[XB_TOPGEN]) == tg, bar);
            __builtin_amdgcn_fence(__ATOMIC_ACQUIRE, "agent");
            xb_add(&bar[XB_XGEN(b.x)], 1u);
            asm volatile("s_waitcnt vmcnt(0)" ::: "memory");
        } else {
            XB_SPIN(xb_ld(&bar[XB_XGEN(b.x)]) == gen, bar);
            __builtin_amdgcn_fence(__ATOMIC_ACQUIRE, "agent");
            asm volatile("s_waitcnt vmcnt(0)" ::: "memory");
        }
    }
    __syncthreads();
}


constexpr int N_PHASES = 3 + 32;

template <int PH>
__device__ __forceinline__ void run_phase(const Args& args, unsigned char* lds, const int wv_) {
    constexpr int ph = PH, l = PH >= 3 ? (PH - 3) >> 4 : 0, s = PH >= 3 ? (PH - 3) & 15 : -1;
    PG8_LAS unsigned char* L = (PG8_LAS unsigned char*)lds;
        int z0 = 0; asm volatile("s_mov_b32 %0, 0" : "=s"(z0));
        unsigned char* ws = args.ws + z0;
        int tid_ = MK_TID; asm volatile("" : "+v"(tid_)); const int tid = tid_, lane = tid & 63, wave = __builtin_amdgcn_readfirstlane(tid >> 6);
        const View vw{&args, z0, ws, args.out + z0};
        const int G = (int)gridDim.x + z0, cid = (int)blockIdx.x + z0;
        bf16_t* XB = (bf16_t*)(ws + WS_XB); float* XF = (float*)(ws + WS_XF);
        bf16_t* GATE = (bf16_t*)(ws + WS_R1); bf16_t* HB = (bf16_t*)(ws + WS_R1);
        bf16_t* PB = (bf16_t*)(ws + WS_R2); bf16_t* QB = (bf16_t*)(ws + WS_R2); bf16_t* PRB = QB + (size_t)M_PAD * D; bf16_t* OB = PRB + (size_t)M_PAD * D;
        bf16_t* MIX = (bf16_t*)(ws + WS_MIX); bf16_t* MRG = (bf16_t*)(ws + WS_MRG); bf16_t* MEMB = (bf16_t*)(ws + WS_MEMB);

        const unsigned char* WL = ws + WS_W + (size_t)l * W_LAYER;
        if constexpr (ph == 0) {
#ifndef SK0
            prologue(vw, lds, G, cid, wv_);
#endif
        }
        if constexpr (s == 8 || s == 10) {
            constexpr int nj = 1;
            for (int j = 0; j < nj; ++j) {
                pg8::Gemm g; pg8::Sched S; pg8::EpiStore E;
                if constexpr (s == 8) {
                    g = pg8::Gemm{XB, (const bf16_t*)(WL + WO_WQ), 1024, 1024, 1024};
                    S.init(MP / 256, 4, 1, G, cid); S.a_pm = (size_t)256 * 1024 * 2; S.b_pn = (size_t)256 * 1024 * 2;
                    E = pg8::EpiStore{QB, 1024, 0.0625f};
                    skinny_gemm<1>(lds, XB, 1024, (const bf16_t*)(WL + WO_WQ), 1024, 256, nullptr, QB, nullptr, 0.f, 0.0625f, G, cid, wv_);
                } else {
                    g = pg8::Gemm{PRB, (const bf16_t*)(ws + WS_VT) + (size_t)l * 1024 * 2048, 1024, 2048, 256};
                    S.init(MP / 256, 4, 1, G, cid); S.a_pm = (size_t)256 * 1024 * 2; S.a_pn = 256 * 2; S.b_pn = (size_t)256 * 2048 * 2; S.b_b = 256 * 2;
                    E = pg8::EpiStore{OB, 1024, 1.0f};
                }
#ifndef SK2
                pg8::gemm_phase<pg8::EpiStore>(L, g, S, E, wv_);
#endif
            }
            if constexpr (s == 10) {
                __syncthreads();
                for (int un = 256 + cid; un < 512; un += G) samp_attn_unit(vw, l, un, lds, QB, OB, wv_);
            }
        } else if constexpr (s == 0 || s == 13) {
            pg8::Gemm g{XB, (const bf16_t*)(WL + (s == 0 ? WO_UP1 : WO_UP2)), 1024, 1024, 1024};
            pg8::Sched S; S.init(M_PAD / 256, 22, 1, G, cid); S.a_pm = (size_t)256 * 1024 * 2; S.b_pn = (size_t)256 * 1024 * 2;
            pg8::EpiUp E{HB, FF};
#ifndef SK3
            pg8::gemm_phase<pg8::EpiUp>(L, g, S, E, wv_);
#endif
            if constexpr (s == 0) {
                constexpr int c0 = (M_PAD / 256) * 22 % 256;
                {
                    pg8::Gemm g2{MEMB, (const bf16_t*)(WL + WO_KV), 1024, 1024, 1024};
                    pg8::Sched S2; S2.init(8, 8, 1, G, (cid + G - c0 % G) % G); S2.a_pm = (size_t)256 * 1024 * 2; S2.b_pn = (size_t)256 * 1024 * 2;
                    pg8::EpiKV E2{vw.out + OUT_MK + (size_t)l * 2048 * 1024, vw.out + OUT_MV + (size_t)l * 2048 * 1024, (bf16_t*)(ws + WS_KB) + (size_t)l * 2048 * 1024};
                    pg8::gemm_phase<pg8::EpiKV>(L, g2, S2, E2, wv_);
                }
                {
                    pg8::Gemm g3{(const bf16_t*)(WL + WO_KV) + (size_t)1024 * 1024, MEMB, 1024, 1024, 1024};
                    pg8::Sched S3; S3.init(4, 8, 1, G, (cid + G - (c0 + 64) % G) % G); S3.a_pm = (size_t)256 * 1024 * 2; S3.b_pn = (size_t)256 * 1024 * 2;
                    pg8::EpiStore E3{(bf16_t*)(ws + WS_VT) + (size_t)l * 1024 * 2048, 2048, 1.0f};
                    pg8::gemm_phase<pg8::EpiStore>(L, g3, S3, E3, wv_);
                }
            }
        } else if constexpr (s == 1 || s == 14 || s == 6 || s == 11) {
            pg8::Gemm g; float sc;
            if constexpr (s == 1 || s == 14) { g = pg8::Gemm{HB, (const bf16_t*)(WL + (s == 1 ? WO_DN1 : WO_DN2)), FF, FF, FF}; sc = 0.5f; }
            else if constexpr (s == 6) { g = pg8::Gemm{MRG, (const bf16_t*)(WL + WO_WO), 1024, 1024, 1024}; sc = 1.0f; }
            else { g = pg8::Gemm{OB, (const bf16_t*)(WL + WO_AO), 1024, 1024, 1024}; sc = 1.0f; }
            pg8::Sched S; S.init(MP / 256, 4, 1, G, cid); S.a_pm = (size_t)256 * g.lda * 2; S.b_pn = (size_t)256 * g.ldb * 2;
            constexpr int which = s == 1 ? 0 : s == 6 ? 1 : s == 11 ? 2 : 3;
            constexpr int gi = which == 0 ? I_LN1G : which == 1 ? I_LN2G : which == 2 ? I_LN3G : I_LN4G;
            constexpr size_t bank_off = WS_CTL + 16384 + (size_t)(l * 4 + which) * 16384;
            typedef pg8::EpiResidLN<(which == 0 || which == 3) ? 1 : 0> EpiT;
            EpiT E{XB, vw.in(gi) + l * D, vw.in(gi + 1) + l * D, (which == 3 && l == 1) ? vw.out + OUT_Y : nullptr, ws + bank_off, (long)WS_XBUF - (long)bank_off};
            skinny_gemm<0>(lds, g.A, g.lda, g.Bt, g.ldb, g.K / 4, XF, XB, nullptr, DN_ALPHA, sc, G, cid, wv_);
#ifndef SK4
            pg8::gemm_phase<EpiT>(L, g, S, E, wv_);
#endif
        } else if constexpr (s == 2 || s == 7 || s == 12 || s == 15) {
            constexpr int gi = s == 2 ? I_LN1G : s == 7 ? I_LN2G : s == 12 ? I_LN3G : I_LN4G;
#ifndef SK5
            ln_pass_sample(XF, XB, vw.in(gi) + l * D, vw.in(gi + 1) + l * D, (s == 15 && l == 1) ? vw.out + OUT_Y : nullptr, G, cid, wv_);
#endif
        } else if constexpr (s == 3) {
            pg8::Gemm g{XB, (const bf16_t*)(WL + WO_IN), 1024, 1024, 1024};
            pg8::Sched S; S.init(M_PAD / 256, 32, 1, G, cid); S.a_pm = (size_t)256 * 1024 * 2; S.b_pn = (size_t)256 * 1024 * 2;
            pg8::EpiIn E{PB, GATE, vw.in(I_BGATE) + l * 4096};
#ifndef SK6
            pg8::gemm_phase<pg8::EpiIn>(L, g, S, E, wv_);
#endif
        } else if constexpr (s == 4) {
#ifndef SK7
            for (int un = cid; un < 256; un += G) sgu_unit(vw, l, un, lds, PB, MIX, wv_);
#endif
#ifndef SK8
            if ((MP % (G * 64)) == 0 || true) {
                __syncthreads();
                LAS float* DW = (LAS float*)((LAS unsigned char*)lds + 65536);
                LAS bf16_t* GL = (LAS bf16_t*)lds;
                const float* dwg = vw.in(I_CDW) + (size_t)l * 31 * 512;
                { f32x4 tw[8];
#pragma unroll
                  for (int u = 0; u < 8; ++u) { const int e = tid + u * NT; tw[u] = *(const f32x4*)(dwg + 4 * (e < 31 * 512 / 4 ? e : 0)); }
#pragma unroll
                  for (int u = 0; u < 8; ++u) { const int e = tid + u * NT; if (e < 31 * 512 / 4) ((LAS f32x4*)DW)[e] = tw[u]; } }
                __syncthreads();
                { const int gw = cid * NWAVES + wave; if ((gw & 15) == 5 && (gw >> 4) < NSAMP) mix_row_s(vw, l, gw >> 4, lane, PB, MIX, DW); }
                const int per = MP / G;
                for (int p0 = 0; p0 < per; p0 += 32) {
                    const int T0 = cid * per + p0, tseq = T0 & 2047;
                    __syncthreads();
                    {
                        u32x4 tw[8]; int t3 = tid; asm volatile("" : "+v"(t3));
#pragma unroll
                        for (int u = 0; u < 8; ++u) { const int e = t3 + u * NT, row = e >> 6, c16 = e & 63; tw[u] = (u32x4){0u, 0u, 0u, 0u};
                            if (e < 62 * 64 && tseq - 30 + row >= 0) tw[u] = *(const u32x4*)(PB + (size_t)(T0 - 30 + row) * 3072 + 1536 + c16 * 8); }
#pragma unroll
                        for (int u = 0; u < 8; ++u) { const int e = t3 + u * NT; if (e < 62 * 64) ((LAS u32x4*)GL)[e] = tw[u]; }
                    }
                    __syncthreads();
                    conv4_lds(vw, l, T0 + wave * 4, lane, MIX, DW, GL + (wave * 4) * 512);
                    { int tb = T0 + wave * 4; asm volatile("" : "+s"(tb));
#pragma nounroll
                      for (int i = 0; i < 4; ++i) mix_row_p<false>(vw, l, tb + i, lane, PB, MIX, DW, GL); }
                }
            }
#endif
        } else if constexpr (s == 5) {
            pg8::Gemm g{MIX, (const bf16_t*)(WL + WO_PROJ), 2048, 2048, 512};
            pg8::Sched S; S.init(MP / 256, 4, 4, G, cid); S.a_pm = (size_t)256 * 2048 * 2; S.b_pn = (size_t)256 * 2048 * 2; S.a_sub = 512 * 2; S.b_sub = 512 * 2;
            pg8::EpiBranch E{GATE, MRG};
            skinny_gemm<2>(lds, MIX, 2048, (const bf16_t*)(WL + WO_PROJ), 2048, 512, nullptr, MRG, GATE, 0.f, 1.0f, G, cid, wv_);
#ifndef SK9
            pg8::gemm_phase<pg8::EpiBranch>(L, g, S, E, wv_);
#endif
        } else if constexpr (s == 9) {
            pg8::Gemm g{QB, (const bf16_t*)(ws + WS_KB) + (size_t)l * 2048 * 1024, 1024, 1024, 256};
            pg8::Sched S; S.init(MP / 256, 4, 1, G, cid); S.a_pm = (size_t)256 * 1024 * 2; S.a_pn = 256 * 2; S.b_pn = 256 * 2; S.b_b = (size_t)256 * 1024 * 2;
            pg8::EpiSoftmax E{PRB};
#ifndef SK10
            pg8::gemm_phase<pg8::EpiSoftmax>(L, g, S, E, wv_);
#endif
            asm volatile("s_waitcnt vmcnt(0)" ::: "memory");
            __syncthreads();
            {
                pg8::Gemm g2{PRB, (const bf16_t*)(ws + WS_VT) + (size_t)l * 1024 * 2048, 1024, 2048, 256};
                pg8::Sched S2; S2.init(MP / 256, 4, 1, G, cid); S2.a_pm = (size_t)256 * 1024 * 2; S2.a_pn = 256 * 2; S2.b_pn = (size_t)256 * 2048 * 2; S2.b_b = 256 * 2;
                pg8::EpiStore E2{OB, 1024, 1.0f};
                pg8::gemm_phase<pg8::EpiStore>(L, g2, S2, E2, wv_);
            }
            __syncthreads();
#ifndef SK11
            for (int un = cid; un < 512; un += G) samp_attn_unit(vw, l, un, lds, QB, OB, wv_);
#endif
        }
}

__global__ void __launch_bounds__(NT, 2) mega_fwd(Args args) {
    extern __shared__ __attribute__((aligned(16))) unsigned char lds[];
    cg::grid_group grid = cg::this_grid();
    const int lo = args.ph_lo, hi = args.ph_hi;
    const int wv_ = __builtin_amdgcn_readfirstlane((int)threadIdx.x >> 6);
    volatile LAS unsigned* MISC = (volatile LAS unsigned*)((LAS unsigned char*)lds + LDS_BYTES - 64);
    if (threadIdx.x < 16) MISC[threadIdx.x] = 0u;
    __syncthreads();
    const XcdBarrier bar = xcd_barrier_post((unsigned*)(args.ws + WS_CTL), MISC);
#define RUN(k) if (lo <= (k) && (k) < hi) { run_phase<(k)>(args, lds, wv_); if ((k) + 1 < hi) { if ((k) == 0) grid.sync(); else xcd_barrier(bar); } }
    RUN(0)
    RUN(3) RUN(4) RUN(5) RUN(6) RUN(7) RUN(8) RUN(9) RUN(10) RUN(11) RUN(12) RUN(14) RUN(15) RUN(16) RUN(17) RUN(18)
    RUN(19) RUN(20) RUN(21) RUN(22) RUN(23) RUN(24) RUN(25) RUN(26) RUN(27) RUN(28) RUN(30) RUN(31) RUN(32) RUN(33) RUN(34)
#undef RUN
}

extern "C" void kernel_launch(void* const* d_in, const int* in_sizes, int n_in, void* d_out, int out_size, void* d_ws, size_t ws_size, hipStream_t stream) {
    static int grid = 0;
    if (grid == 0) {
        if (n_in != N_IN || (size_t)out_size != OUT_END || ws_size < WS_END) { fprintf(stderr, "kernel_launch: unexpected shapes: n_in %d out %d ws %zu (need %zu)\n", n_in, out_size, ws_size, (size_t)WS_END); grid = -1; return; }
        int dev = 0, cus = 0, per_cu = 0;
        if (hipGetDevice(&dev) != hipSuccess || hipDeviceGetAttribute(&cus, hipDeviceAttributeMultiprocessorCount, dev) != hipSuccess) { grid = -1; return; }
        if (hipFuncSetAttribute((const void*)mega_fwd, hipFuncAttributeMaxDynamicSharedMemorySize, LDS_BYTES) != hipSuccess) { fprintf(stderr, "kernel_launch: hipFuncSetAttribute failed\n"); grid = -1; return; }
        if (hipOccupancyMaxActiveBlocksPerMultiprocessor(&per_cu, (const void*)mega_fwd, NT, LDS_BYTES) != hipSuccess || per_cu < 1) { fprintf(stderr, "kernel_launch: occupancy query says %d\n", per_cu); per_cu = 1; }
        (void)hipGetLastError();
        grid = cus * 1;
    }
    if (grid < 0) return;
    Args a{};
    for (int i = 0; i < N_IN; ++i) a.in[i] = (const float*)d_in[i];
    a.out = (float*)d_out; a.ws = (unsigned char*)d_ws;
#if MK_MULTI
#ifndef MK_LAST
#define MK_LAST N_PHASES
#endif
    for (int p = 0; p < MK_LAST; ++p) {
        a.ph_lo = p; a.ph_hi = p + 1;
        hipLaunchKernelGGL(mega_fwd, dim3(grid), dim3(NT), LDS_BYTES, stream, a);
    }
#else
    a.ph_lo = 0; a.ph_hi = N_PHASES;
    if (hipMemsetAsync((char*)d_ws + WS_CTL, 0, CTL_BYTES, stream) != hipSuccess) { fprintf(stderr, "kernel_launch: memset failed\n"); return; }
    void* kargs[] = {&a};
    hipError_t e = hipLaunchCooperativeKernel((const void*)mega_fwd, dim3(grid), dim3(NT), kargs, LDS_BYTES, stream);
    if (e != hipSuccess) fprintf(stderr, "cooperative launch failed: %s (grid %d)\n", hipGetErrorString(e), grid);
#endif
}
```

```cpp
#include <hip/hip_runtime.h>
#include <hip/hip_cooperative_groups.h>
#include <cstdio>
#include <cstdint>
namespace cg = cooperative_groups;
#define MK_TID (wv_ * 64 + (int)__builtin_amdgcn_mbcnt_hi(~0u, __builtin_amdgcn_mbcnt_lo(~0u, 0u)))

#ifndef MK_MULTI
#define MK_MULTI 0
#endif

namespace pg8 {
#define PG8_LAS __attribute__((address_space(3)))
typedef unsigned short bf16_t;
typedef short bf16x8 __attribute__((ext_vector_type(8)));
typedef float f32x4 __attribute__((ext_vector_type(4)));
typedef float f32x2 __attribute__((ext_vector_type(2)));
typedef unsigned u32x4 __attribute__((ext_vector_type(4)));
typedef unsigned u32x2 __attribute__((ext_vector_type(2)));
constexpr int BM = 256, BK = 64, HALF = 128, HTB = HALF * BK * 2, STAGE_BYTES = 8 * HTB, NXCD = 8, WGM = 8;

__host__ __device__ __forceinline__ int lds_byte(int r, int c) { const int st = (r >> 4) * 2 + (c >> 5), rr = r & 15, cc = c & 31, ob = rr * 64 + cc * 2; return st * 1024 + (ob ^ (((ob >> 9) & 1) << 5)); }
__host__ __device__ __forceinline__ void stage_rc(int b, int& R, int& C) { const int st = b / 1024, sb = b % 1024, swz = sb ^ (((sb >> 9) & 1) << 5); R = (st >> 1) * 16 + swz / 64; C = (st & 1) * 32 + (swz % 64) / 2; }
__host__ __device__ __forceinline__ int perm32(int rho) { const int n = rho >> 4, i = rho & 15; return 8 * (i >> 2) + 4 * n + (i & 3); }

struct Unit { int pm, pn, aux; size_t aoff, boff; };
struct Gemm { const bf16_t* A; const bf16_t* Bt; int lda, ldb, K; };

struct Sched {
    int nM, nN, nsub, nwg, G, c;
    size_t a_pm, a_pn, a_sub, a_b, b_pn, b_sub, b_b;
    __device__ __forceinline__ void init(int nM_, int nN_, int nsub_, int G_, int c_) { nM = nM_; nN = nN_; nsub = nsub_; nwg = nM_ * nN_; G = G_; c = c_; a_pm = a_pn = a_sub = a_b = b_pn = b_sub = b_b = 0; }
    __device__ __forceinline__ bool next(int i, Unit& u) const {
        const int sub = i % nsub; const long L = (long)(i / nsub) * G + c; if (L >= nwg) return false;
        int wgid = (int)L; { const int q = nwg / NXCD, r = nwg % NXCD, xcd = wgid % NXCD, off = wgid / NXCD; wgid = (xcd < r ? xcd * (q + 1) : r * (q + 1) + (xcd - r) * q) + off; }
        const int nig = WGM * nN, gid = wgid / nig, fm = gid * WGM, gsz = (nM - fm) < WGM ? (nM - fm) : WGM;
        u.pm = fm + ((wgid % nig) % gsz); u.pn = (wgid % nig) / gsz; u.aux = sub;
        u.aoff = (size_t)u.pm * a_pm + (size_t)u.pn * a_pn + (size_t)sub * a_sub + (size_t)(u.pm >> 3) * a_b;
        u.boff = (size_t)u.pn * b_pn + (size_t)sub * b_sub + (size_t)(u.pm >> 3) * b_b;
        return true;
    }
};

typedef __bf16 bf16v2 __attribute__((ext_vector_type(2)));
__device__ __forceinline__ unsigned cvt_pk_bf16(float lo, float hi) { const f32x2 v = {lo, hi}; return __builtin_bit_cast(unsigned, __builtin_convertvector(v, bf16v2)); }
__device__ __forceinline__ float sigm(float x) { return __builtin_amdgcn_rcpf(1.f + __expf(-x)); }
__device__ __forceinline__ f32x4 sigm4(f32x4 v) { return (f32x4){sigm(v[0]), sigm(v[1]), sigm(v[2]), sigm(v[3])}; }
__device__ __forceinline__ u32x4 pack2(f32x4 v0, f32x4 v1) { u32x4 w; w.x = cvt_pk_bf16(v0[0], v0[1]); w.y = cvt_pk_bf16(v0[2], v0[3]); w.z = cvt_pk_bf16(v1[0], v1[1]); w.w = cvt_pk_bf16(v1[2], v1[3]); return w; }
__device__ __forceinline__ f32x4 bflo(unsigned a, unsigned b) { return (f32x4){__uint_as_float(a << 16), __uint_as_float(a & 0xffff0000u), __uint_as_float(b << 16), __uint_as_float(b & 0xffff0000u)}; }

typedef f32x4 Acc[2][2][4][2];

struct EpiUp {
    bf16_t* H; int ldh;
    __device__ __forceinline__ bool keep(const Unit&) const { return false; }
    __device__ __forceinline__ void operator()(Acc& acc, const Unit& u, int wr, int wc, int fr, int fq, PG8_LAS unsigned char*) const {
        const int row0 = u.pm * BM + wr * 64 + fr, col = u.pn * 128 + wc * 32 + 8 * fq;
#pragma unroll
        for (int ai = 0; ai < 2; ++ai)
#pragma unroll
            for (int m = 0; m < 4; ++m) {
                const f32x4 a0 = acc[ai][0][m][0], a1 = acc[ai][0][m][1], b0 = acc[ai][1][m][0], b1 = acc[ai][1][m][1];
                const f32x4 h0 = a0 * sigm4(a0) * b0, h1 = a1 * sigm4(a1) * b1;
                *(u32x4*)(H + (size_t)(row0 + ai * HALF + m * 16) * ldh + col) = pack2(h0, h1);
            }
    }
};
template <int HALF_SCALE>
struct EpiResidLN {
    bf16_t* XB; const float* g; const float* b; float* out; unsigned char* ctl;
    long xoff;
    __device__ __forceinline__ bool keep(const Unit&) const { return false; }
    __device__ __forceinline__ void operator()(Acc& acc, const Unit& u, int wr, int wc, int fr, int fq, PG8_LAS unsigned char* lds) const {
        constexpr float alpha = 1.41421356237f, s = HALF_SCALE ? 0.5f : 1.0f;
        unsigned long long* xbuf = (unsigned long long*)(ctl + xoff); unsigned* cnt = (unsigned*)ctl;
        PG8_LAS f32x2* P = (PG8_LAS f32x2*)(lds + STAGE_BYTES);
        PG8_LAS f32x2* S = (PG8_LAS f32x2*)(lds + STAGE_BYTES + 8192);
        const int row0 = u.pm * BM + wr * 64 + fr, col = u.pn * BM + wc * 32 + 8 * fq, wid = wr * 4 + wc, lane = fq * 16 + fr;
#pragma unroll
        for (int ai = 0; ai < 2; ++ai) {
            u32x4 xr[4][2];
#pragma unroll
            for (int m = 0; m < 4; ++m)
#pragma unroll
                for (int bj = 0; bj < 2; ++bj) xr[m][bj] = __builtin_nontemporal_load((const u32x4*)(XB + (size_t)(row0 + ai * HALF + m * 16) * 1024 + col + bj * HALF));
#pragma unroll
            for (int m = 0; m < 4; ++m)
#pragma unroll
                for (int bj = 0; bj < 2; ++bj) { const u32x4 x = xr[m][bj];
                    acc[ai][bj][m][0] = bflo(x.x, x.y) * alpha + acc[ai][bj][m][0] * s; acc[ai][bj][m][1] = bflo(x.z, x.w) * alpha + acc[ai][bj][m][1] * s; }
            asm volatile("" ::: "memory");
        }
#pragma unroll
        for (int ai = 0; ai < 2; ++ai)
#pragma unroll
            for (int m = 0; m < 4; ++m) {
                float sm = 0.f;
#pragma unroll
                for (int bj = 0; bj < 2; ++bj)
#pragma unroll
                    for (int n = 0; n < 2; ++n) { const f32x4 x = acc[ai][bj][m][n]; sm += (x[0] + x[1]) + (x[2] + x[3]); }
                sm += __shfl_xor(sm, 16); sm += __shfl_xor(sm, 32);
                const float mw = sm * (1.0f / 64.0f); float q = 0.f;
#pragma unroll
                for (int bj = 0; bj < 2; ++bj)
#pragma unroll
                    for (int n = 0; n < 2; ++n) { const f32x4 d = acc[ai][bj][m][n] - mw; q += (d[0] * d[0] + d[1] * d[1]) + (d[2] * d[2] + d[3] * d[3]); }
                q += __shfl_xor(q, 16); q += __shfl_xor(q, 32);
                if (fq == 0) P[(ai * HALF + wr * 64 + m * 16 + fr) * 4 + wc] = (f32x2){mw, q};
            }
        asm volatile("s_waitcnt lgkmcnt(0)" ::: "memory"); __builtin_amdgcn_s_barrier(); asm volatile("" ::: "memory");
        const int row = wid * 32 + (lane & 31);
        if (lane < 32) {
            const f32x2 a = P[row * 4 + 0], bb = P[row * 4 + 1], c = P[row * 4 + 2], d = P[row * 4 + 3];
            const float mt = (a.x + bb.x + c.x + d.x) * 0.25f;
            const float da = a.x - mt, db = bb.x - mt, dc = c.x - mt, dd = d.x - mt;
            const float m2 = (a.y + bb.y) + (c.y + d.y) + 64.0f * ((da * da + db * db) + (dc * dc + dd * dd));
            unsigned long long* slot = xbuf + ((size_t)(u.pm * BM + row) * 4 + u.pn);
            __hip_atomic_store(slot, ((unsigned long long)__float_as_uint(m2) << 32) | __float_as_uint(mt), __ATOMIC_RELAXED, __HIP_MEMORY_SCOPE_AGENT);
        }
        asm volatile("s_waitcnt vmcnt(0)" ::: "memory");
        if (lane == 0) __hip_atomic_fetch_add(cnt + 64 * u.pm, 1u, __ATOMIC_RELAXED, __HIP_MEMORY_SCOPE_AGENT);
        if (wid == 0) {
            unsigned sp = 0;
            while ((unsigned)__builtin_amdgcn_readfirstlane(__hip_atomic_load(cnt + 64 * u.pm, __ATOMIC_RELAXED, __HIP_MEMORY_SCOPE_AGENT)) < 32u) { __builtin_amdgcn_s_sleep(2); if (++sp > (1u << 22)) break; }
            __builtin_amdgcn_fence(__ATOMIC_ACQUIRE, "agent");
        }
        asm volatile("s_waitcnt vmcnt(0) lgkmcnt(0)" ::: "memory"); __builtin_amdgcn_s_barrier(); asm volatile("" ::: "memory");
        if (lane < 32) {
            const unsigned long long* slot = xbuf + (size_t)(u.pm * BM + row) * 4; float mt[4], m2[4]; float ms = 0.f;
#pragma unroll
            for (int t = 0; t < 4; ++t) { const unsigned long long w = __hip_atomic_load(slot + t, __ATOMIC_RELAXED, __HIP_MEMORY_SCOPE_AGENT); mt[t] = __uint_as_float((unsigned)w); m2[t] = __uint_as_float((unsigned)(w >> 32)); ms += mt[t]; }
            const float mean = ms * 0.25f; float q = 0.f;
#pragma unroll
            for (int t = 0; t < 4; ++t) { const float dm = mt[t] - mean; q += m2[t] + 256.0f * dm * dm; }
            S[row] = (f32x2){mean, 1.0f / sqrtf(q * (1.0f / 1024.0f) + 1e-5f)};
        }
        asm volatile("s_waitcnt lgkmcnt(0)" ::: "memory"); __builtin_amdgcn_s_barrier(); asm volatile("" ::: "memory");
#pragma unroll
        for (int bj = 0; bj < 2; ++bj) {
            const f32x4 g0 = *(const f32x4*)(g + col + bj * HALF), g1 = *(const f32x4*)(g + col + bj * HALF + 4), b0 = *(const f32x4*)(b + col + bj * HALF), b1 = *(const f32x4*)(b + col + bj * HALF + 4);
#pragma unroll
            for (int ai = 0; ai < 2; ++ai)
#pragma unroll
                for (int m = 0; m < 4; ++m) {
                    const f32x2 sr = S[ai * HALF + wr * 64 + m * 16 + fr];
                    const size_t o = (size_t)(row0 + ai * HALF + m * 16) * 1024 + col + bj * HALF;
                    const f32x4 y0 = (acc[ai][bj][m][0] - sr.x) * sr.y * g0 + b0, y1 = (acc[ai][bj][m][1] - sr.x) * sr.y * g1 + b1;
                    *(u32x4*)(XB + o) = pack2(y0, y1);
                    if (out) { __builtin_nontemporal_store(y0, (f32x4*)(out + o)); __builtin_nontemporal_store(y1, (f32x4*)(out + o + 4)); }
                    asm volatile("" ::: "memory");
                }
        }
    }
};
struct EpiStore {
    bf16_t* O; int ldo; float s;
    __device__ __forceinline__ bool keep(const Unit&) const { return false; }
    __device__ __forceinline__ void operator()(Acc& acc, const Unit& u, int wr, int wc, int fr, int fq, PG8_LAS unsigned char*) const {
        const int row0 = u.pm * BM + wr * 64 + fr, col = u.pn * BM + wc * 32 + 8 * fq;
#pragma unroll
        for (int ai = 0; ai < 2; ++ai)
#pragma unroll
            for (int m = 0; m < 4; ++m) {
                bf16_t* p = O + (size_t)(row0 + ai * HALF + m * 16) * ldo + col;
#pragma unroll
                for (int bj = 0; bj < 2; ++bj) *(u32x4*)(p + bj * HALF) = pack2(acc[ai][bj][m][0] * s, acc[ai][bj][m][1] * s);
            }
    }
};
struct EpiKV {
    float* mk; float* mv; bf16_t* KB;
    __device__ __forceinline__ bool keep(const Unit&) const { return false; }
    __device__ __forceinline__ void operator()(Acc& acc, const Unit& u, int wr, int wc, int fr, int fq, PG8_LAS unsigned char*) const {
        const int row0 = u.pm * BM + wr * 64 + fr; const bool isk = u.pn < 4; const int col = (u.pn & 3) * BM + wc * 32 + 8 * fq;
        float* dst = isk ? mk : mv;
#pragma unroll
        for (int ai = 0; ai < 2; ++ai)
#pragma unroll
            for (int m = 0; m < 4; ++m) {
                const size_t o = (size_t)(row0 + ai * HALF + m * 16) * 1024 + col;
#pragma unroll
                for (int bj = 0; bj < 2; ++bj) {
                    __builtin_nontemporal_store(acc[ai][bj][m][0], (f32x4*)(dst + o + bj * HALF)); __builtin_nontemporal_store(acc[ai][bj][m][1], (f32x4*)(dst + o + bj * HALF + 4));
                    if (isk) *(u32x4*)(KB + o + bj * HALF) = pack2(acc[ai][bj][m][0], acc[ai][bj][m][1]);
                }
            }
    }
};
struct EpiIn {
    bf16_t* P; bf16_t* GATE; const float* bg;
    __device__ __forceinline__ bool keep(const Unit&) const { return false; }
    __device__ __forceinline__ void operator()(Acc& acc, const Unit& u, int wr, int wc, int fr, int fq, PG8_LAS unsigned char*) const {
        const int row0 = u.pm * BM + wr * 64 + fr, cw = wc * 32 + 8 * fq, pn = u.pn;
        if (pn >= 16) {
            const int col = (pn - 16) * BM + cw;
            f32x4 bv[2][2];
#pragma unroll
            for (int bj = 0; bj < 2; ++bj) { bv[bj][0] = *(const f32x4*)(bg + col + bj * HALF); bv[bj][1] = *(const f32x4*)(bg + col + bj * HALF + 4); }
#pragma unroll
            for (int ai = 0; ai < 2; ++ai)
#pragma unroll
                for (int m = 0; m < 4; ++m) {
                    bf16_t* p = GATE + (size_t)(row0 + ai * HALF + m * 16) * 4096 + col;
#pragma unroll
                    for (int bj = 0; bj < 2; ++bj) *(u32x4*)(p + bj * HALF) = pack2(sigm4(acc[ai][bj][m][0] + bv[bj][0]), sigm4(acc[ai][bj][m][1] + bv[bj][1]));
                }
        } else if ((pn >= 6 && pn < 10) || pn >= 12) {
            const bool glu = pn < 10; const int col = (glu ? 1536 + (pn - 6) * 128 : 2560 + (pn - 12) * 128) + cw;
#pragma unroll
            for (int ai = 0; ai < 2; ++ai)
#pragma unroll
                for (int m = 0; m < 4; ++m) {
                    f32x4 b0 = acc[ai][1][m][0], b1 = acc[ai][1][m][1];
                    if (glu) { b0 = sigm4(b0); b1 = sigm4(b1); }
                    *(u32x4*)(P + (size_t)(row0 + ai * HALF + m * 16) * 3072 + col) = pack2(acc[ai][0][m][0] * b0, acc[ai][0][m][1] * b1);
                }
        } else {
            const int col = (pn < 6 ? pn * BM : 2048 + (pn - 10) * BM) + cw;
#pragma unroll
            for (int ai = 0; ai < 2; ++ai)
#pragma unroll
                for (int m = 0; m < 4; ++m) {
                    bf16_t* p = P + (size_t)(row0 + ai * HALF + m * 16) * 3072 + col;
#pragma unroll
                    for (int bj = 0; bj < 2; ++bj) *(u32x4*)(p + bj * HALF) = pack2(acc[ai][bj][m][0], acc[ai][bj][m][1]);
                }
        }
    }
};
struct EpiBranch {
    const bf16_t* GATE; bf16_t* O;
    __device__ __forceinline__ bool keep(const Unit& u) const { return u.aux < 3; }
    __device__ __forceinline__ void operator()(Acc& acc, const Unit& u, int wr, int wc, int fr, int fq, PG8_LAS unsigned char*) const {
        const int row0 = u.pm * BM + wr * 64 + fr, col = u.pn * BM + wc * 32 + 8 * fq, kb = u.aux;
#pragma unroll
        for (int ai = 0; ai < 2; ++ai)
#pragma unroll
            for (int m = 0; m < 4; ++m) {
                const size_t r = (size_t)(row0 + ai * HALF + m * 16);
                const bf16_t* gp = GATE + r * 4096 + kb * 1024 + col;
#pragma unroll
                for (int bj = 0; bj < 2; ++bj) {
                    const u32x4 g = __builtin_nontemporal_load((const u32x4*)(gp + bj * HALF));
                    f32x4 g0 = bflo(g.x, g.y), g1 = bflo(g.z, g.w);
                    if (kb < 3) {
                        const u32x4 h = __builtin_nontemporal_load((const u32x4*)(gp + 1024 + bj * HALF));
                        const f32x4 h0 = bflo(h.x, h.y), h1 = bflo(h.z, h.w);
#pragma unroll
                        for (int j = 0; j < 4; ++j) { g0[j] = g0[j] * __builtin_amdgcn_rcpf(fmaxf(h0[j], 1e-30f)); g1[j] = g1[j] * __builtin_amdgcn_rcpf(fmaxf(h1[j], 1e-30f)); }
                        acc[ai][bj][m][0] *= g0; acc[ai][bj][m][1] *= g1;
                    } else {
                        *(u32x4*)(O + r * 1024 + col + bj * HALF) = pack2(acc[ai][bj][m][0] * g0, acc[ai][bj][m][1] * g1);
                    }
                }
            }
    }
};
struct EpiSoftmax {
    bf16_t* PR;
    __device__ __forceinline__ bool keep(const Unit&) const { return false; }
    __device__ __forceinline__ void operator()(Acc& acc, const Unit& u, int wr, int wc, int fr, int fq, PG8_LAS unsigned char* lds) const {
        PG8_LAS f32x2* X = (PG8_LAS f32x2*)(lds + STAGE_BYTES);
        const int row0 = u.pm * BM + wr * 64 + fr, col = u.pn * BM + wc * 32 + 8 * fq;
        float mxs[2][4];
#pragma unroll
        for (int ai = 0; ai < 2; ++ai)
#pragma unroll
            for (int m = 0; m < 4; ++m) {
                float mx = -3.0e38f;
#pragma unroll
                for (int bj = 0; bj < 2; ++bj)
#pragma unroll
                    for (int n = 0; n < 2; ++n) { const f32x4 v = acc[ai][bj][m][n]; mx = fmaxf(mx, fmaxf(fmaxf(v[0], v[1]), fmaxf(v[2], v[3]))); }
                mx = fmaxf(mx, __shfl_xor(mx, 16)); mx = fmaxf(mx, __shfl_xor(mx, 32));
                float sm = 0.f;
#pragma unroll
                for (int bj = 0; bj < 2; ++bj)
#pragma unroll
                    for (int n = 0; n < 2; ++n) { f32x4 v = acc[ai][bj][m][n];
#pragma unroll
                        for (int j = 0; j < 4; ++j) v[j] = __expf(v[j] - mx);
                        acc[ai][bj][m][n] = v; sm += (v[0] + v[1]) + (v[2] + v[3]); }
                sm += __shfl_xor(sm, 16); sm += __shfl_xor(sm, 32);
                mxs[ai][m] = mx;
                if (fq == 0) X[(ai * HALF + wr * 64 + m * 16 + fr) * 4 + wc] = (f32x2){mx, sm};
                asm volatile("" ::: "memory");
            }
        asm volatile("s_waitcnt lgkmcnt(0)" ::: "memory"); __builtin_amdgcn_s_barrier(); asm volatile("" ::: "memory");
#pragma unroll
        for (int ai = 0; ai < 2; ++ai)
#pragma unroll
            for (int m = 0; m < 4; ++m) {
                const int rl = ai * HALF + wr * 64 + m * 16 + fr;
                const f32x2 p0 = X[rl * 4 + 0], p1 = X[rl * 4 + 1], p2 = X[rl * 4 + 2], p3 = X[rl * 4 + 3];
                const float M = fmaxf(fmaxf(p0.x, p1.x), fmaxf(p2.x, p3.x));
                const float L = (p0.y * __expf(p0.x - M) + p1.y * __expf(p1.x - M)) + (p2.y * __expf(p2.x - M) + p3.y * __expf(p3.x - M));
                const float f = __expf(mxs[ai][m] - M) * __builtin_amdgcn_rcpf(L);
                bf16_t* p = PR + (size_t)(row0 + ai * HALF + m * 16) * 1024 + col;
#pragma unroll
                for (int bj = 0; bj < 2; ++bj) *(u32x4*)(p + bj * HALF) = pack2(acc[ai][bj][m][0] * f, acc[ai][bj][m][1] * f);
                asm volatile("" ::: "memory");
            }
        asm volatile("s_waitcnt lgkmcnt(0)" ::: "memory"); __builtin_amdgcn_s_barrier(); asm volatile("" ::: "memory");
    }
};

template <class Epi>
__device__ __forceinline__ void gemm_phase(PG8_LAS unsigned char* lds, const Gemm g, const Sched& S, const Epi& E, const int wv_) {
    int tid_ = MK_TID; asm volatile("" : "+v"(tid_)); const int tid = tid_, wid = __builtin_amdgcn_readfirstlane(tid >> 6), lane = tid & 63, wr = wid >> 2, wc = wid & 3, fr = lane & 15, fq = lane >> 4;
    const int nt = g.K / BK;
    unsigned voffA[2], voffB[2];
#pragma unroll
    for (int i = 0; i < 2; ++i) { int R, C; stage_rc(tid * 16 + i * 8192, R, C); const int Rb = (R & ~31) + perm32(R & 31);
        voffA[i] = (unsigned)(R * g.lda + C) * 2u; voffB[i] = (unsigned)(Rb * g.ldb + C) * 2u; }
    const size_t kstep = (size_t)(BK * 2);
    const size_t hstepA = (size_t)HALF * g.lda * 2, hstepB = (size_t)HALF * g.ldb * 2;
    const unsigned ldsw = (unsigned)wid * 1024u;
    const int aoff = lds_byte(wr * 64 + fr, fq * 8), boff = lds_byte(wc * 32 + fr, fq * 8);
#define PG8_SA(b, h) (((b) * 2 + (h)) * HTB)
#define PG8_SB(b, h) ((4 + (b) * 2 + (h)) * HTB)
#define PG8_STAGE(bufoff, gbase, voff) do { _Pragma("unroll") for (int _i = 0; _i < 2; ++_i) \
        __builtin_amdgcn_global_load_lds((const unsigned*)((const char*)(gbase) + (voff)[_i]), (PG8_LAS unsigned*)(lds + (bufoff) + ldsw + _i * 8192), 16, 0, 0); } while (0)
#define PG8_LDA(dst, b, h) do { _Pragma("unroll") for (int m = 0; m < 4; ++m) _Pragma("unroll") for (int k = 0; k < 2; ++k) dst[m][k] = *(const PG8_LAS bf16x8*)(lds + PG8_SA(b, h) + aoff + m * 2048 + k * 1024); } while (0)
#define PG8_LDB(dst, b, h) do { _Pragma("unroll") for (int n = 0; n < 2; ++n) _Pragma("unroll") for (int k = 0; k < 2; ++k) dst[n][k] = *(const PG8_LAS bf16x8*)(lds + PG8_SB(b, h) + boff + n * 2048 + k * 1024); } while (0)
#define PG8_MMA(ai, bj, At, Bt) do { __builtin_amdgcn_s_setprio(1); _Pragma("unroll") for (int m = 0; m < 4; ++m) _Pragma("unroll") for (int n = 0; n < 2; ++n) _Pragma("unroll") for (int k = 0; k < 2; ++k) \
        acc[ai][bj][m][n] = __builtin_amdgcn_mfma_f32_16x16x32_bf16(Bt[n][k], At[m][k], acc[ai][bj][m][n], 0, 0, 0); __builtin_amdgcn_s_setprio(0); } while (0)
#define PG8_WAIT_V(n) asm volatile("s_waitcnt vmcnt(" #n ")" ::: "memory")
#define PG8_WAIT_L(n) asm volatile("s_waitcnt lgkmcnt(" #n ")" ::: "memory")
#define PG8_BAR __builtin_amdgcn_s_barrier()
#define PG8_SCHED __builtin_amdgcn_sched_barrier(0)
#define PG8_ZERO do { _Pragma("unroll") for (int a = 0; a < 2; ++a) _Pragma("unroll") for (int b = 0; b < 2; ++b) _Pragma("unroll") for (int m = 0; m < 4; ++m) _Pragma("unroll") for (int n = 0; n < 2; ++n) acc[a][b][m][n] = (f32x4){0.f, 0.f, 0.f, 0.f}; } while (0)
    Unit cur, nxt; int ui = 0;
    if (!S.next(0, cur)) return;
    Acc acc;
    PG8_ZERO;
    bf16x8 At[4][2], B0[2][2], B1[2][2];
    const char* cA = (const char*)g.A + cur.aoff; const char* cB = (const char*)g.Bt + cur.boff;
    PG8_STAGE(PG8_SB(0, 0), cB, voffB); PG8_STAGE(PG8_SB(0, 1), cB + hstepB, voffB); PG8_STAGE(PG8_SA(0, 0), cA, voffA); PG8_STAGE(PG8_SA(0, 1), cA + hstepA, voffA);
    if (wr == 1) PG8_BAR;
    PG8_WAIT_V(2); PG8_BAR;
    PG8_STAGE(PG8_SB(1, 0), cB + kstep, voffB); PG8_STAGE(PG8_SA(1, 0), cA + kstep, voffA); PG8_STAGE(PG8_SB(1, 1), cB + hstepB + kstep, voffB);
    PG8_WAIT_V(6); PG8_BAR;
    for (;;) {
        const bool has_next = S.next(ui + 1, nxt);
        const char* nA = has_next ? (const char*)g.A + nxt.aoff : cA; const char* nB = has_next ? (const char*)g.Bt + nxt.boff : cB;
        for (int t = 0; t < nt; t += 2) {
            const bool last = (t == nt - 2);
            const char* a1 = cA + (size_t)(t + 1) * kstep;
            const char* a2 = last ? nA : cA + (size_t)(t + 2) * kstep; const char* b2 = last ? nB : cB + (size_t)(t + 2) * kstep;
            const char* a3 = a2 + kstep; const char* b3 = b2 + kstep;
            PG8_LDB(B0, 0, 0); PG8_LDB(B1, 0, 1); PG8_SCHED; PG8_LDA(At, 0, 0); PG8_STAGE(PG8_SA(1, 1), a1 + hstepA, voffA);
            PG8_WAIT_V(8); PG8_WAIT_L(0); PG8_BAR; PG8_MMA(0, 0, At, B0); PG8_MMA(0, 1, At, B1); PG8_BAR; PG8_SCHED;
            PG8_LDA(At, 0, 1); PG8_STAGE(PG8_SB(0, 0), b2, voffB); PG8_STAGE(PG8_SB(0, 1), b2 + hstepB, voffB); PG8_STAGE(PG8_SA(0, 0), a2, voffA);
            PG8_WAIT_V(8); PG8_WAIT_L(0); PG8_BAR; PG8_MMA(1, 0, At, B0); PG8_MMA(1, 1, At, B1); PG8_BAR; PG8_SCHED;
            PG8_LDB(B0, 1, 0); PG8_LDB(B1, 1, 1); PG8_SCHED; PG8_LDA(At, 1, 0); PG8_STAGE(PG8_SA(0, 1), a2 + hstepA, voffA);
            PG8_WAIT_V(8); PG8_WAIT_L(0); PG8_BAR; PG8_MMA(0, 0, At, B0); PG8_MMA(0, 1, At, B1); PG8_BAR; PG8_SCHED;
            PG8_LDA(At, 1, 1); PG8_STAGE(PG8_SB(1, 0), b3, voffB); PG8_STAGE(PG8_SB(1, 1), b3 + hstepB, voffB); PG8_STAGE(PG8_SA(1, 0), a3, voffA);
            PG8_WAIT_V(8); PG8_WAIT_L(0); PG8_BAR; PG8_MMA(1, 0, At, B0); PG8_MMA(1, 1, At, B1); PG8_BAR; PG8_SCHED;
        }
        if (wr == 0) PG8_BAR;
        PG8_WAIT_V(0);
        { int te = tid; asm volatile("" : "+v"(te));
          E(acc, cur, (te >> 8) & 1, (te >> 6) & 3, te & 15, (te >> 4) & 3, lds); }
        if (!has_next) break;
        if (!E.keep(cur)) PG8_ZERO;
        cur = nxt; cA = nA; cB = nB; ++ui;
        if (wr == 1) PG8_BAR;
    }
    PG8_WAIT_V(0);
    PG8_BAR;
#undef PG8_SA
#undef PG8_SB
#undef PG8_STAGE
#undef PG8_LDA
#undef PG8_LDB
#undef PG8_MMA
#undef PG8_WAIT_V
#undef PG8_WAIT_L
#undef PG8_BAR
#undef PG8_SCHED
#undef PG8_ZERO
}
}

using pg8::bf16_t; using pg8::f32x4; using pg8::u32x4; using pg8::u32x2; using pg8::bf16x8; using pg8::cvt_pk_bf16; using pg8::sigm;

constexpr int NWAVES = 8, NT = 512;
constexpr int D = 1024, MP = 16384, NSAMP = 128, M_TOK = MP + NSAMP, M_PAD = 16640, SEQ = 2048, NB = 8, FF = 2816, NMEM = 256;
constexpr float DN_ALPHA = 1.41421356237f, LN_EPS = 1e-5f;
constexpr size_t OUT_Y = 0, OUT_POOLP = 16908288, OUT_CONVP = 17031168, OUT_SCP = 17276928, OUT_MK = 17293312, OUT_MV = 21487616,
                 OUT_POOLS = 25681920, OUT_CONVS = 27648000, OUT_SCS = 31580160, OUT_GV = 31842304, OUT_END = 31973376;
constexpr size_t MiB = 1u << 20;
constexpr size_t WO_UP1 = 0, WO_DN1 = WO_UP1 + (size_t)5632 * 1024 * 2, WO_IN = WO_DN1 + (size_t)1024 * 2816 * 2, WO_PROJ = WO_IN + (size_t)8192 * 1024 * 2,
                 WO_WO = WO_PROJ + (size_t)1024 * 2048 * 2, WO_WQ = WO_WO + (size_t)1024 * 1024 * 2, WO_KV = WO_WQ + (size_t)1024 * 1024 * 2, WO_AO = WO_KV + (size_t)2048 * 1024 * 2,
                 WO_UP2 = WO_AO + (size_t)1024 * 1024 * 2, WO_DN2 = WO_UP2 + (size_t)5632 * 1024 * 2, W_LAYER = WO_DN2 + (size_t)1024 * 2816 * 2;
constexpr size_t WS_CTL = 0, CTL_BYTES = 16384 + 8 * 16384;
constexpr size_t WS_XBUF = 256 * 1024;
constexpr size_t WS_W = 1 * MiB, WS_XB = WS_W + 2 * W_LAYER, WS_XF = WS_XB + (size_t)M_PAD * 1024 * 2, WS_R1 = WS_XF + (size_t)M_PAD * 1024 * 4,
                 WS_R2 = WS_R1 + (size_t)M_PAD * 4096 * 2, WS_MIX = WS_R2 + (size_t)M_PAD * 3072 * 2, WS_MRG = WS_MIX + (size_t)M_PAD * 2048 * 2,
                 WS_MEMB = WS_MRG + (size_t)M_PAD * 1024 * 2, WS_KB = WS_MEMB + (size_t)2048 * 1024 * 2, WS_VT = WS_KB + (size_t)2 * 2048 * 1024 * 2, WS_END = WS_VT + (size_t)2 * 2048 * 1024 * 2;
static_assert(W_LAYER % 256 == 0, "align");
constexpr int LDS_BYTES = 147456;

enum { I_XP = 0, I_XS, I_MEM, I_SPOOL, I_SCONV, I_SSC, I_CK, I_CV, I_LN1G, I_LN1B, I_F1W1, I_F1W3, I_F1W2, I_WIN, I_WGATE, I_BGATE, I_POOLW, I_POOLS, I_POOLP,
       I_GLNG, I_GLNB, I_GWS, I_GB, I_GPROJ, I_CDW, I_CDB, I_CLNG, I_CLNB, I_CPROJ, I_SCW, I_SCPROJ, I_WO, I_LN2G, I_LN2B, I_WQ, I_WK, I_WV, I_XWO, I_LN3G, I_LN3B,
       I_F2W1, I_F2W3, I_F2W2, I_LN4G, I_LN4B, N_IN };

struct Args { const float* in[N_IN]; float* out; unsigned char* ws; int ph_lo, ph_hi; };
struct View { const Args* a; int z; unsigned char* ws; float* out; __device__ __forceinline__ const float* in(int i) const { return a->in[i + z]; } };

#define LAS __attribute__((address_space(3)))
__device__ __forceinline__ float wave_sum(float v) {
#pragma unroll
    for (int o = 1; o < 64; o <<= 1) v += __shfl_xor(v, o);
    return v;
}
__device__ __forceinline__ float wave_max(float v) {
#pragma unroll
    for (int o = 1; o < 64; o <<= 1) v = fmaxf(v, __shfl_xor(v, o));
    return v;
}
__device__ __forceinline__ void unpack8(u32x4 w, float (&f)[8]) {
    f[0] = __uint_as_float(w.x << 16); f[1] = __uint_as_float(w.x & 0xffff0000u); f[2] = __uint_as_float(w.y << 16); f[3] = __uint_as_float(w.y & 0xffff0000u);
    f[4] = __uint_as_float(w.z << 16); f[5] = __uint_as_float(w.z & 0xffff0000u); f[6] = __uint_as_float(w.w << 16); f[7] = __uint_as_float(w.w & 0xffff0000u);
}
__device__ __forceinline__ u32x4 pack8(const float (&f)[8]) { u32x4 w; w.x = cvt_pk_bf16(f[0], f[1]); w.y = cvt_pk_bf16(f[2], f[3]); w.z = cvt_pk_bf16(f[4], f[5]); w.w = cvt_pk_bf16(f[6], f[7]); return w; }
__device__ __forceinline__ void ldf8(const float* p, float (&f)[8]) { const f32x4 a = *(const f32x4*)p, b = *(const f32x4*)(p + 4); f[0] = a[0]; f[1] = a[1]; f[2] = a[2]; f[3] = a[3]; f[4] = b[0]; f[5] = b[1]; f[6] = b[2]; f[7] = b[3]; }
__device__ __forceinline__ void stf8(float* p, const float (&f)[8]) { *(f32x4*)p = (f32x4){f[0], f[1], f[2], f[3]}; *(f32x4*)(p + 4) = (f32x4){f[4], f[5], f[6], f[7]}; }
__device__ __forceinline__ void ldb8(const bf16_t* p, float (&f)[8]) { unpack8(*(const u32x4*)p, f); }

__device__ __forceinline__ void transpose_item(const float* W, int N, bf16_t* WT, int ldd, int koff, int k0, int n0, int drow0, LAS float* scr, int lane) {
    float wreg[32];
#pragma unroll
    for (int i = 0; i < 32; ++i) { const int kk = 2 * i + (lane >> 5); wreg[i] = __builtin_nontemporal_load(W + (size_t)(k0 + kk) * N + n0 + (lane & 31)); }
#pragma unroll
    for (int i = 0; i < 32; ++i) { const int kk = 2 * i + (lane >> 5); scr[kk * 33 + (lane & 31)] = wreg[i]; }
    asm volatile("s_waitcnt lgkmcnt(0)" ::: "memory");
    const int c = lane & 7;
#pragma unroll
    for (int j = 0; j < 4; ++j) { const int n = (lane >> 3) + 8 * j; const LAS float* s = scr + (8 * c) * 33 + n;
        u32x4 o; o.x = cvt_pk_bf16(s[0 * 33], s[1 * 33]); o.y = cvt_pk_bf16(s[2 * 33], s[3 * 33]); o.z = cvt_pk_bf16(s[4 * 33], s[5 * 33]); o.w = cvt_pk_bf16(s[6 * 33], s[7 * 33]);
        *(u32x4*)(WT + (size_t)(drow0 + n) * ldd + koff + k0 + 8 * c) = o; }
    asm volatile("s_waitcnt lgkmcnt(0)" ::: "memory");
}
__device__ __forceinline__ int map_pair(int n0, int half) { return 256 * (n0 >> 7) + 128 * half + (n0 & 127); }
__device__ __forceinline__ int map_win(int n0) {
    const int seg = n0 >> 9, o = n0 & 511;
    switch (seg) { case 0: case 1: case 2: return n0;
        case 3: return 1536 + map_pair(o, 0); case 4: return 1536 + map_pair(o, 1); case 5: return 2560 + o;
        case 6: return 3072 + map_pair(o, 0); default: return 3072 + map_pair(o, 1); }
}
#define NJOBS 16
template <int J> struct TJ;
#define DEF_TJ(J, SRC, K_, N_, LDD, KOFF, MAP, DST) template <> struct TJ<J> { static constexpr int src = SRC, K = K_, N = N_, ldd = LDD, koff = KOFF, map = MAP, items = (K_ / 64) * (N_ / 32); static constexpr size_t dst = DST; };
DEF_TJ(0, I_F1W1, 1024, 2816, 1024, 0, 1, WO_UP1)
DEF_TJ(1, I_F1W3, 1024, 2816, 1024, 0, 2, WO_UP1)
DEF_TJ(2, I_F1W2, 2816, 1024, 2816, 0, 0, WO_DN1)
DEF_TJ(3, I_WIN, 1024, 4096, 1024, 0, 3, WO_IN)
DEF_TJ(4, I_WGATE, 1024, 4096, 1024, 0, 4, WO_IN)
DEF_TJ(5, I_GPROJ, 512, 1024, 2048, 512, 0, WO_PROJ)
DEF_TJ(6, I_CPROJ, 512, 1024, 2048, 1024, 0, WO_PROJ)
DEF_TJ(7, I_SCPROJ, 512, 1024, 2048, 1536, 0, WO_PROJ)
DEF_TJ(8, I_WO, 1024, 1024, 1024, 0, 0, WO_WO)
DEF_TJ(9, I_WQ, 1024, 1024, 1024, 0, 0, WO_WQ)
DEF_TJ(10, I_WK, 1024, 1024, 1024, 0, 0, WO_KV)
DEF_TJ(11, I_WV, 1024, 1024, 1024, 0, 5, WO_KV)
DEF_TJ(12, I_XWO, 1024, 1024, 1024, 0, 0, WO_AO)
DEF_TJ(13, I_F2W1, 1024, 2816, 1024, 0, 1, WO_UP2)
DEF_TJ(14, I_F2W3, 1024, 2816, 1024, 0, 2, WO_UP2)
DEF_TJ(15, I_F2W2, 2816, 1024, 2816, 0, 0, WO_DN2)
template <int J> __device__ __forceinline__ void run_tjob(const View& a, LAS float* scr, int lane, int gw, int NGW, int& base) {
    typedef TJ<J> T;
    const float* W0 = a.in(T::src); unsigned char* wsW = a.ws + WS_W + T::dst;
    int r = (gw - base) % NGW; if (r < 0) r += NGW;
    for (; r < 2 * T::items; r += NGW) {
        const int l = r / T::items, q = r % T::items;
        constexpr int nblk = T::N / 32; const int kb = q / nblk, nb = q % nblk, n0 = nb * 32;
        int drow;
        if (T::map == 0) drow = n0; else if (T::map == 1) drow = map_pair(n0, 0); else if (T::map == 2) drow = map_pair(n0, 1); else if (T::map == 3) drow = map_win(n0); else if (T::map == 4) drow = 4096 + n0; else drow = 1024 + n0;
        transpose_item(W0 + (size_t)l * T::K * T::N, T::N, (bf16_t*)(wsW + (size_t)l * W_LAYER), T::ldd, T::koff, kb * 64, n0, drow, scr, lane);
    }
    base = (base + 2 * T::items) % NGW;
}

__device__ __forceinline__ void prologue(const View& a, unsigned char* lds_g, int G, int cid, const int wv_) {
    int tid_ = MK_TID; asm volatile("" : "+v"(tid_)); const int tid = tid_, lane = tid & 63, wave = __builtin_amdgcn_readfirstlane(tid >> 6);
    const int gw = cid * NWAVES + wave, NGW = G * NWAVES;
    LAS float* scr = (LAS float*)((LAS unsigned char*)lds_g + wave * 16384);
    { int base = 0;
      run_tjob<0>(a, scr, lane, gw, NGW, base); run_tjob<1>(a, scr, lane, gw, NGW, base); run_tjob<2>(a, scr, lane, gw, NGW, base); run_tjob<3>(a, scr, lane, gw, NGW, base);
      run_tjob<4>(a, scr, lane, gw, NGW, base); run_tjob<5>(a, scr, lane, gw, NGW, base); run_tjob<6>(a, scr, lane, gw, NGW, base); run_tjob<7>(a, scr, lane, gw, NGW, base);
      run_tjob<8>(a, scr, lane, gw, NGW, base); run_tjob<9>(a, scr, lane, gw, NGW, base); run_tjob<10>(a, scr, lane, gw, NGW, base); run_tjob<11>(a, scr, lane, gw, NGW, base);
      run_tjob<12>(a, scr, lane, gw, NGW, base); run_tjob<13>(a, scr, lane, gw, NGW, base); run_tjob<14>(a, scr, lane, gw, NGW, base); run_tjob<15>(a, scr, lane, gw, NGW, base); }
    for (int it = gw; it < 2048; it += NGW) {
        const int l = it >> 10, k0 = ((it >> 4) & 63) * 8, g = k0 >> 7, n = (it & 15) * 64 + lane;
        const float* pw = a.in(I_POOLW) + ((size_t)l * 512 + k0) * 128;
        const float* sc = a.in(I_POOLS) + l * 512 + g * 128;
        const float* pp = a.in(I_POOLP) + ((size_t)l * 512 + g * 128) * 1024 + n;
        float acc[8];
#pragma unroll
        for (int kk = 0; kk < 8; ++kk) acc[kk] = 0.f;
#pragma unroll 2
        for (int d = 0; d < 128; d += 4) {
            float p[4];
#pragma unroll
            for (int q = 0; q < 4; ++q) p[q] = pp[(size_t)(d + q) * 1024] * sc[d + q];
#pragma unroll
            for (int kk = 0; kk < 8; ++kk) { const f32x4 w = *(const f32x4*)(pw + kk * 128 + d); acc[kk] += (w[0] * p[0] + w[1] * p[1]) + (w[2] * p[2] + w[3] * p[3]); }
        }
        *(u32x4*)((bf16_t*)(a.ws + WS_W + (size_t)l * W_LAYER + WO_PROJ) + (size_t)n * 2048 + k0) = pack8(acc);
    }
    bf16_t* XB = (bf16_t*)(a.ws + WS_XB); bf16_t* MEMB = (bf16_t*)(a.ws + WS_MEMB);
    for (int r = gw; r < M_PAD + 2048; r += NGW) {
        if (r < M_PAD) {
            const float* src = r < MP ? a.in(I_XP) + (size_t)r * D : a.in(I_XS) + (size_t)(r - MP) * D;
#pragma unroll
            for (int j = 0; j < 4; ++j) {
                f32x4 v = (f32x4){0.f, 0.f, 0.f, 0.f};
                if (r < M_TOK) v = __builtin_nontemporal_load((const f32x4*)(src + 256 * j + 4 * lane));
                *(u32x2*)(XB + (size_t)r * D + 256 * j + 4 * lane) = (u32x2){cvt_pk_bf16(v[0], v[1]), cvt_pk_bf16(v[2], v[3])};
            }
        } else {
            const int m = r - M_PAD; const float* src = a.in(I_MEM) + (size_t)m * D;
#pragma unroll
            for (int j = 0; j < 4; ++j) { const f32x4 v = __builtin_nontemporal_load((const f32x4*)(src + 256 * j + 4 * lane));
                *(u32x2*)(MEMB + (size_t)m * D + 256 * j + 4 * lane) = (u32x2){cvt_pk_bf16(v[0], v[1]), cvt_pk_bf16(v[2], v[3])}; }
        }
    }
}

__device__ __forceinline__ void ln_pass_sample(const float* Ys, bf16_t* XB, const float* g, const float* b, float* out, int G, int cid, const int wv_) {
    int tid_ = MK_TID; asm volatile("" : "+v"(tid_)); const int tid = tid_, lane = tid & 63, wave = __builtin_amdgcn_readfirstlane(tid >> 6);
    const int gw = cid * NWAVES + wave, NGW = G * NWAVES;
    for (int r = gw; r < NSAMP; r += NGW) {
        const float* xr = Ys + (size_t)r * D + 4 * lane;
        f32x4 v[4]; float s = 0.f;
#pragma unroll
        for (int j = 0; j < 4; ++j) { v[j] = *(const f32x4*)(xr + 256 * j); s += (v[j][0] + v[j][1]) + (v[j][2] + v[j][3]); }
        const float mean = wave_sum(s) * (1.f / D); float s2 = 0.f;
#pragma unroll
        for (int j = 0; j < 4; ++j) { v[j] = v[j] - mean; s2 += (v[j][0] * v[j][0] + v[j][1] * v[j][1]) + (v[j][2] * v[j][2] + v[j][3] * v[j][3]); }
        const float rstd = 1.0f / sqrtf(wave_sum(s2) * (1.f / D) + LN_EPS);
#pragma unroll
        for (int j = 0; j < 4; ++j) {
            const f32x4 y = v[j] * rstd * *(const f32x4*)(g + 256 * j + 4 * lane) + *(const f32x4*)(b + 256 * j + 4 * lane);
            *(u32x2*)(XB + (size_t)(MP + r) * D + 256 * j + 4 * lane) = (u32x2){cvt_pk_bf16(y[0], y[1]), cvt_pk_bf16(y[2], y[3])};
            if (out) *(f32x4*)(out + (size_t)(MP + r) * D + 256 * j + 4 * lane) = y;
        }
    }
}

template <bool DO_C>
__device__ __forceinline__ void mix_row_p(const View& a, int l, int r, int lane, const bf16_t* P, bf16_t* MIX, const LAS float* DW, const LAS bf16_t* GLrow) {
    const int ch0 = lane * 8, b = r >> 11, t = r & 2047;
    const bf16_t* Pr = P + (size_t)r * 3072 + ch0; bf16_t* Mr = MIX + (size_t)r * 2048 + ch0; float* out = a.out + ch0;
    {
        const int win = 2 << (lane >> 4);
        float av[8], sacc[8]; ldb8(Pr, av);
#pragma unroll
        for (int c = 0; c < 8; ++c) sacc[c] = av[c];
        u32x4 x[15];
#pragma unroll
        for (int i = 1; i < 16; ++i) { const int dr = i > t ? t : i; x[i - 1] = *(const u32x4*)(Pr - (ptrdiff_t)dr * 3072); }
#pragma unroll
        for (int i = 1; i < 16; ++i) { float f[8]; unpack8(x[i - 1], f); const float mk = (i < win && i <= t) ? 1.f : 0.f;
#pragma unroll
            for (int c = 0; c < 8; ++c) sacc[c] += f[c] * mk; }
        const int cnt = t + 1 < win ? t + 1 : win; const float inv = 1.0f / (float)cnt; float o[8];
#pragma unroll
        for (int c = 0; c < 8; ++c) o[c] = sacc[c] * inv - av[c];
        *(u32x4*)(Mr) = pack8(o);
        if (t >= SEQ - 15) stf8(out + OUT_POOLP + ((size_t)(l * NB + b) * 15 + (t - (SEQ - 15))) * 512, av);
    }
    asm volatile("" ::: "memory");
    if constexpr (DO_C) {
        float cacc[8]; ldf8(a.in(I_CDB) + l * 512 + ch0, cacc);
#pragma unroll
        for (int jb = 0; jb < 31; jb += 8) {
            u32x4 x[8];
#pragma unroll
            for (int u = 0; u < 8; ++u) { const int j = jb + u; if (j < 31) x[u] = *(const LAS u32x4*)(GLrow - (30 - j) * 512 + ch0); }
#pragma unroll
            for (int u = 0; u < 8; ++u) { const int j = jb + u; if (j < 31) {
                float f[8]; unpack8(x[u], f); const float mk = (30 - j <= t) ? 1.f : 0.f;
                const f32x4 w0 = *(const LAS f32x4*)(DW + j * 512 + ch0) * mk, w1 = *(const LAS f32x4*)(DW + j * 512 + ch0 + 4) * mk;
                cacc[0] += f[0] * w0[0]; cacc[1] += f[1] * w0[1]; cacc[2] += f[2] * w0[2]; cacc[3] += f[3] * w0[3];
                cacc[4] += f[4] * w1[0]; cacc[5] += f[5] * w1[1]; cacc[6] += f[6] * w1[2]; cacc[7] += f[7] * w1[3];
            } }
            asm volatile("" ::: "memory");
        }
        float sm = 0.f;
#pragma unroll
        for (int c = 0; c < 8; ++c) sm += cacc[c];
        const float mean = wave_sum(sm) * (1.f / 512.f); float s2 = 0.f;
#pragma unroll
        for (int c = 0; c < 8; ++c) { cacc[c] -= mean; s2 += cacc[c] * cacc[c]; }
        const float rstd = 1.0f / sqrtf(wave_sum(s2) * (1.f / 512.f) + LN_EPS);
        float g[8], bb[8], o[8]; ldf8(a.in(I_CLNG) + l * 512 + ch0, g); ldf8(a.in(I_CLNB) + l * 512 + ch0, bb);
#pragma unroll
        for (int c = 0; c < 8; ++c) { const float y = cacc[c] * rstd * g[c] + bb[c]; o[c] = y * sigm(y); }
        *(u32x4*)(Mr + 1024) = pack8(o);
        if (t >= SEQ - 30) { float gl[8]; ldb8(Pr + 1536, gl); stf8(out + OUT_CONVP + ((size_t)(l * NB + b) * 30 + (t - (SEQ - 30))) * 512, gl); }
    }
    {
        const float* sw = a.in(I_SCW) + (size_t)l * 3 * 512 + ch0;
        float w0[8], w1[8], w2[8], z0[8], z1[8], z2[8], sb[8], o[8];
        ldf8(sw, w0); ldf8(sw + 512, w1); ldf8(sw + 1024, w2);
        const u32x4 xz2 = *(const u32x4*)(Pr + 2560), xsb = *(const u32x4*)(Pr + 2048);
        const u32x4 xz1 = *(const u32x4*)(Pr - (ptrdiff_t)(t >= 1 ? 1 : 0) * 3072 + 2560), xz0 = *(const u32x4*)(Pr - (ptrdiff_t)(t >= 2 ? 2 : 0) * 3072 + 2560);
        unpack8(xz2, z2); unpack8(xsb, sb); unpack8(xz1, z1); unpack8(xz0, z0);
        const float m1 = t >= 1 ? 1.f : 0.f, m0 = t >= 2 ? 1.f : 0.f;
#pragma unroll
        for (int c = 0; c < 8; ++c) o[c] = sb[c] * (w0[c] * z0[c] * m0 + w1[c] * z1[c] * m1 + w2[c] * z2[c]);
        *(u32x4*)(Mr + 1536) = pack8(o);
        if (t >= SEQ - 2) stf8(out + OUT_SCP + ((size_t)(l * NB + b) * 2 + (t - (SEQ - 2))) * 512, z2);
    }
}

__device__ __forceinline__ void conv4_lds(const View& a, int l, int r0, int lane, bf16_t* MIX, const LAS float* DW, const LAS bf16_t* GLw) {
    const int ch0 = lane * 8;
    float cacc[4][8];
    { float db[8]; ldf8(a.in(I_CDB) + l * 512 + ch0, db);
#pragma unroll
      for (int i = 0; i < 4; ++i)
#pragma unroll
          for (int c = 0; c < 8; ++c) cacc[i][c] = db[c]; }
    float wv[4][8];
#pragma unroll
    for (int q = 0; q < 34; ++q) {
        if (q <= 30) { const f32x4 w0 = *(const LAS f32x4*)(DW + q * 512 + ch0), w1 = *(const LAS f32x4*)(DW + q * 512 + ch0 + 4);
            wv[q & 3][0] = w0[0]; wv[q & 3][1] = w0[1]; wv[q & 3][2] = w0[2]; wv[q & 3][3] = w0[3]; wv[q & 3][4] = w1[0]; wv[q & 3][5] = w1[1]; wv[q & 3][6] = w1[2]; wv[q & 3][7] = w1[3]; }
        float f[8]; unpack8(*(const LAS u32x4*)(GLw + q * 512 + ch0), f);
#pragma unroll
        for (int i = 0; i < 4; ++i) { const int j = q - i; if (j >= 0 && j <= 30) {
#pragma unroll
                for (int c = 0; c < 8; ++c) cacc[i][c] += f[c] * wv[j & 3][c]; } }
    }
    float g[8], bb[8]; ldf8(a.in(I_CLNG) + l * 512 + ch0, g); ldf8(a.in(I_CLNB) + l * 512 + ch0, bb);
#pragma unroll
    for (int i = 0; i < 4; ++i) {
        float sm = 0.f;
#pragma unroll
        for (int c = 0; c < 8; ++c) sm += cacc[i][c];
        const float mean = wave_sum(sm) * (1.f / 512.f); float s2 = 0.f;
#pragma unroll
        for (int c = 0; c < 8; ++c) { cacc[i][c] -= mean; s2 += cacc[i][c] * cacc[i][c]; }
        const float rstd = 1.0f / sqrtf(wave_sum(s2) * (1.f / 512.f) + LN_EPS); float o[8];
#pragma unroll
        for (int c = 0; c < 8; ++c) { const float y = cacc[i][c] * rstd * g[c] + bb[c]; o[c] = y * sigm(y); }
        *(u32x4*)(MIX + (size_t)(r0 + i) * 2048 + 1024 + ch0) = pack8(o);
    }
    const int t0 = r0 & 2047, b = r0 >> 11;
    if (t0 + 3 >= SEQ - 30) {
        for (int i = 0; i < 4; ++i) { const int t = t0 + i; if (t >= SEQ - 30) { float f[8]; unpack8(*(const LAS u32x4*)(GLw + (30 + i) * 512 + ch0), f);
            stf8(a.out + OUT_CONVP + ((size_t)(l * NB + b) * 30 + (t - (SEQ - 30))) * 512 + ch0, f); } }
    }
}

__device__ __forceinline__ void mix_row_s(const View& a, int l, int bs, int lane, const bf16_t* P, bf16_t* MIX, const LAS float* DW) {
    const int ch0 = lane * 8, r = MP + bs;
    const bf16_t* Pr = P + (size_t)r * 3072 + ch0; bf16_t* Mr = MIX + (size_t)r * 2048 + ch0; float* out = a.out + ch0;
    {
        const int win = 2 << (lane >> 4);
        const float* sp = a.in(I_SPOOL) + ((size_t)(l * NSAMP + bs) * 15) * 512 + ch0;
        float* dp = out + OUT_POOLS + ((size_t)(l * NSAMP + bs) * 15) * 512;
        float av[8], sacc[8]; ldb8(Pr, av);
#pragma unroll
        for (int c = 0; c < 8; ++c) sacc[c] = av[c];
        f32x4 x0[15], x1[15];
#pragma unroll
        for (int i = 0; i < 15; ++i) { x0[i] = __builtin_nontemporal_load((const f32x4*)(sp + i * 512)); x1[i] = __builtin_nontemporal_load((const f32x4*)(sp + i * 512 + 4)); }
#pragma unroll
        for (int i = 0; i < 15; ++i) { const float mk = (15 - i < win) ? 1.f : 0.f;
            sacc[0] += x0[i][0] * mk; sacc[1] += x0[i][1] * mk; sacc[2] += x0[i][2] * mk; sacc[3] += x0[i][3] * mk; sacc[4] += x1[i][0] * mk; sacc[5] += x1[i][1] * mk; sacc[6] += x1[i][2] * mk; sacc[7] += x1[i][3] * mk;
            if (i >= 1) { *(f32x4*)(dp + (i - 1) * 512) = x0[i]; *(f32x4*)(dp + (i - 1) * 512 + 4) = x1[i]; } }
        stf8(dp + 14 * 512, av);
        const float inv = 1.0f / (float)win; float o[8];
#pragma unroll
        for (int c = 0; c < 8; ++c) o[c] = sacc[c] * inv - av[c];
        *(u32x4*)(Mr) = pack8(o);
    }
    asm volatile("" ::: "memory");
    {
        float cacc[8]; ldf8(a.in(I_CDB) + l * 512 + ch0, cacc);
        const float* sp = a.in(I_SCONV) + ((size_t)(l * NSAMP + bs) * 30) * 512 + ch0;
        float* dp = out + OUT_CONVS + ((size_t)(l * NSAMP + bs) * 30) * 512;
#pragma unroll
        for (int jb = 0; jb < 30; jb += 10) {
            f32x4 x0[10], x1[10];
#pragma unroll
            for (int u = 0; u < 10; ++u) { x0[u] = __builtin_nontemporal_load((const f32x4*)(sp + (jb + u) * 512)); x1[u] = __builtin_nontemporal_load((const f32x4*)(sp + (jb + u) * 512 + 4)); }
#pragma unroll
            for (int u = 0; u < 10; ++u) { const int j = jb + u;
                const f32x4 w0 = *(const LAS f32x4*)(DW + j * 512 + ch0), w1 = *(const LAS f32x4*)(DW + j * 512 + ch0 + 4);
                cacc[0] += x0[u][0] * w0[0]; cacc[1] += x0[u][1] * w0[1]; cacc[2] += x0[u][2] * w0[2]; cacc[3] += x0[u][3] * w0[3];
                cacc[4] += x1[u][0] * w1[0]; cacc[5] += x1[u][1] * w1[1]; cacc[6] += x1[u][2] * w1[2]; cacc[7] += x1[u][3] * w1[3];
                if (j >= 1) { *(f32x4*)(dp + (j - 1) * 512) = x0[u]; *(f32x4*)(dp + (j - 1) * 512 + 4) = x1[u]; } }
            asm volatile("" ::: "memory");
        }
        { float gl[8]; ldb8(Pr + 1536, gl);
          const f32x4 w0 = *(const LAS f32x4*)(DW + 30 * 512 + ch0), w1 = *(const LAS f32x4*)(DW + 30 * 512 + ch0 + 4);
          cacc[0] += gl[0] * w0[0]; cacc[1] += gl[1] * w0[1]; cacc[2] += gl[2] * w0[2]; cacc[3] += gl[3] * w0[3]; cacc[4] += gl[4] * w1[0]; cacc[5] += gl[5] * w1[1]; cacc[6] += gl[6] * w1[2]; cacc[7] += gl[7] * w1[3];
          stf8(dp + 29 * 512, gl); }
        float sm = 0.f;
#pragma unroll
        for (int c = 0; c < 8; ++c) sm += cacc[c];
        const float mean = wave_sum(sm) * (1.f / 512.f); float s2 = 0.f;
#pragma unroll
        for (int c = 0; c < 8; ++c) { cacc[c] -= mean; s2 += cacc[c] * cacc[c]; }
        const float rstd = 1.0f / sqrtf(wave_sum(s2) * (1.f / 512.f) + LN_EPS);
        float g[8], bb[8], o[8]; ldf8(a.in(I_CLNG) + l * 512 + ch0, g); ldf8(a.in(I_CLNB) + l * 512 + ch0, bb);
#pragma unroll
        for (int c = 0; c < 8; ++c) { const float y = cacc[c] * rstd * g[c] + bb[c]; o[c] = y * sigm(y); }
        *(u32x4*)(Mr + 1024) = pack8(o);
    }
    {
        const float* sw = a.in(I_SCW) + (size_t)l * 3 * 512 + ch0;
        float w0[8], w1[8], w2[8], z0[8], z1[8], z2[8], sb[8], o[8];
        ldf8(sw, w0); ldf8(sw + 512, w1); ldf8(sw + 1024, w2);
        ldb8(Pr + 2560, z2); ldb8(Pr + 2048, sb);
        const float* sp = a.in(I_SSC) + ((size_t)(l * NSAMP + bs) * 2) * 512 + ch0;
        float* dp = out + OUT_SCS + ((size_t)(l * NSAMP + bs) * 2) * 512;
        ldf8(sp, z0); ldf8(sp + 512, z1);
        stf8(dp, z1); stf8(dp + 512, z2);
#pragma unroll
        for (int c = 0; c < 8; ++c) o[c] = sb[c] * (w0[c] * z0[c] + w1[c] * z1[c] + w2[c] * z2[c]);
        *(u32x4*)(Mr + 1536) = pack8(o);
    }
    {
        float v[8]; ldb8(Pr + 1024, v);
        float sm = 0.f;
#pragma unroll
        for (int c = 0; c < 8; ++c) sm += v[c];
        const float mean = wave_sum(sm) * (1.f / 512.f); float s2 = 0.f;
#pragma unroll
        for (int c = 0; c < 8; ++c) { v[c] -= mean; s2 += v[c] * v[c]; }
        const float rstd = 1.0f / sqrtf(wave_sum(s2) * (1.f / 512.f) + LN_EPS);
        float g[8], bb[8], u[8], o[8]; ldf8(a.in(I_GLNG) + l * 512 + ch0, g); ldf8(a.in(I_GLNB) + l * 512 + ch0, bb); ldb8(Pr + 512, u);
        const int h = lane >> 4;
        const float w00 = a.in(I_GWS)[((size_t)(l * 4 + h) * 128) * 128], b0 = a.in(I_GB)[(l * 4 + h) * 128];
#pragma unroll
        for (int c = 0; c < 8; ++c) { v[c] = v[c] * rstd * g[c] + bb[c]; o[c] = u[c] * (w00 * v[c] + b0); }
        stf8(out + OUT_GV + (size_t)(l * NSAMP + bs) * 512, v);
        *(u32x4*)(Mr + 512) = pack8(o);
    }
}

__device__ __forceinline__ void sgu_unit(const View& a, int l, int un, unsigned char* lds_g, const bf16_t* P, bf16_t* MIX, const int wv_) {
    int tid_ = MK_TID; asm volatile("" : "+v"(tid_)); const int tid = tid_, lane = tid & 63, wave = __builtin_amdgcn_readfirstlane(tid >> 6);
    const int ck = un >> 1, h0 = (un & 1) * 2; const int r0 = ck * 128;
    LAS bf16_t* V = (LAS bf16_t*)lds_g;
    {
        float g[8], bb[8]; ldf8(a.in(I_GLNG) + l * 512 + lane * 8, g); ldf8(a.in(I_GLNB) + l * 512 + lane * 8, bb);
        u32x4 vr[16];
#pragma unroll
        for (int i = 0; i < 16; ++i) vr[i] = *(const u32x4*)(P + (size_t)(r0 + wave * 16 + i) * 3072 + 1024 + lane * 8);
#pragma unroll
        for (int i = 0; i < 16; ++i) {
            const int s_ = wave * 16 + i;
            float v[8]; unpack8(vr[i], v);
            float s = 0.f;
#pragma unroll
            for (int q = 0; q < 8; ++q) s += v[q];
            const float mean = wave_sum(s) * (1.f / 512.f); float s2 = 0.f;
#pragma unroll
            for (int q = 0; q < 8; ++q) { v[q] -= mean; s2 += v[q] * v[q]; }
            const float rstd = 1.0f / sqrtf(wave_sum(s2) * (1.f / 512.f) + LN_EPS);
            if ((lane >> 5) == (h0 >> 1)) {
                LAS unsigned* dst = (LAS unsigned*)(V + ((lane >> 4) & 1) * (128 * 130) + s_ * 130 + (lane & 15) * 8);
#pragma unroll
                for (int q = 0; q < 4; ++q) dst[q] = cvt_pk_bf16(v[2 * q] * rstd * g[2 * q] + bb[2 * q], v[2 * q + 1] * rstd * g[2 * q + 1] + bb[2 * q + 1]);
            }
        }
    }
    __syncthreads();
    for (int hh = 0; hh < 2; ++hh) {
        const int h = h0 + hh; const LAS bf16_t* Vh = V + hh * (128 * 130);
        const int t0 = wave * 16, nk = (t0 + 16 + 31) >> 5, fr = lane & 15, fq = lane >> 4;
        const int t = t0 + fr;
        const float* Wrow = a.in(I_GWS) + ((size_t)(l * 4 + h) * 128 + t) * 128;
        f32x4 acc[8];
#pragma unroll
        for (int n = 0; n < 8; ++n) acc[n] = (f32x4){0.f, 0.f, 0.f, 0.f};
        for (int kk = 0; kk < nk; ++kk) {
            const int s0 = kk * 32 + fq * 8;
            float w[8]; ldf8(Wrow + s0, w);
#pragma unroll
            for (int q = 0; q < 8; ++q) if (s0 + q > t) w[q] = 0.f;
            const u32x4 wp = pack8(w);
            const bf16x8 wf = __builtin_bit_cast(bf16x8, wp);
#pragma unroll
            for (int n = 0; n < 8; ++n) {
                bf16x8 vf;
#pragma unroll
                for (int q = 0; q < 8; ++q) vf[q] = (short)Vh[(s0 + q) * 130 + n * 16 + fr];
                acc[n] = __builtin_amdgcn_mfma_f32_16x16x32_bf16(vf, wf, acc[n], 0, 0, 0);
            }
        }
        const float bias = a.in(I_GB)[(l * 4 + h) * 128 + t];
        const bf16_t* up = P + (size_t)(r0 + t) * 3072 + 512 + h * 128 + fq * 4;
        bf16_t* op = MIX + (size_t)(r0 + t) * 2048 + 512 + h * 128 + fq * 4;
#pragma unroll
        for (int n = 0; n < 8; ++n) {
            const u32x2 uu = *(const u32x2*)(up + n * 16);
            const f32x4 u4 = pg8::bflo(uu.x, uu.y);
            const f32x4 z = (acc[n] + bias) * u4;
            *(u32x2*)(op + n * 16) = (u32x2){cvt_pk_bf16(z[0], z[1]), cvt_pk_bf16(z[2], z[3])};
        }
    }
    __syncthreads();
}

__device__ __forceinline__ void samp_attn_unit(const View& a, int l, int un, unsigned char* lds_g, const bf16_t* Q, bf16_t* O, const int wv_) {
    int tid_ = MK_TID; asm volatile("" : "+v"(tid_)); const int tid = tid_, lane = tid & 63, wave = __builtin_amdgcn_readfirstlane(tid >> 6);
    const int b = un >> 2, h = un & 3;
    LAS float* S = (LAS float*)lds_g;
    LAS float* Pl = S + 256;
    LAS float* RED = S + 512;
    const size_t base = (((size_t)(l * NSAMP + b) * NMEM) * 4 + h) * 256;
    const float* Kp = a.in(I_CK) + base + 4 * lane; const float* Vp = a.in(I_CV) + base + 4 * lane;
    const u32x2 qq = *(const u32x2*)(Q + (size_t)(MP + b) * D + h * 256 + 4 * lane);
    const f32x4 q4 = pg8::bflo(qq.x, qq.y);
    for (int mm = 0; mm < 32; mm += 8) {
        f32x4 k[8];
#pragma unroll
        for (int i = 0; i < 8; ++i) k[i] = __builtin_nontemporal_load((const f32x4*)(Kp + (size_t)(wave * 32 + mm + i) * 1024));
#pragma unroll
        for (int i = 0; i < 8; ++i) { float d = (q4[0] * k[i][0] + q4[1] * k[i][1]) + (q4[2] * k[i][2] + q4[3] * k[i][3]); d = wave_sum(d); if (lane == 0) S[wave * 32 + mm + i] = d; }
    }
    __syncthreads();
    {
        const float s0 = S[lane], s1 = S[64 + lane], s2 = S[128 + lane], s3 = S[192 + lane];
        const float mx = wave_max(fmaxf(fmaxf(s0, s1), fmaxf(s2, s3)));
        const float e0 = __expf(s0 - mx), e1 = __expf(s1 - mx), e2 = __expf(s2 - mx), e3 = __expf(s3 - mx);
        const float inv = 1.0f / wave_sum((e0 + e1) + (e2 + e3));
        if (wave == 0) { Pl[lane] = e0 * inv; Pl[64 + lane] = e1 * inv; Pl[128 + lane] = e2 * inv; Pl[192 + lane] = e3 * inv; }
    }
    __syncthreads();
    {
        f32x4 o = (f32x4){0.f, 0.f, 0.f, 0.f};
        for (int mm = 0; mm < 32; mm += 8) {
            f32x4 v[8];
#pragma unroll
            for (int i = 0; i < 8; ++i) v[i] = __builtin_nontemporal_load((const f32x4*)(Vp + (size_t)(wave * 32 + mm + i) * 1024));
#pragma unroll
            for (int i = 0; i < 8; ++i) o += v[i] * Pl[wave * 32 + mm + i];
        }
        *(LAS f32x4*)(RED + wave * 256 + 4 * lane) = o;
    }
    __syncthreads();
    if (tid < 256) {
        float s = 0.f;
#pragma unroll
        for (int w = 0; w < 8; ++w) s += RED[w * 256 + tid];
        const float other = __shfl_xor(s, 1);
        if ((tid & 1) == 0) *(unsigned*)(O + (size_t)(MP + b) * D + h * 256 + tid) = cvt_pk_bf16(s, other);
    }
    __syncthreads();
}

template <int MODE>
__device__ __forceinline__ void skinny_gemm(unsigned char* lds_g, const bf16_t* A, int lda, const bf16_t* Bt, int ldb, int Kq, float* X, bf16_t* O, const bf16_t* GATE, float alpha, float sc, int G, int cid, const int wv_) {
    int tid_ = MK_TID; asm volatile("" : "+v"(tid_)); const int tid = tid_, lane = tid & 63, wave = __builtin_amdgcn_readfirstlane(tid >> 6);
    const int rg = wave & 1, kq = wave >> 1, fr = lane & 15, fq = lane >> 4, nIt = Kq >> 5;
    LAS f32x4* RED = (LAS f32x4*)lds_g;
    for (int j = cid; j < 256; j += G) {
        const int rb = j & 3, cb = j >> 2;
        const bf16_t* ap = A + (size_t)(MP + rb * 32 + rg * 16 + fr) * lda + kq * Kq + fq * 8;
        const bf16_t* bp = Bt + (size_t)(cb * 16 + fr) * ldb + kq * Kq + fq * 8;
        f32x4 acc = (f32x4){0.f, 0.f, 0.f, 0.f};
        for (int k = 0; k < nIt; k += 4) {
            bf16x8 a[4], b[4];
#pragma unroll
            for (int u = 0; u < 4; ++u) {
                if (k + u < nIt) { a[u] = *(const bf16x8*)(ap + (k + u) * 32); b[u] = *(const bf16x8*)(bp + (k + u) * 32); }
                else { a[u] = (bf16x8){0, 0, 0, 0, 0, 0, 0, 0}; b[u] = a[u]; }
            }
#pragma unroll
            for (int u = 0; u < 4; ++u) acc = __builtin_amdgcn_mfma_f32_16x16x32_bf16(b[u], a[u], acc, 0, 0, 0);
        }
        RED[(kq * 2 + rg) * 64 + lane] = acc;
        __syncthreads();
        if (kq == 0) {
            const int orow = MP + rb * 32 + rg * 16 + fr, ocol = cb * 16 + 4 * fq;
            f32x4 v;
            if (MODE == 2) {
                v = (f32x4){0.f, 0.f, 0.f, 0.f};
#pragma unroll
                for (int q = 0; q < 4; ++q) { const u32x2 gq = *(const u32x2*)(GATE + (size_t)orow * 4096 + q * 1024 + ocol); v += RED[(q * 2 + rg) * 64 + lane] * pg8::bflo(gq.x, gq.y); }
            } else {
                v = (RED[(0 * 2 + rg) * 64 + lane] + RED[(1 * 2 + rg) * 64 + lane]) + (RED[(2 * 2 + rg) * 64 + lane] + RED[(3 * 2 + rg) * 64 + lane]);
            }
            if (MODE == 0) { const u32x2 xr = *(const u32x2*)(O + (size_t)orow * 1024 + ocol); *(f32x4*)(X + (size_t)(orow - MP) * 1024 + ocol) = pg8::bflo(xr.x, xr.y) * alpha + v * sc; }
            else { *(u32x2*)(O + (size_t)orow * 1024 + ocol) = (u32x2){cvt_pk_bf16(v[0] * sc, v[1] * sc), cvt_pk_bf16(v[2] * sc, v[3] * sc)}; }
        }
        __syncthreads();
    }
}

#define XB_TMO      128
#define XB_XCNT(j)  (256  + 64 * (j))
#define XB_XSUB(j)  (1280 + 64 * (j))
#define XB_XGEN(j)  (2304 + 64 * (j))
#define XB_TOP      3328
#define XB_TOPGEN   3392
#define XCD_BAR_WORDS 3456
#define XB_SPIN_CAP (1u << 18)

__device__ __forceinline__ unsigned xb_ld(unsigned* p)              { return __hip_atomic_load(p, __ATOMIC_RELAXED, __HIP_MEMORY_SCOPE_AGENT); }
__device__ __forceinline__ unsigned xb_add(unsigned* p, unsigned v) { return __hip_atomic_fetch_add(p, v, __ATOMIC_RELAXED, __HIP_MEMORY_SCOPE_AGENT); }
__device__ __forceinline__ unsigned xb_xcc_id() { return (unsigned)__builtin_amdgcn_s_getreg((3 << 11) | 20) & 0xFu; }
#define XB_SPIN(cond, bar) do { unsigned _sp = 0; while (cond) { __builtin_amdgcn_s_sleep(1); \
    if ((++_sp & 255u) == 0u) { if (xb_ld(&(bar)[XB_TMO])) break; if (_sp > XB_SPIN_CAP) { atomicAdd(&(bar)[XB_TMO], 1u); break; } } } } while (0)

struct XcdBarrier {
    unsigned* bar; unsigned x;
    volatile LAS unsigned* st;
};

__device__ __forceinline__ XcdBarrier xcd_barrier_post(unsigned* bar, volatile LAS unsigned* st) {
    XcdBarrier b; b.bar = bar; b.x = xb_xcc_id(); b.st = st;
    if (threadIdx.x == 0) (void)xb_add(&bar[XB_XCNT(b.x)], 1u);
    return b;
}
__device__ __forceinline__ void xcd_barrier_complete(unsigned* bar, unsigned x, unsigned& nloc, unsigned& nx) {
    const unsigned G = gridDim.x * gridDim.y * gridDim.z;
    unsigned sum, cnt, mine, sp = 0u;
    for (;;) {
        sum = 0u; cnt = 0u; mine = 0u;
#pragma unroll
        for (unsigned j = 0; j < 16; ++j) { const unsigned c = xb_ld(&bar[XB_XCNT(j)]); sum += c; cnt += (c > 0u) ? 1u : 0u; mine = (j == x) ? c : mine; }
        if (sum == G) break;
        __builtin_amdgcn_s_sleep(1);
        if ((++sp & 255u) == 0u) { if (xb_ld(&bar[XB_TMO])) break; if (sp > XB_SPIN_CAP) { atomicAdd(&bar[XB_TMO], 1u); break; } }
    }
    nloc = mine > 0u ? mine : 1u; nx = cnt > 0u ? cnt : 1u;
}

__device__ __forceinline__ void xcd_barrier(const XcdBarrier& b) {
    asm volatile("s_waitcnt vmcnt(0)" ::: "memory");
    __syncthreads();
    if (threadIdx.x == 0) {
        unsigned* bar = b.bar;
        __builtin_amdgcn_s_waitcnt(0);
        unsigned nloc = b.st[0], nx = b.st[1];
        if (nloc == 0u) { xcd_barrier_complete(bar, b.x, nloc, nx); b.st[0] = nloc; b.st[1] = nx; }
        const unsigned old = xb_add(&bar[XB_XSUB(b.x)], 1u);
        const unsigned gen = old / nloc;
        if (old + 1u == (gen + 1u) * nloc) {
            __builtin_amdgcn_fence(__ATOMIC_RELEASE, "agent");
            asm volatile("s_waitcnt vmcnt(0)" ::: "memory");
            const unsigned og = xb_add(&bar[XB_TOP], 1u);
            const unsigned tg = og / nx;
            if (og + 1u == (tg + 1u) * nx) xb_add(&bar[XB_TOPGEN], 1u);
            else XB_SPIN(xb_ld(&bar[XB_TOPGEN]) == tg, bar);
            __builtin_amdgcn_fence(__ATOMIC_ACQUIRE, "agent");
            xb_add(&bar[XB_XGEN(b.x)], 1u);
            asm volatile("s_waitcnt vmcnt(0)" ::: "memory");
        } else {
            XB_SPIN(xb_ld(&bar[XB_XGEN(b.x)]) == gen, bar);
            __builtin_amdgcn_fence(__ATOMIC_ACQUIRE, "agent");
            asm volatile("s_waitcnt vmcnt(0)" ::: "memory");
        }
    }
    __syncthreads();
}


constexpr int N_PHASES = 3 + 32;

template <int PH>
__device__ __forceinline__ void run_phase(const Args& args, unsigned char* lds, const int wv_) {
    constexpr int ph = PH, l = PH >= 3 ? (PH - 3) >> 4 : 0, s = PH >= 3 ? (PH - 3) & 15 : -1;
    PG8_LAS unsigned char* L = (PG8_LAS unsigned char*)lds;
        int z0 = 0; asm volatile("s_mov_b32 %0, 0" : "=s"(z0));
        unsigned char* ws = args.ws + z0;
        int tid_ = MK_TID; asm volatile("" : "+v"(tid_)); const int tid = tid_, lane = tid & 63, wave = __builtin_amdgcn_readfirstlane(tid >> 6);
        const View vw{&args, z0, ws, args.out + z0};
        const int G = (int)gridDim.x + z0, cid = (int)blockIdx.x + z0;
        bf16_t* XB = (bf16_t*)(ws + WS_XB); float* XF = (float*)(ws + WS_XF);
        bf16_t* GATE = (bf16_t*)(ws + WS_R1); bf16_t* HB = (bf16_t*)(ws + WS_R1);
        bf16_t* PB = (bf16_t*)(ws + WS_R2); bf16_t* QB = (bf16_t*)(ws + WS_R2); bf16_t* PRB = QB + (size_t)M_PAD * D; bf16_t* OB = PRB + (size_t)M_PAD * D;
        bf16_t* MIX = (bf16_t*)(ws + WS_MIX); bf16_t* MRG = (bf16_t*)(ws + WS_MRG); bf16_t* MEMB = (bf16_t*)(ws + WS_MEMB);

        const unsigned char* WL = ws + WS_W + (size_t)l * W_LAYER;
        if constexpr (ph == 0) {
#ifndef SK0
            prologue(vw, lds, G, cid, wv_);
#endif
        }
        if constexpr (s == 8 || s == 10) {
            constexpr int nj = 1;
            for (int j = 0; j < nj; ++j) {
                pg8::Gemm g; pg8::Sched S; pg8::EpiStore E;
                if constexpr (s == 8) {
                    g = pg8::Gemm{XB, (const bf16_t*)(WL + WO_WQ), 1024, 1024, 1024};
                    S.init(MP / 256, 4, 1, G, cid); S.a_pm = (size_t)256 * 1024 * 2; S.b_pn = (size_t)256 * 1024 * 2;
                    E = pg8::EpiStore{QB, 1024, 0.0625f};
                    skinny_gemm<1>(lds, XB, 1024, (const bf16_t*)(WL + WO_WQ), 1024, 256, nullptr, QB, nullptr, 0.f, 0.0625f, G, cid, wv_);
                } else {
                    g = pg8::Gemm{PRB, (const bf16_t*)(ws + WS_VT) + (size_t)l * 1024 * 2048, 1024, 2048, 256};
                    S.init(MP / 256, 4, 1, G, cid); S.a_pm = (size_t)256 * 1024 * 2; S.a_pn = 256 * 2; S.b_pn = (size_t)256 * 2048 * 2; S.b_b = 256 * 2;
                    E = pg8::EpiStore{OB, 1024, 1.0f};
                }
#ifndef SK2
                pg8::gemm_phase<pg8::EpiStore>(L, g, S, E, wv_);
#endif
            }
            if constexpr (s == 10) {
                __syncthreads();
                for (int un = 256 + cid; un < 512; un += G) samp_attn_unit(vw, l, un, lds, QB, OB, wv_);
            }
        } else if constexpr (s == 0 || s == 13) {
            pg8::Gemm g{XB, (const bf16_t*)(WL + (s == 0 ? WO_UP1 : WO_UP2)), 1024, 1024, 1024};
            pg8::Sched S; S.init(M_PAD / 256, 22, 1, G, cid); S.a_pm = (size_t)256 * 1024 * 2; S.b_pn = (size_t)256 * 1024 * 2;
            pg8::EpiUp E{HB, FF};
#ifndef SK3
            pg8::gemm_phase<pg8::EpiUp>(L, g, S, E, wv_);
#endif
            if constexpr (s == 0) {
                constexpr int c0 = (M_PAD / 256) * 22 % 256;
                {
                    pg8::Gemm g2{MEMB, (const bf16_t*)(WL + WO_KV), 1024, 1024, 1024};
                    pg8::Sched S2; S2.init(8, 8, 1, G, (cid + G - c0 % G) % G); S2.a_pm = (size_t)256 * 1024 * 2; S2.b_pn = (size_t)256 * 1024 * 2;
                    pg8::EpiKV E2{vw.out + OUT_MK + (size_t)l * 2048 * 1024, vw.out + OUT_MV + (size_t)l * 2048 * 1024, (bf16_t*)(ws + WS_KB) + (size_t)l * 2048 * 1024};
                    pg8::gemm_phase<pg8::EpiKV>(L, g2, S2, E2, wv_);
                }
                {
                    pg8::Gemm g3{(const bf16_t*)(WL + WO_KV) + (size_t)1024 * 1024, MEMB, 1024, 1024, 1024};
                    pg8::Sched S3; S3.init(4, 8, 1, G, (cid + G - (c0 + 64) % G) % G); S3.a_pm = (size_t)256 * 1024 * 2; S3.b_pn = (size_t)256 * 1024 * 2;
                    pg8::EpiStore E3{(bf16_t*)(ws + WS_VT) + (size_t)l * 1024 * 2048, 2048, 1.0f};
                    pg8::gemm_phase<pg8::EpiStore>(L, g3, S3, E3, wv_);
                }
            }
        } else if constexpr (s == 1 || s == 14 || s == 6 || s == 11) {
            pg8::Gemm g; float sc;
            if constexpr (s == 1 || s == 14) { g = pg8::Gemm{HB, (const bf16_t*)(WL + (s == 1 ? WO_DN1 : WO_DN2)), FF, FF, FF}; sc = 0.5f; }
            else if constexpr (s == 6) { g = pg8::Gemm{MRG, (const bf16_t*)(WL + WO_WO), 1024, 1024, 1024}; sc = 1.0f; }
            else { g = pg8::Gemm{OB, (const bf16_t*)(WL + WO_AO), 1024, 1024, 1024}; sc = 1.0f; }
            pg8::Sched S; S.init(MP / 256, 4, 1, G, cid); S.a_pm = (size_t)256 * g.lda * 2; S.b_pn = (size_t)256 * g.ldb * 2;
            constexpr int which = s == 1 ? 0 : s == 6 ? 1 : s == 11 ? 2 : 3;
            constexpr int gi = which == 0 ? I_LN1G : which == 1 ? I_LN2G : which == 2 ? I_LN3G : I_LN4G;
            constexpr size_t bank_off = WS_CTL + 16384 + (size_t)(l * 4 + which) * 16384;
            typedef pg8::EpiResidLN<(which == 0 || which == 3) ? 1 : 0> EpiT;
            EpiT E{XB, vw.in(gi) + l * D, vw.in(gi + 1) + l * D, (which == 3 && l == 1) ? vw.out + OUT_Y : nullptr, ws + bank_off, (long)WS_XBUF - (long)bank_off};
            skinny_gemm<0>(lds, g.A, g.lda, g.Bt, g.ldb, g.K / 4, XF, XB, nullptr, DN_ALPHA, sc, G, cid, wv_);
#ifndef SK4
            pg8::gemm_phase<EpiT>(L, g, S, E, wv_);
#endif
        } else if constexpr (s == 2 || s == 7 || s == 12 || s == 15) {
            constexpr int gi = s == 2 ? I_LN1G : s == 7 ? I_LN2G : s == 12 ? I_LN3G : I_LN4G;
#ifndef SK5
            ln_pass_sample(XF, XB, vw.in(gi) + l * D, vw.in(gi + 1) + l * D, (s == 15 && l == 1) ? vw.out + OUT_Y : nullptr, G, cid, wv_);
#endif
        } else if constexpr (s == 3) {
            pg8::Gemm g{XB, (const bf16_t*)(WL + WO_IN), 1024, 1024, 1024};
            pg8::Sched S; S.init(M_PAD / 256, 32, 1, G, cid); S.a_pm = (size_t)256 * 1024 * 2; S.b_pn = (size_t)256 * 1024 * 2;
            pg8::EpiIn E{PB, GATE, vw.in(I_BGATE) + l * 4096};
#ifndef SK6
            pg8::gemm_phase<pg8::EpiIn>(L, g, S, E, wv_);
#endif
        } else if constexpr (s == 4) {
#ifndef SK7
            for (int un = cid; un < 256; un += G) sgu_unit(vw, l, un, lds, PB, MIX, wv_);
#endif
#ifndef SK8
            if ((MP % (G * 64)) == 0 || true) {
                __syncthreads();
                LAS float* DW = (LAS float*)((LAS unsigned char*)lds + 65536);
                LAS bf16_t* GL = (LAS bf16_t*)lds;
                const float* dwg = vw.in(I_CDW) + (size_t)l * 31 * 512;
                { f32x4 tw[8];
#pragma unroll
                  for (int u = 0; u < 8; ++u) { const int e = tid + u * NT; tw[u] = *(const f32x4*)(dwg + 4 * (e < 31 * 512 / 4 ? e : 0)); }
#pragma unroll
                  for (int u = 0; u < 8; ++u) { const int e = tid + u * NT; if (e < 31 * 512 / 4) ((LAS f32x4*)DW)[e] = tw[u]; } }
                __syncthreads();
                { const int gw = cid * NWAVES + wave; if ((gw & 15) == 5 && (gw >> 4) < NSAMP) mix_row_s(vw, l, gw >> 4, lane, PB, MIX, DW); }
                const int per = MP / G;
                for (int p0 = 0; p0 < per; p0 += 32) {
                    const int T0 = cid * per + p0, tseq = T0 & 2047;
                    __syncthreads();
                    {
                        u32x4 tw[8]; int t3 = tid; asm volatile("" : "+v"(t3));
#pragma unroll
                        for (int u = 0; u < 8; ++u) { const int e = t3 + u * NT, row = e >> 6, c16 = e & 63; tw[u] = (u32x4){0u, 0u, 0u, 0u};
                            if (e < 62 * 64 && tseq - 30 + row >= 0) tw[u] = *(const u32x4*)(PB + (size_t)(T0 - 30 + row) * 3072 + 1536 + c16 * 8); }
#pragma unroll
                        for (int u = 0; u < 8; ++u) { const int e = t3 + u * NT; if (e < 62 * 64) ((LAS u32x4*)GL)[e] = tw[u]; }
                    }
                    __syncthreads();
                    conv4_lds(vw, l, T0 + wave * 4, lane, MIX, DW, GL + (wave * 4) * 512);
                    { int tb = T0 + wave * 4; asm volatile("" : "+s"(tb));
#pragma nounroll
                      for (int i = 0; i < 4; ++i) mix_row_p<false>(vw, l, tb + i, lane, PB, MIX, DW, GL); }
                }
            }
#endif
        } else if constexpr (s == 5) {
            pg8::Gemm g{MIX, (const bf16_t*)(WL + WO_PROJ), 2048, 2048, 512};
            pg8::Sched S; S.init(MP / 256, 4, 4, G, cid); S.a_pm = (size_t)256 * 2048 * 2; S.b_pn = (size_t)256 * 2048 * 2; S.a_sub = 512 * 2; S.b_sub = 512 * 2;
            pg8::EpiBranch E{GATE, MRG};
            skinny_gemm<2>(lds, MIX, 2048, (const bf16_t*)(WL + WO_PROJ), 2048, 512, nullptr, MRG, GATE, 0.f, 1.0f, G, cid, wv_);
#ifndef SK9
            pg8::gemm_phase<pg8::EpiBranch>(L, g, S, E, wv_);
#endif
        } else if constexpr (s == 9) {
            pg8::Gemm g{QB, (const bf16_t*)(ws + WS_KB) + (size_t)l * 2048 * 1024, 1024, 1024, 256};
            pg8::Sched S; S.init(MP / 256, 4, 1, G, cid); S.a_pm = (size_t)256 * 1024 * 2; S.a_pn = 256 * 2; S.b_pn = 256 * 2; S.b_b = (size_t)256 * 1024 * 2;
            pg8::EpiSoftmax E{PRB};
#ifndef SK10
            pg8::gemm_phase<pg8::EpiSoftmax>(L, g, S, E, wv_);
#endif
            asm volatile("s_waitcnt vmcnt(0)" ::: "memory");
            __syncthreads();
            {
                pg8::Gemm g2{PRB, (const bf16_t*)(ws + WS_VT) + (size_t)l * 1024 * 2048, 1024, 2048, 256};
                pg8::Sched S2; S2.init(MP / 256, 4, 1, G, cid); S2.a_pm = (size_t)256 * 1024 * 2; S2.a_pn = 256 * 2; S2.b_pn = (size_t)256 * 2048 * 2; S2.b_b = 256 * 2;
                pg8::EpiStore E2{OB, 1024, 1.0f};
                pg8::gemm_phase<pg8::EpiStore>(L, g2, S2, E2, wv_);
            }
            __syncthreads();
#ifndef SK11
            for (int un = cid; un < 512; un += G) samp_attn_unit(vw, l, un, lds, QB, OB, wv_);
#endif
        }
}

__global__ void __launch_bounds__(NT, 2) mega_fwd(Args args) {
    extern __shared__ __attribute__((aligned(16))) unsigned char lds[];
    cg::grid_group grid = cg::this_grid();
    const int lo = args.ph_lo, hi = args.ph_hi;
    const int wv_ = __builtin_amdgcn_readfirstlane((int)threadIdx.x >> 6);
    volatile LAS unsigned* MISC = (volatile LAS unsigned*)((LAS unsigned char*)lds + LDS_BYTES - 64);
    if (threadIdx.x < 16) MISC[threadIdx.x] = 0u;
    __syncthreads();
    const XcdBarrier bar = xcd_barrier_post((unsigned*)(args.ws + WS_CTL), MISC);
#define RUN(k) if (lo <= (k) && (k) < hi) { run_phase<(k)>(args, lds, wv_); if ((k) + 1 < hi) { if ((k) == 0) grid.sync(); else xcd_barrier(bar); } }
    RUN(0)
    RUN(3) RUN(4) RUN(5) RUN(6) RUN(7) RUN(8) RUN(9) RUN(10) RUN(11) RUN(12) RUN(14) RUN(15) RUN(16) RUN(17) RUN(18)
    RUN(19) RUN(20) RUN(21) RUN(22) RUN(23) RUN(24) RUN(25) RUN(26) RUN(27) RUN(28) RUN(30) RUN(31) RUN(32) RUN(33) RUN(34)
#undef RUN
}

extern "C" void kernel_launch(void* const* d_in, const int* in_sizes, int n_in, void* d_out, int out_size, void* d_ws, size_t ws_size, hipStream_t stream) {
    static int grid = 0;
    if (grid == 0) {
        if (n_in != N_IN || (size_t)out_size != OUT_END || ws_size < WS_END) { fprintf(stderr, "kernel_launch: unexpected shapes: n_in %d out %d ws %zu (need %zu)\n", n_in, out_size, ws_size, (size_t)WS_END); grid = -1; return; }
        int dev = 0, cus = 0, per_cu = 0;
        if (hipGetDevice(&dev) != hipSuccess || hipDeviceGetAttribute(&cus, hipDeviceAttributeMultiprocessorCount, dev) != hipSuccess) { grid = -1; return; }
        if (hipFuncSetAttribute((const void*)mega_fwd, hipFuncAttributeMaxDynamicSharedMemorySize, LDS_BYTES) != hipSuccess) { fprintf(stderr, "kernel_launch: hipFuncSetAttribute failed\n"); grid = -1; return; }
        if (hipOccupancyMaxActiveBlocksPerMultiprocessor(&per_cu, (const void*)mega_fwd, NT, LDS_BYTES) != hipSuccess || per_cu < 1) { fprintf(stderr, "kernel_launch: occupancy query says %d\n", per_cu); per_cu = 1; }
        (void)hipGetLastError();
        grid = cus * 1;
    }
    if (grid < 0) return;
    Args a{};
    for (int i = 0; i < N_IN; ++i) a.in[i] = (const float*)d_in[i];
    a.out = (float*)d_out; a.ws = (unsigned char*)d_ws;
#if MK_MULTI
#ifndef MK_LAST
#define MK_LAST N_PHASES
#endif
    for (int p = 0; p < MK_LAST; ++p) {
        a.ph_lo = p; a.ph_hi = p + 1;
        hipLaunchKernelGGL(mega_fwd, dim3(grid), dim3(NT), LDS_BYTES, stream, a);
    }
#else
    a.ph_lo = 0; a.ph_hi = N_PHASES;
    if (hipMemsetAsync((char*)d_ws + WS_CTL, 0, CTL_BYTES, stream) != hipSuccess) { fprintf(stderr, "kernel_launch: memset failed\n"); return; }
    void* kargs[] = {&a};
    hipError_t e = hipLaunchCooperativeKernel((const void*)mega_fwd, dim3(grid), dim3(NT), kargs, LDS_BYTES, stream);
    if (e != hipSuccess) fprintf(stderr, "cooperative launch failed: %s (grid %d)\n", hipGetErrorString(e), grid);
#endif
}
```
